# Optimizing an MI355X kernel written in HIP

```python
import math
import jax, jax.numpy as jnp
from jax import lax
import numpy as np

D_MODEL = 2048
BATCH = 4
SEQ = 8192
DEPTH = 4

GRID_W = 64
CTX_LEN = 256
NORM_EPS = 1e-6
N_MOD = 6
HEAD_DIM = 128
N_Q_HEADS = D_MODEL // 256
N_KV_HEADS = 2
GQA_GROUP = N_Q_HEADS // N_KV_HEADS
ATTN_WIDTH = N_Q_HEADS * HEAD_DIM
KV_WIDTH = N_KV_HEADS * HEAD_DIM
ATTN_SCALE = HEAD_DIM ** -0.5
Q_BLOCK = 128
ROPE_AXIS_DIM = HEAD_DIM // 2
ROPE_BASE = 10000.0
CONV_WIDTH = D_MODEL // 2
CONV_K = 3
SSM_GROUP = 16
SSM_WIDTH = 3 * D_MODEL // 8
SSM_GROUPS = SSM_WIDTH // SSM_GROUP
SSM_STATE = 64
SSM_RE_MAX = -1e-4
N_BRANCH = 3
D_FF = 4 * D_MODEL
PROJ_WIDTHS = (CONV_WIDTH, CONV_WIDTH, CONV_WIDTH, SSM_WIDTH, ATTN_WIDTH, KV_WIDTH, KV_WIDTH, N_BRANCH * D_MODEL)
IN_WIDTH = sum(PROJ_WIDTHS)

kernel_name = "hybrid_conv_s5_gqa_parallel_diffusion_block"


def rms_norm(x, g):
    xf = x.astype(jnp.float32)
    y = xf * lax.rsqrt(jnp.mean(xf * xf, axis=-1, keepdims=True) + NORM_EPS)
    return (y * g.astype(jnp.float32)).astype(x.dtype)


def modulate(h, shift, scale):
    return h * (1 + scale) + shift


def split_proj(p):
    offs = np.cumsum(PROJ_WIDTHS)[:-1].tolist()
    return jnp.split(p, offs, axis=-1)


def axial_rope_tables(n, dtype):
    rows = n // GRID_W
    row = jnp.repeat(jnp.arange(rows), GRID_W)
    col = jnp.tile(jnp.arange(GRID_W), rows)
    half = ROPE_AXIS_DIM // 2
    inv_freq = ROPE_BASE ** (-jnp.arange(half, dtype=jnp.float32) / half)
    ang_r = row.astype(jnp.float32)[:, None] * inv_freq
    ang_c = col.astype(jnp.float32)[:, None] * inv_freq
    return (jnp.cos(ang_r).astype(dtype), jnp.sin(ang_r).astype(dtype),
            jnp.cos(ang_c).astype(dtype), jnp.sin(ang_c).astype(dtype))


def rotate_half_rope(x, cos, sin):
    x1, x2 = jnp.split(x, 2, axis=-1)
    cos = cos[None, :, None, :]
    sin = sin[None, :, None, :]
    return jnp.concatenate([x1 * cos - x2 * sin, x2 * cos + x1 * sin], axis=-1)


def apply_axial_rope(x, tables):
    cos_r, sin_r, cos_c, sin_c = tables
    x_row, x_col = jnp.split(x, 2, axis=-1)
    return jnp.concatenate([rotate_half_rope(x_row, cos_r, sin_r), rotate_half_rope(x_col, cos_c, sin_c)], axis=-1)


def gqa_attend(q, k, v):
    b, lq = q.shape[:2]
    qg = q.reshape(b, lq, N_KV_HEADS, GQA_GROUP, HEAD_DIM)
    s = jnp.einsum('bqhgd,bkhd->bhgqk', qg, k).astype(jnp.float32) * ATTN_SCALE
    p = jax.nn.softmax(s, axis=-1).astype(v.dtype)
    o = jnp.einsum('bhgqk,bkhd->bqhgd', p, v)
    return o.reshape(b, lq, ATTN_WIDTH)


def blocked_attention(q, k, v):
    b, n = q.shape[:2]
    nblk = n // Q_BLOCK
    qb = jnp.moveaxis(q.reshape(b, nblk, Q_BLOCK, N_Q_HEADS, HEAD_DIM), 1, 0)
    o = lax.map(lambda qq: gqa_attend(qq, k, v), qb)
    return jnp.moveaxis(o, 0, 1).reshape(b, n, ATTN_WIDTH)


def dwconv3_centred(u, w):
    n = u.shape[1]
    up = jnp.pad(u, ((0, 0), (1, 1), (0, 0)))
    return up[:, :n] * w[0] + up[:, 1:n + 1] * w[1] + up[:, 2:] * w[2]


def short_conv_branch(gate_b, gate_c, v, conv_w, w_conv_out):
    return (gate_b * dwconv3_centred(gate_c * v, conv_w)) @ w_conv_out


def ssm_discretise(lam_re, lam_im, log_dt, b_re, b_im):
    lam_re = jnp.minimum(lam_re.astype(jnp.float32), SSM_RE_MAX)
    lam_im = lam_im.astype(jnp.float32)
    dt = jnp.exp(log_dt.astype(jnp.float32))[:, None]
    mag = jnp.exp(lam_re * dt)
    ab_re = mag * jnp.cos(lam_im * dt)
    ab_im = mag * jnp.sin(lam_im * dt)
    nr = ab_re - 1
    den = lam_re * lam_re + lam_im * lam_im
    f_re = (nr * lam_re + ab_im * lam_im) / den
    f_im = (ab_im * lam_re - nr * lam_im) / den
    b_re = b_re.astype(jnp.float32)
    b_im = b_im.astype(jnp.float32)
    bb_re = f_re[..., None] * b_re - f_im[..., None] * b_im
    bb_im = f_re[..., None] * b_im + f_im[..., None] * b_re
    return ab_re, ab_im, bb_re, bb_im


def complex_linear_combine(e1, e2):
    a1r, a1i, b1r, b1i = e1
    a2r, a2i, b2r, b2i = e2
    return (a2r * a1r - a2i * a1i, a2r * a1i + a2i * a1r,
            a2r * b1r - a2i * b1i + b2r, a2r * b1i + a2i * b1r + b2i)


def ssm_states(u, disc, h0):
    ab_re, ab_im, bb_re, bb_im = disc
    bu_re = jnp.einsum('blgp,gnp->blgn', u, bb_re)
    bu_im = jnp.einsum('blgp,gnp->blgn', u, bb_im)
    if h0 is not None:
        h_re, h_im = h0
        bu_re = bu_re.at[:, 0].add(ab_re * h_re - ab_im * h_im)
        bu_im = bu_im.at[:, 0].add(ab_re * h_im + ab_im * h_re)
    l = u.shape[1]
    a_re = jnp.broadcast_to(ab_re, (1, l) + ab_re.shape)
    a_im = jnp.broadcast_to(ab_im, (1, l) + ab_im.shape)
    _, _, h_re, h_im = lax.associative_scan(complex_linear_combine, (a_re, a_im, bu_re, bu_im), axis=1)
    return h_re, h_im


def ssm_readout(h_re, h_im, c_re, c_im):
    return jnp.einsum('blgn,gpn->blgp', h_re, c_re) - jnp.einsum('blgn,gpn->blgp', h_im, c_im)


def glu_out(y, w_glu):
    a, g = jnp.split(jax.nn.gelu(y) @ w_glu, 2, axis=-1)
    return a * jax.nn.sigmoid(g)


def ssm_branch(u_x, u_c, lam_re, lam_im, log_dt, b_re, b_im, c_re, c_im, d_skip, w_glu, need_ctx):
    dtype = u_x.dtype
    bx, n, _ = u_x.shape
    bc, m, _ = u_c.shape
    ux = u_x.astype(jnp.float32).reshape(bx, n, SSM_GROUPS, SSM_GROUP)
    uc = u_c.astype(jnp.float32).reshape(bc, m, SSM_GROUPS, SSM_GROUP)
    dsk = d_skip.astype(jnp.float32).reshape(SSM_GROUPS, SSM_GROUP)
    y_x = dsk * ux
    y_c = dsk * uc if need_ctx else None
    for d in range(2):
        disc = ssm_discretise(lam_re[d], lam_im[d], log_dt[d], b_re[d], b_im[d])
        cr = c_re[d].astype(jnp.float32)
        ci = c_im[d].astype(jnp.float32)
        sx = ux if d == 0 else jnp.flip(ux, axis=1)
        sc = uc if d == 0 else jnp.flip(uc, axis=1)
        hc_re, hc_im = ssm_states(sc, disc, None)
        hx_re, hx_im = ssm_states(sx, disc, (hc_re[:, -1], hc_im[:, -1]))
        yx = ssm_readout(hx_re, hx_im, cr, ci)
        y_x = y_x + (yx if d == 0 else jnp.flip(yx, axis=1))
        if need_ctx:
            yc = ssm_readout(hc_re, hc_im, cr, ci)
            y_c = y_c + (yc if d == 0 else jnp.flip(yc, axis=1))
    out_x = glu_out(y_x.reshape(bx, n, SSM_WIDTH).astype(dtype), w_glu)
    out_c = glu_out(y_c.reshape(bc, m, SSM_WIDTH).astype(dtype), w_glu) if need_ctx else None
    return out_x, out_c


def gated_merge(y_conv, y_ssm, y_attn, gate_logits, w_out):
    g = jax.nn.sigmoid(gate_logits.astype(jnp.float32)).astype(y_conv.dtype)
    g_conv, g_ssm, g_attn = jnp.split(g, N_BRANCH, axis=-1)
    return (g_conv * y_conv + g_ssm * y_ssm + g_attn * y_attn) @ w_out


def hybrid_mixer(hx, hc, w_in, conv_w, w_conv_out, lam_re, lam_im, log_dt, b_re, b_im, c_re, c_im,
                 d_skip, w_glu, q_gain, k_gain, w_attn_out, w_out, rope, need_ctx):
    bx, n, _ = hx.shape
    bc, m, _ = hc.shape
    xa_b, xa_c, xa_v, xs_u, xq, xk, xv, xg = split_proj(hx @ w_in)
    ca_b, ca_c, ca_v, cs_u, cq, ck, cv, cg = split_proj(hc @ w_in)
    ya_x = short_conv_branch(xa_b, xa_c, xa_v, conv_w, w_conv_out)
    ys_x, ys_c = ssm_branch(xs_u, cs_u, lam_re, lam_im, log_dt, b_re, b_im, c_re, c_im, d_skip, w_glu, need_ctx)
    q_x = apply_axial_rope(rms_norm(xq.reshape(bx, n, N_Q_HEADS, HEAD_DIM), q_gain), rope)
    k_x = apply_axial_rope(rms_norm(xk.reshape(bx, n, N_KV_HEADS, HEAD_DIM), k_gain), rope)
    v_x = xv.reshape(bx, n, N_KV_HEADS, HEAD_DIM)
    k_c = rms_norm(ck.reshape(bc, m, N_KV_HEADS, HEAD_DIM), k_gain)
    v_c = cv.reshape(bc, m, N_KV_HEADS, HEAD_DIM)
    k_all = jnp.concatenate([k_c, k_x], axis=1)
    v_all = jnp.concatenate([v_c, v_x], axis=1)
    yc_x = blocked_attention(q_x, k_all, v_all) @ w_attn_out
    out_x = gated_merge(ya_x, ys_x, yc_x, xg, w_out)
    if not need_ctx:
        return out_x, None
    ya_c = short_conv_branch(ca_b, ca_c, ca_v, conv_w, w_conv_out)
    q_c = rms_norm(cq.reshape(bc, m, N_Q_HEADS, HEAD_DIM), q_gain)
    yc_c = gqa_attend(q_c, k_c, v_c) @ w_attn_out
    out_c = gated_merge(ya_c, ys_c, yc_c, cg, w_out)
    return out_x, out_c


def sq_relu_mlp(h, w_up, w_down):
    return jnp.square(jax.nn.relu(h @ w_up)) @ w_down


def setup_inputs(seed: int = 0) -> dict:
    key = jax.random.key(seed)
    ks = jax.random.split(key, 32)
    f32 = jnp.float32

    def nrm(k, shape, s):
        return jax.random.normal(k, shape, f32) * s

    g_shape = (DEPTH, SSM_GROUPS, SSM_STATE)
    n_idx = jnp.arange(SSM_STATE, dtype=f32)
    return {
        "x": nrm(ks[0], (BATCH, SEQ, D_MODEL), 1.0),
        "c": nrm(ks[1], (BATCH, D_MODEL), 1.0),
        "ctx": nrm(ks[2], (BATCH, CTX_LEN, D_MODEL), 1.0),
        "c_ctx": nrm(ks[3], (D_MODEL,), 1.0),
        "w_mod": nrm(ks[4], (DEPTH, D_MODEL, N_MOD * D_MODEL), 0.5 * D_MODEL ** -0.5),
        "b_mod": nrm(ks[5], (DEPTH, N_MOD * D_MODEL), 0.02),
        "g_pre_mix": 1.0 + nrm(ks[6], (DEPTH, D_MODEL), 0.05),
        "g_post_mix": 1.0 + nrm(ks[7], (DEPTH, D_MODEL), 0.05),
        "g_pre_mlp": 1.0 + nrm(ks[8], (DEPTH, D_MODEL), 0.05),
        "g_post_mlp": 1.0 + nrm(ks[9], (DEPTH, D_MODEL), 0.05),
        "w_in": nrm(ks[10], (DEPTH, D_MODEL, IN_WIDTH), D_MODEL ** -0.5),
        "conv_w": nrm(ks[11], (DEPTH, CONV_K, CONV_WIDTH), CONV_K ** -0.5),
        "w_conv_out": nrm(ks[12], (DEPTH, CONV_WIDTH, D_MODEL), CONV_WIDTH ** -0.5),
        "ssm_lam_re": -0.5 + nrm(ks[13], (DEPTH, 2, SSM_GROUPS, SSM_STATE), 0.01),
        "ssm_lam_im": math.pi * n_idx + nrm(ks[14], (DEPTH, 2, SSM_GROUPS, SSM_STATE), 0.01),
        "ssm_log_dt": jax.random.uniform(ks[15], (DEPTH, 2, SSM_GROUPS), f32, math.log(1e-3), math.log(1e-1)),
        "ssm_b_re": nrm(ks[16], (DEPTH, 2, SSM_GROUPS, SSM_STATE, SSM_GROUP), (2 * SSM_GROUP) ** -0.5),
        "ssm_b_im": nrm(ks[17], (DEPTH, 2, SSM_GROUPS, SSM_STATE, SSM_GROUP), (2 * SSM_GROUP) ** -0.5),
        "ssm_c_re": nrm(ks[18], (DEPTH, 2, SSM_GROUPS, SSM_GROUP, SSM_STATE), SSM_STATE ** -0.5),
        "ssm_c_im": nrm(ks[19], (DEPTH, 2, SSM_GROUPS, SSM_GROUP, SSM_STATE), SSM_STATE ** -0.5),
        "ssm_d": nrm(ks[20], (DEPTH, SSM_WIDTH), 1.0),
        "w_glu": nrm(ks[21], (DEPTH, SSM_WIDTH, 2 * D_MODEL), SSM_WIDTH ** -0.5),
        "q_gain": 1.0 + nrm(ks[22], (DEPTH, HEAD_DIM), 0.05),
        "k_gain": 1.0 + nrm(ks[23], (DEPTH, HEAD_DIM), 0.05),
        "w_attn_out": nrm(ks[24], (DEPTH, ATTN_WIDTH, D_MODEL), ATTN_WIDTH ** -0.5),
        "w_out": nrm(ks[25], (DEPTH, D_MODEL, D_MODEL), D_MODEL ** -0.5),
        "w_up": nrm(ks[26], (DEPTH, D_MODEL, D_FF), D_MODEL ** -0.5),
        "w_down": nrm(ks[27], (DEPTH, D_FF, D_MODEL), D_FF ** -0.5),
    }


def reference(x, c, ctx, c_ctx, w_mod, b_mod, g_pre_mix, g_post_mix, g_pre_mlp, g_post_mlp, w_in, conv_w,
              w_conv_out, ssm_lam_re, ssm_lam_im, ssm_log_dt, ssm_b_re, ssm_b_im, ssm_c_re, ssm_c_im, ssm_d,
              w_glu, q_gain, k_gain, w_attn_out, w_out, w_up, w_down):
    b, n, _ = x.shape
    rope = axial_rope_tables(n, x.dtype)
    for l in range(DEPTH):
        need_ctx = l < DEPTH - 1
        mod_x = (jax.nn.silu(c) @ w_mod[l] + b_mod[l]).reshape(b, 1, N_MOD, D_MODEL)
        mod_c = (jax.nn.silu(c_ctx) @ w_mod[l] + b_mod[l]).reshape(1, 1, N_MOD, D_MODEL)
        hx = modulate(rms_norm(x, g_pre_mix[l]), mod_x[:, :, 0], mod_x[:, :, 1])
        hc = modulate(rms_norm(ctx, g_pre_mix[l]), mod_c[:, :, 0], mod_c[:, :, 1])
        mx, mc = hybrid_mixer(hx, hc, w_in[l], conv_w[l], w_conv_out[l], ssm_lam_re[l], ssm_lam_im[l],
                              ssm_log_dt[l], ssm_b_re[l], ssm_b_im[l], ssm_c_re[l], ssm_c_im[l], ssm_d[l],
                              w_glu[l], q_gain[l], k_gain[l], w_attn_out[l], w_out[l], rope, need_ctx)
        x = x + mod_x[:, :, 2] * rms_norm(mx, g_post_mix[l])
        hx = modulate(rms_norm(x, g_pre_mlp[l]), mod_x[:, :, 3], mod_x[:, :, 4])
        x = x + mod_x[:, :, 5] * rms_norm(sq_relu_mlp(hx, w_up[l], w_down[l]), g_post_mlp[l])
        if need_ctx:
            ctx = ctx + mod_c[:, :, 2] * rms_norm(mc, g_post_mix[l])
            hc = modulate(rms_norm(ctx, g_pre_mlp[l]), mod_c[:, :, 3], mod_c[:, :, 4])
            ctx = ctx + mod_c[:, :, 5] * rms_norm(sq_relu_mlp(hc, w_up[l], w_down[l]), g_post_mlp[l])
    return x
```

```cpp
#include <hip/hip_runtime.h>
#include <cstdio>
#include <cstdint>
#include <cmath>

#ifndef MK_PER_PHASE
#define MK_PER_PHASE 0
#endif

#define LAS __attribute__((address_space(3)))
#define GAS __attribute__((address_space(1)))
typedef unsigned short bf16_t;
typedef short bf16x8 __attribute__((ext_vector_type(8)));
typedef short s16x4 __attribute__((ext_vector_type(4)));
typedef float f32x2 __attribute__((ext_vector_type(2)));
typedef float f32x4 __attribute__((ext_vector_type(4)));
typedef float f32x16 __attribute__((ext_vector_type(16)));
typedef unsigned u32x2 __attribute__((ext_vector_type(2)));
typedef unsigned u32x4 __attribute__((ext_vector_type(4)));
typedef GAS unsigned gu32;

constexpr int D = 2048, NBATCH = 4, SEQ = 8192, CTXL = 256, DEPTH = 4;
constexpr int ML = NBATCH * SEQ, MC = NBATCH * CTXL, M = ML + MC;
constexpr int NIN = 11520, FF = 8192, NMOD = 6 * D;
constexpr int C_AB = 0, C_AC = 1024, C_AV = 2048, C_SU = 3072, C_Q = 3840, C_K = 4864, C_V = 5120, C_GC = 5376, C_GS = 7424, C_GA = 9472;
constexpr int C_O = C_AC, C_Y = C_SU;
constexpr int SG = 48, SGR = 1280, SGV = 1056;
constexpr float NORM_EPS = 1e-6f;

constexpr size_t MiB = 1u << 20;
constexpr size_t WS_CTL = 0, CTL_ZERO_BYTES = 1 * MiB;
constexpr size_t WS_MOD = 1 * MiB;
constexpr size_t WS_ROPE = 2 * MiB;
constexpr size_t WS_ETAB = 3 * MiB;
constexpr size_t WS_BB = 10 * MiB;
constexpr size_t WS_MT = 13 * MiB;
constexpr size_t WS_CTXR = 25 * MiB;
constexpr size_t WS_WIN = 33 * MiB, WS_WCO = 78 * MiB, WS_WGLU = 82 * MiB, WS_WAO = 88 * MiB, WS_WOUT = 92 * MiB, WS_WUP = 100 * MiB, WS_WDN = 132 * MiB;
constexpr size_t WS_W1 = 164 * MiB, WS_W3 = 176 * MiB;
constexpr size_t WS_XN = 212 * MiB, WS_MX = 344 * MiB, WS_ASSM = 476 * MiB, WS_S = 566 * MiB, WS_P = 626 * MiB;
constexpr size_t WS_END = WS_P + (size_t)M * NIN * 2 + MiB;
constexpr size_t WS_UP = WS_P;
static_assert((size_t)M * FF * 2 <= (size_t)M * NIN * 2, "UP overlay");
constexpr int CW_BAR = 4096;

constexpr int LDS_BYTES = 147456, MISC_OFF = LDS_BYTES - 256;

#define RLX_AGENT __ATOMIC_RELAXED, __HIP_MEMORY_SCOPE_AGENT
#define LDS_WAIT() asm volatile("s_waitcnt lgkmcnt(0)" ::: "memory")
__device__ __forceinline__ unsigned cvt_pk_bf16(float lo, float hi) { unsigned r; asm volatile("v_cvt_pk_bf16_f32 %0, %1, %2" : "=v"(r) : "v"(lo), "v"(hi)); return r; }
__device__ __forceinline__ float bf_lo(unsigned w) { return __uint_as_float(w << 16); }
__device__ __forceinline__ float bf_hi(unsigned w) { return __uint_as_float(w & 0xffff0000u); }
__device__ __forceinline__ float wave_sum(float v) {
#pragma unroll
    for (int o = 1; o < 64; o <<= 1) v += __shfl_xor(v, o);
    return v;
}
__device__ __forceinline__ float sigmoidf_(float x) { return __builtin_amdgcn_rcpf(1.0f + __builtin_amdgcn_exp2f(-1.4426950408889634f * x)); }
__device__ __forceinline__ float gelu_tanh(float x) { const float u = 0.7978845608028654f * (x + 0.044715f * x * x * x); return x * sigmoidf_(2.0f * u); }

#define XB_TMO      128
#define XB_XCNT(j)  (256  + 64 * (j))
#define XB_XSUB(j)  (1280 + 64 * (j))
#define XB_XGEN(j)  (2304 + 64 * (j))
#define XB_TOP      3328
#define XB_TOPGEN   3392
#define XCD_BAR_WORDS 3456
#define XB_SPIN_CAP (1u << 22)
__device__ __forceinline__ unsigned xb_ld(unsigned* p)              { return __hip_atomic_load(p, __ATOMIC_RELAXED, __HIP_MEMORY_SCOPE_AGENT); }
__device__ __forceinline__ unsigned xb_add(unsigned* p, unsigned v) { return __hip_atomic_fetch_add(p, v, __ATOMIC_RELAXED, __HIP_MEMORY_SCOPE_AGENT); }
__device__ __forceinline__ unsigned xb_xcc_id() { return (unsigned)__builtin_amdgcn_s_getreg((3 << 11) | 20) & 0xFu; }
#define XB_SPIN(cond, bar) do { unsigned _sp = 0; while (cond) { __builtin_amdgcn_s_sleep(1); \
    if ((++_sp & 255u) == 0u) { if (xb_ld(&(bar)[XB_TMO])) break; if (_sp > XB_SPIN_CAP) { atomicAdd(&(bar)[XB_TMO], 1u); break; } } } } while (0)
struct XcdBarrier { unsigned* bar; unsigned x; volatile LAS unsigned* st; };
__device__ __forceinline__ XcdBarrier xcd_barrier_post(unsigned* bar, volatile LAS unsigned* st) {
    XcdBarrier b; b.bar = bar; b.x = xb_xcc_id(); b.st = st;
    if (threadIdx.x == 0) (void)xb_add(&bar[XB_XCNT(b.x)], 1u);
    return b;
}
__device__ __forceinline__ void xcd_barrier_complete(unsigned* bar, unsigned x, unsigned& nloc, unsigned& nx) {
    const unsigned G = gridDim.x * gridDim.y * gridDim.z;
    unsigned sum, cnt, mine, sp = 0u;
    for (;;) {
        sum = 0u; cnt = 0u; mine = 0u;
#pragma unroll
        for (unsigned j = 0; j < 16; ++j) { const unsigned c = xb_ld(&bar[XB_XCNT(j)]); sum += c; cnt += (c > 0u) ? 1u : 0u; mine = (j == x) ? c : mine; }
        if (sum == G) break;
        __builtin_amdgcn_s_sleep(1);
        if ((++sp & 255u) == 0u) { if (xb_ld(&bar[XB_TMO])) break; if (sp > XB_SPIN_CAP) { atomicAdd(&bar[XB_TMO], 1u); break; } }
    }
    nloc = mine > 0u ? mine : 1u; nx = cnt > 0u ? cnt : 1u;
}
__device__ __forceinline__ void xcd_barrier(const XcdBarrier& b) {
    asm volatile("s_waitcnt vmcnt(0)" ::: "memory");
    __syncthreads();
    if (threadIdx.x == 0) {
        unsigned* bar = b.bar;
        __builtin_amdgcn_s_waitcnt(0);
        unsigned nloc = b.st[0], nx = b.st[1];
        if (nloc == 0u) { xcd_barrier_complete(bar, b.x, nloc, nx); b.st[0] = nloc; b.st[1] = nx; }
        const unsigned old = xb_add(&bar[XB_XSUB(b.x)], 1u);
        const unsigned gen = old / nloc;
        if (old + 1u == (gen + 1u) * nloc) {
            __builtin_amdgcn_fence(__ATOMIC_RELEASE, "agent");
            asm volatile("s_waitcnt vmcnt(0)" ::: "memory");
            const unsigned og = xb_add(&bar[XB_TOP], 1u);
            const unsigned tg = og / nx;
            if (og + 1u == (tg + 1u) * nx) xb_add(&bar[XB_TOPGEN], 1u);
            else XB_SPIN(xb_ld(&bar[XB_TOPGEN]) == tg, bar);
            __builtin_amdgcn_fence(__ATOMIC_ACQUIRE, "agent");
            xb_add(&bar[XB_XGEN(b.x)], 1u);
            asm volatile("s_waitcnt vmcnt(0)" ::: "memory");
        } else {
            XB_SPIN(xb_ld(&bar[XB_XGEN(b.x)]) == gen, bar);
            __builtin_amdgcn_fence(__ATOMIC_ACQUIRE, "agent");
            asm volatile("s_waitcnt vmcnt(0)" ::: "memory");
        }
    }
    __syncthreads();
}

namespace pg8 {
constexpr int BM = 256, BK = 64, HALF = 128, HTB = HALF * BK * 2, STAGE_BYTES = 8 * HTB, NXCD = 8, WGM = 8;
__host__ __device__ __forceinline__ int lds_byte(int r, int c) { const int st = (r >> 4) * 2 + (c >> 5), rr = r & 15, cc = c & 31, ob = rr * 64 + cc * 2; return st * 1024 + (ob ^ (((ob >> 9) & 1) << 5)); }
__host__ __device__ __forceinline__ void stage_rc(int b, int& R, int& C) { const int st = b / 1024, sb = b % 1024, swz = sb ^ (((sb >> 9) & 1) << 5); R = (st >> 1) * 16 + swz / 64; C = (st & 1) * 32 + (swz % 64) / 2; }
__host__ __device__ __forceinline__ int perm32(int rho) { const int n = rho >> 4, i = rho & 15; return 8 * (i >> 2) + 4 * n + (i & 3); }
struct Unit { int pm, pn; };
struct Gemm { const bf16_t* A; const bf16_t* Bt; int lda, ldb, K; };
struct StaticOrder {
    int nM, nN, nwg, G, c;
    __device__ void init(int M_, int N_, int G_, int c_) { nM = M_ / BM; nN = N_ / BM; nwg = nM * nN; G = G_; c = c_; }
    __device__ bool next(int i, Unit& u) const {
        const long L = (long)i * G + c; if (L >= nwg) return false;
        int wgid = (int)L; { const int q = nwg / NXCD, r = nwg % NXCD, xcd = wgid % NXCD, off = wgid / NXCD; wgid = (xcd < r ? xcd * (q + 1) : r * (q + 1) + (xcd - r) * q) + off; }
        const int nig = WGM * nN, gid = wgid / nig, fm = gid * WGM, gsz = (nM - fm) < WGM ? (nM - fm) : WGM;
        u.pm = fm + ((wgid % nig) % gsz); u.pn = (wgid % nig) / gsz; return true;
    }
};
struct GroupOrder {
    int nj, nunits, G, c;
    __device__ void init(int nj_, int G_, int c_) { nj = nj_; nunits = SG * 5 * nj_; G = G_; c = c_; }
    __device__ bool next(int i, Unit& u) const {
        const int L = i * G + c; if (L >= nunits) return false;
        u.pm = L / nj; u.pn = (u.pm / 5) * nj + (L % nj); return true;
    }
};

template <class Epi, class Sched>
__device__ __forceinline__ void gemm_phase(LAS unsigned char* lds, const Gemm g, const Sched& S, const Epi& E) {
    int tid_ = threadIdx.x; asm volatile("" : "+v"(tid_));
    const int tid = tid_, wid = __builtin_amdgcn_readfirstlane(tid >> 6), lane = tid & 63, wr = wid >> 2, wc = wid & 3, fr = lane & 15, fq = lane >> 4;
    const int nt = g.K / BK;
    unsigned voffA[2], voffB[2];
#pragma unroll
    for (int i = 0; i < 2; ++i) { int R, C; stage_rc(tid * 16 + i * 8192, R, C); const int Rb = Epi::PERM ? ((R & ~31) + perm32(R & 31)) : R;
        voffA[i] = (unsigned)(R * g.lda + C) * 2u; voffB[i] = (unsigned)(Rb * g.ldb + C) * 2u; }
    const size_t kstep = (size_t)(BK * 2);
    const size_t hA = (size_t)HALF * g.lda * 2, hB = (size_t)HALF * g.ldb * 2, tA = 2 * hA, tB = 2 * hB;
    const unsigned ldsw = (unsigned)wid * 1024u;
    const int aoff = lds_byte(wr * 64 + fr, fq * 8), boff = lds_byte(wc * 32 + fr, fq * 8);
#define PG8_SA(b, h) (((b) * 2 + (h)) * HTB)
#define PG8_SB(b, h) ((4 + (b) * 2 + (h)) * HTB)
#define PG8_STAGE(bufoff, gbase, voff) do { _Pragma("unroll") for (int _i = 0; _i < 2; ++_i) \
        __builtin_amdgcn_global_load_lds((const unsigned*)((const char*)(gbase) + (voff)[_i]), (LAS unsigned*)(lds + (bufoff) + ldsw + _i * 8192), 16, 0, 0); } while (0)
#define PG8_LDA(dst, b, h) do { _Pragma("unroll") for (int m = 0; m < 4; ++m) _Pragma("unroll") for (int k = 0; k < 2; ++k) dst[m][k] = *(const LAS bf16x8*)(lds + PG8_SA(b, h) + aoff + m * 2048 + k * 1024); } while (0)
#define PG8_LDB(dst, b, h) do { _Pragma("unroll") for (int n = 0; n < 2; ++n) _Pragma("unroll") for (int k = 0; k < 2; ++k) dst[n][k] = *(const LAS bf16x8*)(lds + PG8_SB(b, h) + boff + n * 2048 + k * 1024); } while (0)
#define PG8_MMA(ai, bj, At, Bt) do { __builtin_amdgcn_s_setprio(1); _Pragma("unroll") for (int m = 0; m < 4; ++m) _Pragma("unroll") for (int n = 0; n < 2; ++n) _Pragma("unroll") for (int k = 0; k < 2; ++k) \
        acc[ai][bj][m][n] = __builtin_amdgcn_mfma_f32_16x16x32_bf16(Bt[n][k], At[m][k], acc[ai][bj][m][n], 0, 0, 0); __builtin_amdgcn_s_setprio(0); } while (0)
#define PG8_WAIT_V(n) asm volatile("s_waitcnt vmcnt(" #n ")" ::: "memory")
#define PG8_WAIT_L(n) asm volatile("s_waitcnt lgkmcnt(" #n ")" ::: "memory")
#define PG8_BAR __builtin_amdgcn_s_barrier()
#define PG8_SCHED __builtin_amdgcn_sched_barrier(0)
    Unit cur, nxt; int ui = 0;
    if (!S.next(0, cur)) return;
    f32x4 acc[2][2][4][2];
#pragma unroll
    for (int a = 0; a < 2; ++a)
#pragma unroll
        for (int b = 0; b < 2; ++b)
#pragma unroll
            for (int m = 0; m < 4; ++m)
#pragma unroll
                for (int n = 0; n < 2; ++n) acc[a][b][m][n] = (f32x4){0.f, 0.f, 0.f, 0.f};
    bf16x8 At[4][2], B0[2][2], B1[2][2];
    const char* cA = (const char*)g.A + (size_t)cur.pm * tA; const char* cB = (const char*)g.Bt + (size_t)cur.pn * tB;
    PG8_STAGE(PG8_SB(0, 0), cB, voffB); PG8_STAGE(PG8_SB(0, 1), cB + hB, voffB); PG8_STAGE(PG8_SA(0, 0), cA, voffA); PG8_STAGE(PG8_SA(0, 1), cA + hA, voffA);
    if (wr == 1) PG8_BAR;
    PG8_WAIT_V(2); PG8_BAR;
    PG8_STAGE(PG8_SB(1, 0), cB + kstep, voffB); PG8_STAGE(PG8_SA(1, 0), cA + kstep, voffA); PG8_STAGE(PG8_SB(1, 1), cB + hB + kstep, voffB);
    PG8_WAIT_V(6); PG8_BAR;
    for (;;) {
        const bool has_next = S.next(ui + 1, nxt);
        const char* nA = has_next ? (const char*)g.A + (size_t)nxt.pm * tA : cA; const char* nB = has_next ? (const char*)g.Bt + (size_t)nxt.pn * tB : cB;
        for (int t = 0; t < nt; t += 2) {
            const bool last = (t == nt - 2);
            const char* a1 = cA + (size_t)(t + 1) * kstep;
            const char* a2 = last ? nA : cA + (size_t)(t + 2) * kstep; const char* b2 = last ? nB : cB + (size_t)(t + 2) * kstep;
            const char* a3 = a2 + kstep; const char* b3 = b2 + kstep;
            PG8_LDB(B0, 0, 0); PG8_LDB(B1, 0, 1); PG8_SCHED; PG8_LDA(At, 0, 0); PG8_STAGE(PG8_SA(1, 1), a1 + hA, voffA);
            PG8_WAIT_V(8); PG8_WAIT_L(0); PG8_BAR; PG8_MMA(0, 0, At, B0); PG8_MMA(0, 1, At, B1); PG8_BAR; PG8_SCHED;
            PG8_LDA(At, 0, 1); PG8_STAGE(PG8_SB(0, 0), b2, voffB); PG8_STAGE(PG8_SB(0, 1), b2 + hB, voffB); PG8_STAGE(PG8_SA(0, 0), a2, voffA);
            PG8_WAIT_V(8); PG8_WAIT_L(0); PG8_BAR; PG8_MMA(1, 0, At, B0); PG8_MMA(1, 1, At, B1); PG8_BAR; PG8_SCHED;
            PG8_LDB(B0, 1, 0); PG8_LDB(B1, 1, 1); PG8_SCHED; PG8_LDA(At, 1, 0); PG8_STAGE(PG8_SA(0, 1), a2 + hA, voffA);
            PG8_WAIT_V(8); PG8_WAIT_L(0); PG8_BAR; PG8_MMA(0, 0, At, B0); PG8_MMA(0, 1, At, B1); PG8_BAR; PG8_SCHED;
            PG8_LDA(At, 1, 1); PG8_STAGE(PG8_SB(1, 0), b3, voffB); PG8_STAGE(PG8_SB(1, 1), b3 + hB, voffB); PG8_STAGE(PG8_SA(1, 0), a3, voffA);
            PG8_WAIT_V(8); PG8_WAIT_L(0); PG8_BAR; PG8_MMA(1, 0, At, B0); PG8_MMA(1, 1, At, B1); PG8_BAR; PG8_SCHED;
        }
        if (wr == 0) PG8_BAR;
        E(acc, cur, wr, wc, fr, fq);
        if (!has_next) break;
#pragma unroll
        for (int a = 0; a < 2; ++a)
#pragma unroll
            for (int b = 0; b < 2; ++b)
#pragma unroll
                for (int m = 0; m < 4; ++m)
#pragma unroll
                    for (int n = 0; n < 2; ++n) acc[a][b][m][n] = (f32x4){0.f, 0.f, 0.f, 0.f};
        cur = nxt; cA = nA; cB = nB; ++ui;
        if (wr == 1) PG8_BAR;
    }
    PG8_WAIT_V(0);
    PG8_BAR;
#undef PG8_SA
#undef PG8_SB
#undef PG8_STAGE
#undef PG8_LDA
#undef PG8_LDB
#undef PG8_MMA
#undef PG8_WAIT_V
#undef PG8_WAIT_L
#undef PG8_BAR
#undef PG8_SCHED
}

typedef const f32x4 (&AccRef)[2][2][4][2];
__device__ __forceinline__ u32x4 pack8(const f32x4 v0, const f32x4 v1) { u32x4 w; w.x = cvt_pk_bf16(v0[0], v0[1]); w.y = cvt_pk_bf16(v0[2], v0[3]); w.z = cvt_pk_bf16(v1[0], v1[1]); w.w = cvt_pk_bf16(v1[2], v1[3]); return w; }
__device__ __forceinline__ void unpack8(const u32x4 w, f32x4& v0, f32x4& v1) { v0 = (f32x4){bf_lo(w.x), bf_hi(w.x), bf_lo(w.y), bf_hi(w.y)}; v1 = (f32x4){bf_lo(w.z), bf_hi(w.z), bf_lo(w.w), bf_hi(w.w)}; }

template <int ACT> struct EpiBf16 {
    static constexpr bool PERM = true;
    bf16_t* O; int ldc;
    __device__ __forceinline__ void operator()(AccRef acc, const Unit& u, int wr, int wc, int fr, int fq) const {
        const int row0 = u.pm * BM + wr * 64 + fr, col0 = u.pn * BM + wc * 32 + 8 * fq;
#pragma unroll
        for (int ai = 0; ai < 2; ++ai)
#pragma unroll
            for (int m = 0; m < 4; ++m) { bf16_t* rowp = O + (size_t)(row0 + ai * HALF + m * 16) * ldc + col0;
#pragma unroll
                for (int bj = 0; bj < 2; ++bj) { f32x4 v0 = acc[ai][bj][m][0], v1 = acc[ai][bj][m][1];
                    if (ACT == 1) {
#pragma unroll
                        for (int e = 0; e < 4; ++e) { const float a = fmaxf(v0[e], 0.f), b = fmaxf(v1[e], 0.f); v0[e] = a * a; v1[e] = b * b; } }
                    *(u32x4*)(rowp + bj * HALF) = pack8(v0, v1); } }
    }
};
struct EpiProj {
    static constexpr bool PERM = true;
    bf16_t* P; bf16_t* Assm;
    __device__ __forceinline__ void operator()(AccRef acc, const Unit& u, int wr, int wc, int fr, int fq) const {
        const int row0 = u.pm * BM + wr * 64 + fr, col0 = u.pn * BM + wc * 32 + 8 * fq;
        if (u.pn >= 12 && u.pn < 15) {
#pragma unroll
            for (int ai = 0; ai < 2; ++ai)
#pragma unroll
                for (int m = 0; m < 4; ++m) { const int r = row0 + ai * HALF + m * 16;
#pragma unroll
                    for (int bj = 0; bj < 2; ++bj) { const int c = col0 + bj * HALF - C_SU, gq = c >> 4, p0 = c & 15;
                        bf16_t* dst = Assm + ((size_t)(gq * SGR + (r >> 5)) * 768 + (r & 31) * 16 + p0);
                        *(u32x4*)dst = pack8(acc[ai][bj][m][0], acc[ai][bj][m][1]); } }
        } else {
            const bool sg = u.pn >= 21;
#pragma unroll
            for (int ai = 0; ai < 2; ++ai)
#pragma unroll
                for (int m = 0; m < 4; ++m) { bf16_t* rowp = P + (size_t)(row0 + ai * HALF + m * 16) * NIN + col0;
#pragma unroll
                    for (int bj = 0; bj < 2; ++bj) { f32x4 v0 = acc[ai][bj][m][0], v1 = acc[ai][bj][m][1];
                        if (sg) {
#pragma unroll
                            for (int e = 0; e < 4; ++e) { v0[e] = sigmoidf_(v0[e]); v1[e] = sigmoidf_(v1[e]); } }
                        *(u32x4*)(rowp + bj * HALF) = pack8(v0, v1); } }
        }
    }
};
struct EpiState {
    static constexpr bool PERM = false;
    float* S;
    __device__ __forceinline__ void operator()(AccRef acc, const Unit& u, int wr, int wc, int fr, int fq) const {
        const int row0 = u.pm * BM + wr * 64 + fr, col0 = wc * 32 + 4 * fq;
#pragma unroll
        for (int ai = 0; ai < 2; ++ai)
#pragma unroll
            for (int m = 0; m < 4; ++m) { float* rowp = S + (size_t)(row0 + ai * HALF + m * 16) * 256 + col0;
#pragma unroll
                for (int bj = 0; bj < 2; ++bj)
#pragma unroll
                    for (int n = 0; n < 2; ++n) *(f32x4*)(rowp + bj * HALF + n * 16) = acc[ai][bj][m][n]; }
    }
};
struct EpiSsmY {
    static constexpr bool PERM = true;
    bf16_t* P;
    __device__ __forceinline__ void operator()(AccRef acc, const Unit& u, int wr, int wc, int fr, int fq) const {
        const int gq = u.pm / 5, rl0 = (u.pm % 5) * BM + wr * 64 + fr, cl0 = (u.pn & 1) * BM + wc * 32 + 8 * fq;
#pragma unroll
        for (int ai = 0; ai < 2; ++ai)
#pragma unroll
            for (int m = 0; m < 4; ++m) { const int rl = rl0 + ai * HALF + m * 16;
                if (rl < SGV) {
#pragma unroll
                    for (int bj = 0; bj < 2; ++bj) { const int cl = cl0 + bj * HALF, t = cl >> 4, p0 = cl & 15;
                        f32x4 v0 = acc[ai][bj][m][0], v1 = acc[ai][bj][m][1];
#pragma unroll
                        for (int e = 0; e < 4; ++e) { v0[e] = gelu_tanh(v0[e]); v1[e] = gelu_tanh(v1[e]); }
                        *(u32x4*)(P + (size_t)(rl * 32 + t) * NIN + C_Y + gq * 16 + p0) = pack8(v0, v1); } } }
    }
};
template <bool ACCUM> struct EpiMerge {
    static constexpr bool PERM = true;
    bf16_t* Mg; const bf16_t* P; int gcol;
    __device__ __forceinline__ void operator()(AccRef acc, const Unit& u, int wr, int wc, int fr, int fq) const {
        const int row0 = u.pm * BM + wr * 64 + fr, col0 = u.pn * BM + wc * 32 + 8 * fq;
#pragma unroll
        for (int ai = 0; ai < 2; ++ai)
#pragma unroll
            for (int m = 0; m < 4; ++m) { const size_t r = (size_t)(row0 + ai * HALF + m * 16);
#pragma unroll
                for (int bj = 0; bj < 2; ++bj) { const int c = col0 + bj * HALF;
                    f32x4 g0, g1; unpack8(*(const u32x4*)(P + r * NIN + gcol + c), g0, g1);
                    f32x4 v0 = acc[ai][bj][m][0] * g0, v1 = acc[ai][bj][m][1] * g1;
                    if (ACCUM) { f32x4 o0, o1; unpack8(*(const u32x4*)(Mg + r * D + c), o0, o1); v0 += o0; v1 += o1; }
                    *(u32x4*)(Mg + r * D + c) = pack8(v0, v1); } }
    }
};
struct EpiGlu {
    static constexpr bool PERM = true;
    bf16_t* Mg; const bf16_t* P;
    __device__ __forceinline__ void operator()(AccRef acc, const Unit& u, int wr, int wc, int fr, int fq) const {
        const int row0 = u.pm * BM + wr * 64 + fr, c = u.pn * HALF + wc * 32 + 8 * fq;
#pragma unroll
        for (int ai = 0; ai < 2; ++ai)
#pragma unroll
            for (int m = 0; m < 4; ++m) { const size_t r = (size_t)(row0 + ai * HALF + m * 16);
                f32x4 g0, g1; unpack8(*(const u32x4*)(P + r * NIN + C_GS + c), g0, g1);
                f32x4 o0, o1; unpack8(*(const u32x4*)(Mg + r * D + c), o0, o1);
                f32x4 a0 = acc[ai][0][m][0], a1 = acc[ai][0][m][1]; const f32x4 s0 = acc[ai][1][m][0], s1 = acc[ai][1][m][1];
#pragma unroll
                for (int e = 0; e < 4; ++e) { a0[e] = o0[e] + g0[e] * a0[e] * sigmoidf_(s0[e]); a1[e] = o1[e] + g1[e] * a1[e] * sigmoidf_(s1[e]); }
                *(u32x4*)(Mg + r * D + c) = pack8(a0, a1); }
    }
};
}

namespace attn {
constexpr int DH = 128, NW = 8, QBLK = 32, KVBLK = 64;
constexpr float SCALE = 0.088388347648318440f;
constexpr float THR = 8.f;
constexpr size_t SHM_V = KVBLK * DH * 2, SHM_K = KVBLK * DH * 2, SHM_ATTN = 2 * SHM_V + 2 * SHM_K + NW * 64 * 4;
#define KSWZ(row, colB) ((row) * 256 + ((colB) ^ (((row) & 7) << 4)))
#define SBAR() __builtin_amdgcn_sched_barrier(0)
__device__ __forceinline__ int crow(int r, int hi) { return (r & 3) + 8 * (r >> 2) + 4 * hi; }
__device__ __forceinline__ void partialSM(f32x16& p0, f32x16& p1, float& m_reg, float& mn, float& alpha) {
  constexpr float C = SCALE * 1.4426950408889634f;
  float pmax = p0[0];
#pragma unroll
  for (int r = 1; r < 16; ++r) pmax = fmaxf(pmax, p0[r]);
#pragma unroll
  for (int r = 0; r < 16; ++r) pmax = fmaxf(pmax, p1[r]);
  { auto rr = __builtin_amdgcn_permlane32_swap(__float_as_uint(pmax), __float_as_uint(pmax), false, false);
    pmax = fmaxf(__uint_as_float(rr[0]), __uint_as_float(rr[1])); }
  if (__builtin_expect(__all(pmax - m_reg <= THR / SCALE), 1)) { mn = m_reg; alpha = 1.f; }
  else { mn = fmaxf(m_reg, pmax); alpha = __builtin_amdgcn_exp2f((m_reg - mn) * C); m_reg = mn; }
  float mnC = -mn * C;
#pragma unroll
  for (int r = 0; r < 16; ++r) p0[r] = fmaf(p0[r], C, mnC);
#pragma unroll
  for (int r = 0; r < 16; ++r) p1[r] = fmaf(p1[r], C, mnC);
#pragma unroll
  for (int r = 0; r < 16; ++r) p0[r] = __builtin_amdgcn_exp2f(p0[r]);
}
__device__ __forceinline__ void finishSM(f32x16& p0, f32x16& p1, float alpha, float& l_reg, bf16x8& pa0, bf16x8& pa1, bf16x8& pa2, bf16x8& pa3) {
#pragma unroll
  for (int r = 0; r < 16; ++r) p1[r] = __builtin_amdgcn_exp2f(p1[r]);
  float ps = 0;
#pragma unroll
  for (int r = 0; r < 16; ++r) ps += p0[r];
#pragma unroll
  for (int r = 0; r < 16; ++r) ps += p1[r];
  { auto rr = __builtin_amdgcn_permlane32_swap(__float_as_uint(ps), __float_as_uint(ps), false, false);
    ps = __uint_as_float(rr[0]) + __uint_as_float(rr[1]); }
  l_reg = l_reg * alpha + ps;
#define PK4(P, BASE, OUT) do { unsigned a0 = cvt_pk_bf16(P[BASE + 0], P[BASE + 1]), a1 = cvt_pk_bf16(P[BASE + 2], P[BASE + 3]);   \
    unsigned b0 = cvt_pk_bf16(P[BASE + 4], P[BASE + 5]), b1 = cvt_pk_bf16(P[BASE + 6], P[BASE + 7]);                              \
    auto r0 = __builtin_amdgcn_permlane32_swap(a0, b0, false, false); auto r1 = __builtin_amdgcn_permlane32_swap(a1, b1, false, false); \
    u32x4 w = {r0[0], r1[0], r0[1], r1[1]}; OUT = *reinterpret_cast<bf16x8*>(&w); } while (0)
  PK4(p0, 0, pa0); PK4(p0, 8, pa1); PK4(p1, 0, pa2); PK4(p1, 8, pa3);
#undef PK4
}
__device__ __forceinline__ void qkt(f32x16& p0, f32x16& p1, const char* Ks, const bf16x8* qr, int r32, int hi) {
  p0 = f32x16{}; p1 = f32x16{};
#pragma unroll
  for (int d0 = 0; d0 < 8; ++d0) { int cb = (d0 * 16 + hi * 8) * 2;
    bf16x8 b0 = *reinterpret_cast<const bf16x8*>(Ks + KSWZ(r32, cb));
    bf16x8 b1 = *reinterpret_cast<const bf16x8*>(Ks + KSWZ(32 + r32, cb));
    p0 = __builtin_amdgcn_mfma_f32_32x32x16_bf16(b0, qr[d0], p0, 0, 0, 0);
    p1 = __builtin_amdgcn_mfma_f32_32x32x16_bf16(b1, qr[d0], p1, 0, 0, 0); }
}
__device__ __forceinline__ int v_st(int k, int c) { const int kk = (k & ~0xC) | ((k & 4) << 1) | ((k & 8) >> 1); return ((kk >> 3) * 4 + (c >> 5)) * 512 + ((kk & 7) * 32 + (c & 31)) * 2; }
__device__ __forceinline__ int v_rd_base(int lane) { return ((lane & 3) << 3) | (((lane >> 2) & 3) << 6) | (((lane >> 4) & 1) << 5) | (((lane >> 5) & 1) << 8); }
constexpr int v_rd_off(int d0, int ks, int half) { return d0 * 512 + ks * 4096 + half * 2048; }
template <int OFF> __device__ __forceinline__ s16x4 tr_read(int vb) {
  s16x4 r; asm volatile("ds_read_b64_tr_b16 %0, %1 offset:%2" : "=&v"(r) : "v"(vb), "i"(OFF) : "memory"); return r;
}
template <int D0> __device__ __forceinline__ void pv_one(f32x16& od, int vb, bf16x8 pa0, bf16x8 pa1, bf16x8 pa2, bf16x8 pa3) {
  const s16x4 l0 = tr_read<v_rd_off(D0, 0, 0)>(vb), h0 = tr_read<v_rd_off(D0, 0, 1)>(vb), l1 = tr_read<v_rd_off(D0, 1, 0)>(vb), h1 = tr_read<v_rd_off(D0, 1, 1)>(vb);
  const s16x4 l2 = tr_read<v_rd_off(D0, 2, 0)>(vb), h2 = tr_read<v_rd_off(D0, 2, 1)>(vb), l3 = tr_read<v_rd_off(D0, 3, 0)>(vb), h3 = tr_read<v_rd_off(D0, 3, 1)>(vb);
  asm volatile("s_waitcnt lgkmcnt(0)" ::: "memory"); SBAR();
#define PK(L, H) (bf16x8){L[0], L[1], L[2], L[3], H[0], H[1], H[2], H[3]}
  od = __builtin_amdgcn_mfma_f32_32x32x16_bf16(pa0, PK(l0, h0), od, 0, 0, 0);
  od = __builtin_amdgcn_mfma_f32_32x32x16_bf16(pa1, PK(l1, h1), od, 0, 0, 0);
  od = __builtin_amdgcn_mfma_f32_32x32x16_bf16(pa2, PK(l2, h2), od, 0, 0, 0);
  od = __builtin_amdgcn_mfma_f32_32x32x16_bf16(pa3, PK(l3, h3), od, 0, 0, 0);
#undef PK
}
__device__ __forceinline__ void pv_d0(f32x16* o, int vb, bf16x8 pa0, bf16x8 pa1, bf16x8 pa2, bf16x8 pa3) {
  pv_one<0>(o[0], vb, pa0, pa1, pa2, pa3); pv_one<1>(o[1], vb, pa0, pa1, pa2, pa3); pv_one<2>(o[2], vb, pa0, pa1, pa2, pa3); pv_one<3>(o[3], vb, pa0, pa1, pa2, pa3);
}
__device__ __forceinline__ void attn_unit(const bf16_t* __restrict__ Qb, const bf16_t* __restrict__ Kc, const bf16_t* __restrict__ Kl, bf16_t* __restrict__ Ob, int nkc, int seq, char* lds) {
  int tid_ = threadIdx.x; asm volatile("" : "+v"(tid_));
  const int tid = tid_, wid = tid >> 6, lane = tid & 63, r32 = lane & 31, hi = lane >> 5;
  char* V_lds = lds; char* K_lds = lds + 2 * SHM_V;
  float* ws = (float*)(lds + 2 * SHM_V + 2 * SHM_K) + wid * 64; float* li_l = ws; float* al_l = ws + 32;
  float m_reg = -1e30f, l_reg = 0; f32x16 o[4] = {}; bf16x8 qr[8];
  const bf16_t* Qw = Qb + (long)(wid * QBLK + r32) * NIN + hi * 8;
#pragma unroll
  for (int d0 = 0; d0 < 8; ++d0) qr[d0] = *reinterpret_cast<const bf16x8*>(Qw + d0 * 16);
  const int sr = tid >> 4, sc = (tid & 15) * 8, vst0 = v_st(sr, sc), vst1 = v_st(32 + sr, sc);
  const int vb0 = (int)(uintptr_t)V_lds + v_rd_base(lane);
  struct { bf16x8 vs0, vs1, ks0, ks1; } sr_[2];
#define KROWP(k0) (((k0) < nkc) ? (Kc + (long)(k0) * NIN) : (Kl + (long)((k0) - nkc) * NIN))
#define SLOAD(i, k0) do { const bf16_t* kb_ = KROWP(k0) + (long)sr * NIN + sc; \
    sr_[i].vs0 = *reinterpret_cast<const bf16x8*>(kb_ + 256); sr_[i].vs1 = *reinterpret_cast<const bf16x8*>(kb_ + 32L * NIN + 256); \
    sr_[i].ks0 = *reinterpret_cast<const bf16x8*>(kb_); sr_[i].ks1 = *reinterpret_cast<const bf16x8*>(kb_ + 32L * NIN); } while (0)
#define SWRITE(b, i) do { *(bf16x8*)(V_lds + (b) * SHM_V + vst0) = sr_[i].vs0;          \
    *(bf16x8*)(V_lds + (b) * SHM_V + vst1) = sr_[i].vs1; int kc = sc * 2;               \
    *(bf16x8*)(K_lds + (b) * SHM_K + KSWZ(sr, kc)) = sr_[i].ks0;                       \
    *(bf16x8*)(K_lds + (b) * SHM_K + KSWZ(32 + sr, kc)) = sr_[i].ks1; } while (0)
#define SWAIT() asm volatile("s_waitcnt vmcnt(4)" ::: "memory")
#define RESC(a) do { if (__any((a) < 1.f)) { if (hi == 0) al_l[r32] = (a); asm volatile("s_waitcnt lgkmcnt(0)" ::: "memory"); \
    _Pragma("unroll") for (int d = 0; d < 4; ++d) _Pragma("unroll") for (int r = 0; r < 16; ++r) o[d][r] *= al_l[crow(r, hi)]; } } while (0)
  f32x16 pA0, pA1, pB0, pB1; float mnA, mnB, alA, alB; bf16x8 pa0, pa1, pa2, pa3; const int NT = seq / KVBLK;
  constexpr int SE = 0, SO = 1;
  SLOAD(SE, 0); asm volatile("s_waitcnt vmcnt(0)" ::: "memory"); SWRITE(0, SE); __syncthreads();
  qkt(pA0, pA1, K_lds, qr, r32, hi); partialSM(pA0, pA1, m_reg, mnA, alA);
  SLOAD(SO, KVBLK); if (2 < NT) SLOAD(SE, 2 * KVBLK);
  SWAIT(); SWRITE(1, SO); __syncthreads();
  for (int j = 1; j + 1 < NT; j += 2) {
    SBAR(); qkt(pB0, pB1, K_lds + SHM_K, qr, r32, hi);
    finishSM(pA0, pA1, alA, l_reg, pa0, pa1, pa2, pa3); SBAR();
    SLOAD(SO, (j + 2) * KVBLK); SBAR();
    pv_d0(o, vb0, pa0, pa1, pa2, pa3); partialSM(pB0, pB1, m_reg, mnB, alB);
    __syncthreads(); SWAIT(); SWRITE(0, SE);
    RESC(alB); __syncthreads();
    SBAR(); qkt(pA0, pA1, K_lds, qr, r32, hi);
    finishSM(pB0, pB1, alB, l_reg, pa0, pa1, pa2, pa3); SBAR();
    if (j + 3 < NT) SLOAD(SE, (j + 3) * KVBLK); SBAR();
    pv_d0(o, vb0 + (int)SHM_V, pa0, pa1, pa2, pa3); partialSM(pA0, pA1, m_reg, mnA, alA);
    __syncthreads(); SWAIT(); SWRITE(1, SO);
    RESC(alA); __syncthreads();
  }
  SBAR(); qkt(pB0, pB1, K_lds + SHM_K, qr, r32, hi);
  finishSM(pA0, pA1, alA, l_reg, pa0, pa1, pa2, pa3); SBAR();
  pv_d0(o, vb0, pa0, pa1, pa2, pa3); partialSM(pB0, pB1, m_reg, mnB, alB);
  __syncthreads(); RESC(alB);
  finishSM(pB0, pB1, alB, l_reg, pa0, pa1, pa2, pa3); SBAR();
  pv_d0(o, vb0 + (int)SHM_V, pa0, pa1, pa2, pa3);
  if (hi == 0) li_l[r32] = l_reg; asm volatile("s_waitcnt lgkmcnt(0)" ::: "memory");
  float rli[16];
#pragma unroll
  for (int r = 0; r < 16; ++r) rli[r] = __builtin_amdgcn_rcpf(li_l[crow(r, hi)]);
  bf16_t* Ow = Ob + (long)(wid * QBLK) * NIN;
#pragma unroll
  for (int r = 0; r < 16; ++r) { int orow = crow(r, hi);
#pragma unroll
    for (int d0 = 0; d0 < 4; ++d0) Ow[(long)orow * NIN + d0 * 32 + r32] = (bf16_t)(cvt_pk_bf16(o[d0][r] * rli[r], 0.f) & 0xffffu); }
  __syncthreads();
#undef KROWP
#undef SLOAD
#undef SWRITE
#undef SWAIT
#undef RESC
}
}

struct Args { const float* in[28]; float* out; unsigned char* ws; int lo, hi; };
enum { I_X = 0, I_C, I_CTX, I_CCTX, I_WMOD, I_BMOD, I_GPREMIX, I_GPOSTMIX, I_GPREMLP, I_GPOSTMLP, I_WIN, I_CONVW, I_WCO, I_LRE, I_LIM, I_LDT, I_BRE, I_BIM, I_CRE, I_CIM, I_SD, I_WGLU, I_QG, I_KG, I_WAO, I_WOUT, I_WUP, I_WDN };

__device__ __forceinline__ void transpose_block(const float* W, int K, int N, int k0, int n0, bf16_t* dst, LAS float* scr, int lane) {
#pragma unroll 8
    for (int i = 0; i < 32; ++i) { const int kk = 2 * i + (lane >> 5); scr[kk * 33 + (lane & 31)] = W[(size_t)(k0 + kk) * N + n0 + (lane & 31)]; }
    LDS_WAIT(); asm volatile("" ::: "memory");
    const int c = lane & 7;
#pragma unroll
    for (int j = 0; j < 4; ++j) { const int n = (lane >> 3) + 8 * j; const LAS float* s = scr + (8 * c) * 33 + n;
        u32x4 o; o.x = cvt_pk_bf16(s[0 * 33], s[1 * 33]); o.y = cvt_pk_bf16(s[2 * 33], s[3 * 33]); o.z = cvt_pk_bf16(s[4 * 33], s[5 * 33]); o.w = cvt_pk_bf16(s[6 * 33], s[7 * 33]);
        *(u32x4*)(dst + (size_t)n * K + k0 + 8 * c) = o; }
    LDS_WAIT(); asm volatile("" ::: "memory");
}
__device__ __forceinline__ void convert_weights(const Args& a, int l, LAS unsigned char* lds, int gw, int NGW, int wave, int lane) {
    LAS float* scr = (LAS float*)(lds + wave * 16384);
    unsigned char* ws = a.ws;
    constexpr int I_IN = (D / 64) * (NIN / 32), I_CO = (1024 / 64) * (D / 32), I_GLU = (768 / 64) * (4096 / 32), I_AO = I_CO, I_OUT = (D / 64) * (D / 32), I_UP = (D / 64) * (FF / 32), I_DN = (FF / 64) * (D / 32);
    constexpr int NITEMS = I_IN + I_CO + I_GLU + I_AO + I_OUT + I_UP + I_DN;
    for (int it = gw; it < NITEMS; it += NGW) {
        int r = it;
        if (r < I_IN) { const int nb = r % (NIN / 32), kb = r / (NIN / 32); transpose_block(a.in[I_WIN] + (size_t)l * D * NIN, D, NIN, 64 * kb, 32 * nb, (bf16_t*)(ws + WS_WIN) + (size_t)(32 * nb) * D, scr, lane); continue; } r -= I_IN;
        if (r < I_CO) { const int nb = r % (D / 32), kb = r / (D / 32); transpose_block(a.in[I_WCO] + (size_t)l * 1024 * D, 1024, D, 64 * kb, 32 * nb, (bf16_t*)(ws + WS_WCO) + (size_t)(32 * nb) * 1024, scr, lane); continue; } r -= I_CO;
        if (r < I_GLU) { const int nb = r % 128, kb = r / 128; const int nq = nb & 63, drow = 256 * (nq >> 2) + 32 * (nq & 3) + (nb >= 64 ? 128 : 0);
            transpose_block(a.in[I_WGLU] + (size_t)l * 768 * 4096, 768, 4096, 64 * kb, 32 * nb, (bf16_t*)(ws + WS_WGLU) + (size_t)drow * 768, scr, lane); continue; } r -= I_GLU;
        if (r < I_AO) { const int nb = r % (D / 32), kb = r / (D / 32); transpose_block(a.in[I_WAO] + (size_t)l * 1024 * D, 1024, D, 64 * kb, 32 * nb, (bf16_t*)(ws + WS_WAO) + (size_t)(32 * nb) * 1024, scr, lane); continue; } r -= I_AO;
        if (r < I_OUT) { const int nb = r % (D / 32), kb = r / (D / 32); transpose_block(a.in[I_WOUT] + (size_t)l * D * D, D, D, 64 * kb, 32 * nb, (bf16_t*)(ws + WS_WOUT) + (size_t)(32 * nb) * D, scr, lane); continue; } r -= I_OUT;
        if (r < I_UP) { const int nb = r % (FF / 32), kb = r / (FF / 32); transpose_block(a.in[I_WUP] + (size_t)l * D * FF, D, FF, 64 * kb, 32 * nb, (bf16_t*)(ws + WS_WUP) + (size_t)(32 * nb) * D, scr, lane); continue; } r -= I_UP;
        { const int nb = r % (D / 32), kb = r / (D / 32); transpose_block(a.in[I_WDN] + (size_t)l * FF * D, FF, D, 64 * kb, 32 * nb, (bf16_t*)(ws + WS_WDN) + (size_t)(32 * nb) * FF, scr, lane); }
    }
}

__device__ __forceinline__ void mod_gemv(const Args& a, LAS unsigned char* lds, int bid, int G, int tid, int wave, int lane) {
    LAS float* SV = (LAS float*)lds;
    LAS float* RED = (LAS float*)(lds + 40960);
    float* MOD = (float*)(a.ws + WS_MOD);
    if (bid >= 384) return;
    for (int i = tid; i < 5 * D; i += 512) { const int j = i / D, k = i % D; const float v = j < 4 ? a.in[I_C][j * D + k] : a.in[I_CCTX][k]; SV[i] = v * sigmoidf_(v); }
    __syncthreads();
    for (int it = bid; it < 384; it += G) {
        const int l = it / 96, n0 = (it % 96) * 128;
        const float* W = a.in[I_WMOD] + (size_t)l * D * NMOD + n0 + 2 * lane;
        float acc[5][2];
#pragma unroll
        for (int j = 0; j < 5; ++j) { acc[j][0] = 0.f; acc[j][1] = 0.f; }
        const int kb = wave * 256;
#pragma unroll 8
        for (int k = 0; k < 256; ++k) { const f32x2 w = *(const f32x2*)(W + (size_t)(kb + k) * NMOD);
#pragma unroll
            for (int j = 0; j < 5; ++j) { const float s = SV[j * D + kb + k]; acc[j][0] += s * w.x; acc[j][1] += s * w.y; } }
#pragma unroll
        for (int j = 0; j < 5; ++j) { RED[(wave * 5 + j) * 128 + 2 * lane] = acc[j][0]; RED[(wave * 5 + j) * 128 + 2 * lane + 1] = acc[j][1]; }
        __syncthreads();
        for (int i = tid; i < 640; i += 512) { const int j = i >> 7, cn = i & 127; float s = 0.f;
#pragma unroll
            for (int w = 0; w < 8; ++w) s += RED[(w * 5 + j) * 128 + cn];
            MOD[((size_t)l * 5 + j) * NMOD + n0 + cn] = s + a.in[I_BMOD][l * NMOD + n0 + cn]; }
        __syncthreads();
    }
}

__device__ __forceinline__ void ssm_tables_t1(const Args& a, int gtid, int NT) {
    float* ETAB = (float*)(a.ws + WS_ETAB); float* BBT = (float*)(a.ws + WS_BB);
    for (int idx = gtid; idx < DEPTH * 2 * SG * 64; idx += NT) {
        const int n = idx & 63, gq = (idx >> 6) % SG, dir = (idx / (64 * SG)) & 1, l = idx / (64 * SG * 2);
        const double lr = fmin((double)a.in[I_LRE][idx], -1e-4), li = (double)a.in[I_LIM][idx], dt = exp((double)a.in[I_LDT][(l * 2 + dir) * SG + gq]);
        const double mag = exp(lr * dt), th = li * dt; double sn, cs; sincos(th, &sn, &cs);
        const double ab_re = mag * cs, ab_im = mag * sn, nr = ab_re - 1.0, den = lr * lr + li * li;
        const double f_re = (nr * lr + ab_im * li) / den, f_im = (ab_im * lr - nr * li) / den;
        const size_t o = (((size_t)(l * SG + gq) * 2 + dir) * 64 + n);
        float* e = ETAB + o * 66;
        for (int k = 0; k <= 32; ++k) { double s2, c2; sincos(th * k, &s2, &c2); const double mg = exp(lr * dt * k); e[2 * k] = (float)(mg * c2); e[2 * k + 1] = (float)(mg * s2); }
        float* bb = BBT + o * 32;
        for (int q = 0; q < 16; ++q) { const double br = (double)a.in[I_BRE][(size_t)idx * 16 + q], bi = (double)a.in[I_BIM][(size_t)idx * 16 + q];
            bb[2 * q] = (float)(f_re * br - f_im * bi); bb[2 * q + 1] = (float)(f_re * bi + f_im * br); }
    }
}
__device__ __forceinline__ void ssm_tables_t2(const Args& a, LAS unsigned char* lds, int bid, int G, int tid) {
    LAS float* Cs = (LAS float*)lds;
    LAS float* Es = (LAS float*)(lds + 16 * 65 * 8);
    LAS float* Bs = Es + 64 * 32 * 2;
    const float* ETAB = (const float*)(a.ws + WS_ETAB); const float* BBT = (const float*)(a.ws + WS_BB); float* MT = (float*)(a.ws + WS_MT);
    for (int it = bid; it < DEPTH * SG * 2; it += G) {
        const int dir = it & 1, gq = (it >> 1) % SG, l = it / (2 * SG);
        const size_t o = ((size_t)(l * SG + gq) * 2 + dir);
        const size_t ci = ((size_t)(l * 2 + dir) * SG + gq) * 1024;
        for (int i = tid; i < 1024; i += 512) { const int p = i >> 6, n = i & 63; Cs[(p * 65 + n) * 2] = a.in[I_CRE][ci + i]; Cs[(p * 65 + n) * 2 + 1] = a.in[I_CIM][ci + i]; }
        for (int i = tid; i < 64 * 32; i += 512) { const int n = i >> 5, lag = i & 31; Es[i * 2] = ETAB[(o * 64 + n) * 66 + 2 * lag]; Es[i * 2 + 1] = ETAB[(o * 64 + n) * 66 + 2 * lag + 1]; }
        for (int i = tid; i < 64 * 32; i += 512) Bs[i] = BBT[o * 64 * 32 + i];
        __syncthreads();
        const int lag = tid >> 4, p = tid & 15;
        float acc[16];
#pragma unroll
        for (int q = 0; q < 16; ++q) acc[q] = 0.f;
        for (int n = 0; n < 64; ++n) {
            const float cr = Cs[(p * 65 + n) * 2], cim = Cs[(p * 65 + n) * 2 + 1], er = Es[(n * 32 + lag) * 2], ei = Es[(n * 32 + lag) * 2 + 1];
            const float gr = cr * er - cim * ei, gi = cr * ei + cim * er;
#pragma unroll
            for (int q = 0; q < 16; ++q) acc[q] += gr * Bs[(n * 16 + q) * 2] - gi * Bs[(n * 16 + q) * 2 + 1];
        }
        float* dst = MT + (o * 32 + lag) * 256 + p * 16;
#pragma unroll
        for (int q = 0; q < 16; q += 4) *(f32x4*)(dst + q) = (f32x4){acc[q], acc[q + 1], acc[q + 2], acc[q + 3]};
        __syncthreads();
    }
}
__device__ __forceinline__ void ssm_fill(const Args& a, int l, LAS unsigned char* lds, int bid, int G, int tid) {
    LAS float* MTs = (LAS float*)lds;
    LAS float* Es = (LAS float*)(lds + 65536);
    LAS float* Cs = (LAS float*)(lds + 65536 + 33792);
    LAS float* Bs = (LAS float*)(lds + 65536 + 33792 + 16384);
    LAS float* Ds = (LAS float*)(lds + 65536 + 33792 + 32768);
    const float* ETAB = (const float*)(a.ws + WS_ETAB); const float* BBT = (const float*)(a.ws + WS_BB); const float* MT = (const float*)(a.ws + WS_MT);
    bf16_t* W1 = (bf16_t*)(a.ws + WS_W1); bf16_t* W3 = (bf16_t*)(a.ws + WS_W3);
    for (int it = bid; it < SG * 4; it += G) {
        const int gq = it >> 2, part = it & 3;
        const size_t o = (size_t)(l * SG + gq) * 2;
        for (int i = tid; i < 2 * 32 * 256; i += 512) MTs[i] = MT[o * 32 * 256 + i];
        for (int i = tid; i < 2 * 64 * 66; i += 512) Es[i] = ETAB[o * 64 * 66 + i];
        for (int i = tid; i < 2 * 64 * 32; i += 512) Bs[i] = BBT[o * 64 * 32 + i];
        for (int i = tid; i < 2 * 1024; i += 512) { const int dir = i >> 10, pn = i & 1023; const size_t ci = ((size_t)(l * 2 + dir) * SG + gq) * 1024 + pn;
            Cs[i * 2] = a.in[I_CRE][ci]; Cs[i * 2 + 1] = a.in[I_CIM][ci]; }
        if (tid < 16) Ds[tid] = a.in[I_SD][l * 768 + gq * 16 + tid];
        __syncthreads();
        for (int ch = tid; ch < 128 * 96; ch += 512) {
            const int ncol = part * 128 + ch / 96, kc = ch % 96, t = ncol >> 4, p = ncol & 15;
            float v[8];
            if (kc < 64) { const int s = kc >> 1, q0 = (kc & 1) * 8;
#pragma unroll
                for (int i = 0; i < 8; ++i) { const int q = q0 + i; float x = 0.f;
                    if (s <= t) x += MTs[((t - s) * 16 + p) * 16 + q];
                    if (s >= t) x += MTs[8192 + ((s - t) * 16 + p) * 16 + q];
                    if (s == t && p == q) x += Ds[p];
                    v[i] = x; }
            } else { const int dir = (kc - 64) >> 4, kk0 = ((kc - 64) & 15) * 8, e = dir == 0 ? t + 1 : 32 - t;
#pragma unroll
                for (int i = 0; i < 8; ++i) { const int kk = kk0 + i, prt = kk >> 6, n = kk & 63;
                    const float cr = Cs[((dir * 16 + p) * 64 + n) * 2], cim = Cs[((dir * 16 + p) * 64 + n) * 2 + 1], er = Es[((dir * 64 + n) * 33 + e) * 2], ei = Es[((dir * 64 + n) * 33 + e) * 2 + 1];
                    v[i] = prt == 0 ? (cr * er - cim * ei) : -(cr * ei + cim * er); }
            }
            u32x4 w; w.x = cvt_pk_bf16(v[0], v[1]); w.y = cvt_pk_bf16(v[2], v[3]); w.z = cvt_pk_bf16(v[4], v[5]); w.w = cvt_pk_bf16(v[6], v[7]);
            *(u32x4*)(W3 + ((size_t)(gq * 512 + ncol) * 768 + kc * 8)) = w;
        }
        for (int ch = tid; ch < 64 * 64; ch += 512) {
            const int ncol = part * 64 + (ch >> 6), kc = ch & 63, dir = ncol >> 7, prt = (ncol >> 6) & 1, n = ncol & 63, s = kc >> 1, q0 = (kc & 1) * 8, e = dir == 0 ? 31 - s : s;
            const float er = Es[((dir * 64 + n) * 33 + e) * 2], ei = Es[((dir * 64 + n) * 33 + e) * 2 + 1];
            float v[8];
#pragma unroll
            for (int i = 0; i < 8; ++i) { const float br = Bs[((dir * 64 + n) * 16 + q0 + i) * 2], bi = Bs[((dir * 64 + n) * 16 + q0 + i) * 2 + 1];
                v[i] = prt == 0 ? (er * br - ei * bi) : (er * bi + ei * br); }
            u32x4 w; w.x = cvt_pk_bf16(v[0], v[1]); w.y = cvt_pk_bf16(v[2], v[3]); w.z = cvt_pk_bf16(v[4], v[5]); w.w = cvt_pk_bf16(v[6], v[7]);
            *(u32x4*)(W1 + ((size_t)(gq * 256 + ncol) * 512 + kc * 8)) = w;
        }
        __syncthreads();
    }
}

template <int MODE>
__device__ __forceinline__ void row_pass(LAS unsigned char* lds, int bid, int G, int tid, int wave, int lane,
                                         const float* xin, float* xout, const float* cin, float* cout, const bf16_t* Y, bf16_t* XN,
                                         const float* gpost, const float* gpre, const float* modg  , int gate_off,
                                         const float* modn  , int shift_off, int scale_off) {
    LAS float* V = (LAS float*)lds;
    int cur = -1;
    const int nblk = (MODE == 2 ? ML : M) / 16;
    for (int blk = bid; blk < nblk; blk += G) {
        const int row0 = blk * 16, jb = row0 < ML ? row0 / SEQ : 4;
        if (jb != cur) {
            __syncthreads();
            for (int i = tid; i < D; i += 512) {
                if (cur < 0) { if (MODE != 0) V[i] = gpost[i]; if (MODE != 2) V[D + i] = gpre[i]; }
                if (MODE != 0) V[2 * D + i] = modg[(size_t)jb * NMOD + gate_off + i];
                if (MODE != 2) { V[3 * D + i] = modn[(size_t)jb * NMOD + shift_off + i]; V[4 * D + i] = 1.0f + modn[(size_t)jb * NMOD + scale_off + i]; }
            }
            cur = jb;
            __syncthreads();
        }
#pragma unroll 1
        for (int rr = 0; rr < 2; ++rr) {
            const int row = row0 + wave * 2 + rr;
            const float* xs = row < ML ? xin + (size_t)row * D : cin + (size_t)(row - ML) * D;
            float* xd = row < ML ? xout + (size_t)row * D : cout + (size_t)(row - ML) * D;
            f32x4 x[8];
#pragma unroll
            for (int j = 0; j < 8; ++j) x[j] = *(const f32x4*)(xs + 4 * lane + 256 * j);
            if (MODE != 0) {
                f32x4 y[8]; float ss = 0.f;
#pragma unroll
                for (int j = 0; j < 8; ++j) { const u32x2 w = *(const u32x2*)(Y + (size_t)row * D + 4 * lane + 256 * j);
                    y[j] = (f32x4){bf_lo(w.x), bf_hi(w.x), bf_lo(w.y), bf_hi(w.y)}; ss += (y[j].x * y[j].x + y[j].y * y[j].y) + (y[j].z * y[j].z + y[j].w * y[j].w); }
                const float rstd = rsqrtf(wave_sum(ss) * (1.f / D) + NORM_EPS);
#pragma unroll
                for (int j = 0; j < 8; ++j) { const f32x4 gp = *(const LAS f32x4*)(V + 4 * lane + 256 * j), gt = *(const LAS f32x4*)(V + 2 * D + 4 * lane + 256 * j);
                    x[j] = x[j] + gt * (y[j] * rstd * gp);
                    *(f32x4*)(xd + 4 * lane + 256 * j) = x[j]; }
            }
            if (MODE != 2) {
                float ss = 0.f;
#pragma unroll
                for (int j = 0; j < 8; ++j) ss += (x[j].x * x[j].x + x[j].y * x[j].y) + (x[j].z * x[j].z + x[j].w * x[j].w);
                const float rstd = rsqrtf(wave_sum(ss) * (1.f / D) + NORM_EPS);
#pragma unroll
                for (int j = 0; j < 8; ++j) { const f32x4 gp = *(const LAS f32x4*)(V + D + 4 * lane + 256 * j), sh = *(const LAS f32x4*)(V + 3 * D + 4 * lane + 256 * j), sc = *(const LAS f32x4*)(V + 4 * D + 4 * lane + 256 * j);
                    const f32x4 h = sh + sc * (x[j] * rstd * gp);
                    u32x2 w; w.x = cvt_pk_bf16(h.x, h.y); w.y = cvt_pk_bf16(h.z, h.w);
                    *(u32x2*)(XN + (size_t)row * D + 4 * lane + 256 * j) = w; }
            }
        }
    }
    __syncthreads();
}

__device__ __forceinline__ void conv_pass(const Args& a, int l, int bid, int G, int wave, int lane) {
    bf16_t* P = (bf16_t*)(a.ws + WS_P);
    const int c = (wave & 1) * 512 + 8 * lane;
    const float* cw = a.in[I_CONVW] + (size_t)l * 3 * 1024 + c;
    float w0[8], w1[8], w2[8];
#pragma unroll
    for (int i = 0; i < 8; ++i) { w0[i] = cw[i]; w1[i] = cw[1024 + i]; w2[i] = cw[2048 + i]; }
    for (int blk = bid; blk < M / 16; blk += G) {
        const int r0 = blk * 16 + (wave >> 1) * 4;
        const int s0 = r0 < ML ? (r0 / SEQ) * SEQ : ML + ((r0 - ML) / CTXL) * CTXL, s1 = s0 + (r0 < ML ? SEQ : CTXL);
        float u[6][8];
#pragma unroll
        for (int k = 0; k < 6; ++k) { const int r = r0 - 1 + k;
            if (r >= s0 && r < s1) { f32x4 c0, c1, v0, v1; pg8::unpack8(*(const u32x4*)(P + (size_t)r * NIN + C_AC + c), c0, c1); pg8::unpack8(*(const u32x4*)(P + (size_t)r * NIN + C_AV + c), v0, v1);
#pragma unroll
                for (int i = 0; i < 4; ++i) { u[k][i] = c0[i] * v0[i]; u[k][4 + i] = c1[i] * v1[i]; } }
            else {
#pragma unroll
                for (int i = 0; i < 8; ++i) u[k][i] = 0.f; } }
#pragma unroll
        for (int k = 0; k < 4; ++k) { bf16_t* pb = P + (size_t)(r0 + k) * NIN + C_AB + c; f32x4 b0, b1; pg8::unpack8(*(const u32x4*)pb, b0, b1);
#pragma unroll
            for (int i = 0; i < 4; ++i) { b0[i] *= w0[i] * u[k][i] + w1[i] * u[k + 1][i] + w2[i] * u[k + 2][i]; b1[i] *= w0[4 + i] * u[k][4 + i] + w1[4 + i] * u[k + 1][4 + i] + w2[4 + i] * u[k + 2][4 + i]; }
            *(u32x4*)pb = pg8::pack8(b0, b1); }
    }
}
__device__ __forceinline__ void qk_pass(const Args& a, int l, int gw, int NGW, int lane) {
    bf16_t* P = (bf16_t*)(a.ws + WS_P);
    const float* ROPE = (const float*)(a.ws + WS_ROPE);
    const int j = lane & 15, hq = lane >> 4;
    float gq_[8], gk_[8];
#pragma unroll
    for (int i = 0; i < 8; ++i) { gq_[i] = a.in[I_QG][l * 128 + 8 * j + i]; gk_[i] = a.in[I_KG][l * 128 + 8 * j + i]; }
    for (int row = gw; row < M; row += NGW) {
        const bool lat = row < ML; const int t = row % SEQ, pos = (j < 8) ? (t >> 6) : (t & 63);
        float cs[8], sn[8];
        if (lat) {
#pragma unroll
            for (int i = 0; i < 8; ++i) { cs[i] = ROPE[pos * 32 + 8 * (j & 3) + i]; sn[i] = ROPE[4096 + pos * 32 + 8 * (j & 3) + i]; } }
#pragma unroll
        for (int st = 0; st < 3; ++st) {
            const bool act = st < 2 || hq < 2;
            bf16_t* p = P + (size_t)row * NIN + (st < 2 ? C_Q + (st * 4 + hq) * 128 : C_K + (hq & 1) * 128) + 8 * j;
            f32x4 v0 = {0.f, 0.f, 0.f, 0.f}, v1 = {0.f, 0.f, 0.f, 0.f};
            if (act) pg8::unpack8(*(const u32x4*)p, v0, v1);
            float x[8] = {v0[0], v0[1], v0[2], v0[3], v1[0], v1[1], v1[2], v1[3]};
            float ss = 0.f;
#pragma unroll
            for (int i = 0; i < 8; ++i) ss += x[i] * x[i];
            ss += __shfl_xor(ss, 1); ss += __shfl_xor(ss, 2); ss += __shfl_xor(ss, 4); ss += __shfl_xor(ss, 8);
            const float rstd = rsqrtf(ss * (1.f / 128.f) + NORM_EPS);
#pragma unroll
            for (int i = 0; i < 8; ++i) x[i] = x[i] * rstd * (st < 2 ? gq_[i] : gk_[i]);
            if (lat) {
#pragma unroll
                for (int i = 0; i < 8; ++i) { const float pr = __shfl_xor(x[i], 4); x[i] = x[i] * cs[i] + ((j & 4) ? pr : -pr) * sn[i]; } }
            if (act) *(u32x4*)p = pg8::pack8((f32x4){x[0], x[1], x[2], x[3]}, (f32x4){x[4], x[5], x[6], x[7]});
        }
    }
}
__device__ __forceinline__ void ssm_scan(const Args& a, int l, int bid, int G, int wave, int lane) {
    const float* S = (const float*)(a.ws + WS_S); bf16_t* As = (bf16_t*)(a.ws + WS_ASSM); const float* ETAB = (const float*)(a.ws + WS_ETAB);
    for (int ch = bid + G * wave; ch < NBATCH * SG * 2; ch += G * 8) {
        const int dir = ch & 1, gq = (ch >> 1) % SG, b = ch / (2 * SG);
        const float* e = ETAB + ((((size_t)(l * SG + gq) * 2 + dir) * 64 + lane) * 66 + 64);
        const float ar = e[0], ai = e[1];
        float hr = 0.f, hi = 0.f;
        for (int s0 = 0; s0 < 264; s0 += 8) {
            float sr[8], si[8]; int rows[8];
#pragma unroll
            for (int k = 0; k < 8; ++k) { const int s = s0 + k; int row;
                if (s < 8) row = 1024 + 8 * b + (dir == 0 ? s : 7 - s); else row = 256 * b + (dir == 0 ? s - 8 : 263 - s);
                rows[k] = row; const float* sp = S + ((size_t)(gq * SGR + row) * 256 + dir * 128 + lane); sr[k] = sp[0]; si[k] = sp[64]; }
#pragma unroll
            for (int k = 0; k < 8; ++k) { bf16_t* hp = As + ((size_t)(gq * SGR + rows[k]) * 768 + 512 + dir * 128 + lane);
                hp[0] = (bf16_t)(cvt_pk_bf16(hr, 0.f) & 0xffffu); hp[64] = (bf16_t)(cvt_pk_bf16(hi, 0.f) & 0xffffu);
                const float nr = ar * hr - ai * hi + sr[k], ni = ar * hi + ai * hr + si[k]; hr = nr; hi = ni; }
        }
    }
}

typedef const __attribute__((address_space(4))) unsigned long long* KArgP;
__device__ __forceinline__ Args load_args() {
    KArgP p = (KArgP)__builtin_amdgcn_kernarg_segment_ptr(); asm volatile("" : "+s"(p));
    Args r;
#pragma unroll
    for (int i = 0; i < 28; ++i) r.in[i] = (const float*)(const GAS float*)p[i];
    r.out = (float*)(GAS float*)p[28]; r.ws = (unsigned char*)(GAS unsigned char*)p[29]; const unsigned long long lh = p[30]; r.lo = (int)(unsigned)lh; r.hi = (int)(unsigned)(lh >> 32);
    return r;
}
__global__ void __launch_bounds__(512, 2) hybrid_fwd(Args ka) {
    extern __shared__ __attribute__((aligned(16))) unsigned char lds_raw[];
    LAS unsigned char* lds = (LAS unsigned char*)lds_raw;
    volatile LAS unsigned* MISC = (volatile LAS unsigned*)(lds + MISC_OFF);
    const int G = gridDim.x, bid = blockIdx.x;
    if (threadIdx.x < 64) MISC[threadIdx.x] = 0u;
    __syncthreads();
    XcdBarrier bar; bar.bar = (unsigned*)(ka.ws + WS_CTL) + CW_BAR; bar.x = 0; bar.st = nullptr;
    if (ka.hi - ka.lo > 1) bar = xcd_barrier_post((unsigned*)(ka.ws + WS_CTL) + CW_BAR, MISC + 8);
#define PH(k) (ka.lo <= (k) && (k) < ka.hi)
#define SEAM(k) do { if ((k) + 1 < ka.hi) xcd_barrier(bar); } while (0)
#define PHASE_ARGS const Args a = load_args(); unsigned char* const ws = a.ws; (void)ws; \
    int tid_ = threadIdx.x; asm volatile("" : "+v"(tid_)); const int tid = tid_, lane = tid & 63, wave = __builtin_amdgcn_readfirstlane(tid >> 6); \
    const int gw = bid * 8 + wave, NGW = G * 8, gtid = bid * 512 + tid, NTHR = G * 512; (void)lane; (void)gw; (void)NGW; (void)gtid; (void)NTHR; \
    bf16_t* const P = (bf16_t*)(ws + WS_P); bf16_t* const XN = (bf16_t*)(ws + WS_XN); bf16_t* const MX = (bf16_t*)(ws + WS_MX); bf16_t* const UP = (bf16_t*)(ws + WS_UP); \
    bf16_t* const ASSM = (bf16_t*)(ws + WS_ASSM); float* const SST = (float*)(ws + WS_S); float* const CTXR = (float*)(ws + WS_CTXR); float* const MOD = (float*)(ws + WS_MOD); \
    (void)P; (void)XN; (void)MX; (void)UP; (void)ASSM; (void)SST; (void)CTXR; (void)MOD;

    if (PH(0)) { PHASE_ARGS
        float* ROPE = (float*)(ws + WS_ROPE);
        for (int idx = gtid; idx < 4096; idx += NTHR) { const int pos = idx >> 5, i = idx & 31; const double inv = exp(-(double)i * (9.210340371976184 / 32.0)); double s, c; sincos((double)pos * inv, &s, &c); ROPE[idx] = (float)c; ROPE[4096 + idx] = (float)s; }
        ssm_tables_t1(a, gtid, NTHR);
        mod_gemv(a, lds, bid, G, tid, wave, lane);
        __syncthreads();
        convert_weights(a, 0, lds, gw, NGW, wave, lane);
        SEAM(0);
    }
    if (PH(1)) { PHASE_ARGS
        ssm_tables_t2(a, lds, bid, G, tid);
        row_pass<0>(lds, bid, G, tid, wave, lane, a.in[I_X], a.out, a.in[I_CTX], CTXR, MX, XN, a.in[I_GPREMIX], a.in[I_GPREMIX], MOD, 0, MOD, 0, D);
        SEAM(1);
    }
    for (int l = 0; l < DEPTH; ++l) {
        const int pb = 2 + 12 * l;
        if (PH(pb + 0)) { PHASE_ARGS
            ssm_fill(a, l, lds, bid, G, tid);
            pg8::Gemm g{XN, (const bf16_t*)(ws + WS_WIN), D, D, D}; pg8::StaticOrder S; S.init(M, NIN, G, bid);
            pg8::EpiProj E{P, ASSM};
            pg8::gemm_phase(lds, g, S, E);
            SEAM(pb + 0);
        }
        if (PH(pb + 1)) { PHASE_ARGS
            { pg8::Gemm g{ASSM, (const bf16_t*)(ws + WS_W1), 768, 512, 512}; pg8::GroupOrder S; S.init(1, G, bid); pg8::EpiState E{SST}; pg8::gemm_phase(lds, g, S, E); }
            conv_pass(a, l, bid, G, wave, lane);
            qk_pass(a, l, gw, NGW, lane);
            SEAM(pb + 1);
        }
        if (PH(pb + 2)) { PHASE_ARGS ssm_scan(a, l, bid, G, wave, lane); SEAM(pb + 2); }
        if (PH(pb + 3)) { PHASE_ARGS
            { pg8::Gemm g{ASSM, (const bf16_t*)(ws + WS_W3), 768, 768, 768}; pg8::GroupOrder S; S.init(2, G, bid); pg8::EpiSsmY E{P}; pg8::gemm_phase(lds, g, S, E); }
            for (int u = bid; u < 1056; u += G) {
                const bool lat = u < 1024; int b, hq, qb;
                if (lat) { const int xcd = u & 7, idx = (u >> 3) & 31, rnd = u >> 8; b = xcd >> 1; hq = (xcd & 1) * 4 + (idx >> 3); qb = (idx & 7) + 8 * rnd; }
                else { const int c = u - 1024; b = c >> 3; hq = c & 7; qb = 0; }
                const int kvh = hq >> 2;
                const size_t r0 = lat ? (size_t)b * SEQ + (size_t)qb * 256 : (size_t)(ML + b * CTXL);
                const bf16_t* Kc = P + (size_t)(ML + b * CTXL) * NIN + C_K + kvh * 128;
                const bf16_t* Kl = P + (size_t)b * SEQ * NIN + C_K + kvh * 128;
                attn::attn_unit(P + r0 * NIN + C_Q + hq * 128, Kc, Kl, P + r0 * NIN + C_O + hq * 128, CTXL, lat ? CTXL + SEQ : CTXL, (char*)lds_raw);
            }
            SEAM(pb + 3);
        }
        if (PH(pb + 4)) { PHASE_ARGS pg8::Gemm g{P + C_AB, (const bf16_t*)(ws + WS_WCO), NIN, 1024, 1024}; pg8::StaticOrder S; S.init(M, D, G, bid); pg8::EpiMerge<false> E{XN, P, C_GC}; pg8::gemm_phase(lds, g, S, E); SEAM(pb + 4); }
        if (PH(pb + 5)) { PHASE_ARGS pg8::Gemm g{P + C_Y, (const bf16_t*)(ws + WS_WGLU), NIN, 768, 768}; pg8::StaticOrder S; S.init(M, 4096, G, bid); pg8::EpiGlu E{XN, P}; pg8::gemm_phase(lds, g, S, E); SEAM(pb + 5); }
        if (PH(pb + 6)) { PHASE_ARGS pg8::Gemm g{P + C_O, (const bf16_t*)(ws + WS_WAO), NIN, 1024, 1024}; pg8::StaticOrder S; S.init(M, D, G, bid); pg8::EpiMerge<true> E{XN, P, C_GA}; pg8::gemm_phase(lds, g, S, E); SEAM(pb + 6); }
        if (PH(pb + 7)) { PHASE_ARGS pg8::Gemm g{XN, (const bf16_t*)(ws + WS_WOUT), D, D, D}; pg8::StaticOrder S; S.init(M, D, G, bid); pg8::EpiBf16<0> E{MX, D}; pg8::gemm_phase(lds, g, S, E); SEAM(pb + 7); }
        if (PH(pb + 8)) { PHASE_ARGS
            const float* modl = MOD + (size_t)l * 5 * NMOD;
            row_pass<1>(lds, bid, G, tid, wave, lane, l == 0 ? a.in[I_X] : a.out, a.out, l == 0 ? a.in[I_CTX] : CTXR, CTXR, MX, XN, a.in[I_GPOSTMIX] + l * D, a.in[I_GPREMLP] + l * D, modl, 2 * D, modl, 3 * D, 4 * D);
            SEAM(pb + 8);
        }
        if (PH(pb + 9)) { PHASE_ARGS pg8::Gemm g{XN, (const bf16_t*)(ws + WS_WUP), D, D, D}; pg8::StaticOrder S; S.init(M, FF, G, bid); pg8::EpiBf16<1> E{UP, FF}; pg8::gemm_phase(lds, g, S, E); SEAM(pb + 9); }
        if (PH(pb + 10)) { PHASE_ARGS pg8::Gemm g{UP, (const bf16_t*)(ws + WS_WDN), FF, FF, FF}; pg8::StaticOrder S; S.init(M, D, G, bid); pg8::EpiBf16<0> E{MX, D}; pg8::gemm_phase(lds, g, S, E); SEAM(pb + 10); }
        if (PH(pb + 11)) { PHASE_ARGS
            const float* modl = MOD + (size_t)l * 5 * NMOD;
            if (l + 1 < DEPTH) {
                row_pass<1>(lds, bid, G, tid, wave, lane, a.out, a.out, CTXR, CTXR, MX, XN, a.in[I_GPOSTMLP] + l * D, a.in[I_GPREMIX] + (l + 1) * D, modl, 5 * D, modl + 5 * NMOD, 0, D);
                convert_weights(a, l + 1, lds, gw, NGW, wave, lane);
                SEAM(pb + 11);
            } else {
                row_pass<2>(lds, bid, G, tid, wave, lane, a.out, a.out, CTXR, CTXR, MX, XN, a.in[I_GPOSTMLP] + l * D, a.in[I_GPOSTMLP] + l * D, modl, 5 * D, modl, 0, 0);
            }
        }
    }
#undef PH
#undef PHASE_ARGS
#undef SEAM
}

constexpr int N_PHASES = 2 + 12 * DEPTH;
extern "C" void kernel_launch(void* const* d_in, const int* in_sizes, int n_in, void* d_out, int out_size, void* d_ws, size_t ws_size, hipStream_t stream) {
    static int grid = 0;
    if (grid == 0) {
        if (n_in != 28 || in_sizes[0] != ML * D || out_size != ML * D || ws_size < WS_END) { fprintf(stderr, "kernel_launch: shape/workspace mismatch (n_in %d, ws %zu < %zu?)\n", n_in, ws_size, (size_t)WS_END); grid = -1; return; }
        int dev = 0, cus = 0, per_cu = 0;
        if (hipGetDevice(&dev) != hipSuccess || hipDeviceGetAttribute(&cus, hipDeviceAttributeMultiprocessorCount, dev) != hipSuccess) { grid = -1; return; }
        if (hipFuncSetAttribute((const void*)hybrid_fwd, hipFuncAttributeMaxDynamicSharedMemorySize, LDS_BYTES) != hipSuccess) { fprintf(stderr, "kernel_launch: hipFuncSetAttribute failed\n"); grid = -1; return; }
        if (hipOccupancyMaxActiveBlocksPerMultiprocessor(&per_cu, (const void*)hybrid_fwd, 512, LDS_BYTES) != hipSuccess || per_cu < 1) { fprintf(stderr, "kernel_launch: occupancy query says %d blocks per CU\n", per_cu); (void)hipGetLastError(); if (per_cu < 1) { grid = -1; return; } }
        grid = cus;
    }
    if (grid < 0) return;
    if (hipMemsetAsync((char*)d_ws + WS_CTL, 0, CTL_ZERO_BYTES, stream) != hipSuccess) return;
    Args a{};
    for (int i = 0; i < 28; ++i) a.in[i] = (const float*)d_in[i];
    a.out = (float*)d_out; a.ws = (unsigned char*)d_ws;
#if MK_PER_PHASE
    for (int p = 0; p < N_PHASES; ++p) { a.lo = p; a.hi = p + 1; hipLaunchKernelGGL(hybrid_fwd, dim3(grid), dim3(512), LDS_BYTES, stream, a); }
#else
    a.lo = 0; a.hi = N_PHASES;
    hipLaunchKernelGGL(hybrid_fwd, dim3(grid), dim3(512), LDS_BYTES, stream, a);
#endif
    const hipError_t le = hipPeekAtLastError();
    if (le != hipSuccess) fprintf(stderr, "kernel_launch: launch failed: %s\n", hipGetErrorName(le));
}
```

```cpp
#include <hip/hip_runtime.h>
#include <cstdio>
#include <cstdint>
#include <cmath>

#ifndef MK_PER_PHASE
#define MK_PER_PHASE 0
#endif
#ifndef REP_BIG
#define REP_BIG 1
#endif
#ifndef REP_ATT
#define REP_ATT 1
#endif

#define LAS __attribute__((address_space(3)))
#define GAS __attribute__((address_space(1)))
typedef unsigned short bf16_t;
typedef short bf16x8 __attribute__((ext_vector_type(8)));
typedef short s16x4 __attribute__((ext_vector_type(4)));
typedef float f32x2 __attribute__((ext_vector_type(2)));
typedef float f32x4 __attribute__((ext_vector_type(4)));
typedef float f32x16 __attribute__((ext_vector_type(16)));
typedef unsigned u32x2 __attribute__((ext_vector_type(2)));
typedef unsigned u32x4 __attribute__((ext_vector_type(4)));
typedef GAS unsigned gu32;

constexpr int D = 2048, NBATCH = 4, SEQ = 8192, CTXL = 256, DEPTH = 4;
constexpr int ML = NBATCH * SEQ, MC = NBATCH * CTXL, M = ML + MC;
constexpr int NIN = 11520, FF = 8192, NMOD = 6 * D;
constexpr int C_AB = 0, C_AC = 1024, C_AV = 2048, C_SU = 3072, C_Q = 3840, C_K = 4864, C_V = 5120, C_GC = 5376, C_GS = 7424, C_GA = 9472;
constexpr int C_O = C_AC, C_Y = C_SU;
constexpr int SG = 48, SGR = 1280, SGV = 1056;
constexpr float NORM_EPS = 1e-6f;

constexpr size_t MiB = 1u << 20;
constexpr size_t WS_CTL = 0, CTL_ZERO_BYTES = 1 * MiB;
constexpr size_t WS_MOD = 1 * MiB;
constexpr size_t WS_ROPE = 2 * MiB;
constexpr size_t WS_ETAB = 3 * MiB;
constexpr size_t WS_BB = 10 * MiB;
constexpr size_t WS_MT = 13 * MiB;
constexpr size_t WS_CTXR = 25 * MiB;
constexpr size_t WS_WIN = 33 * MiB, WS_WCO = 78 * MiB, WS_WGLU = 82 * MiB, WS_WAO = 88 * MiB, WS_WOUT = 92 * MiB, WS_WUP = 100 * MiB, WS_WDN = 132 * MiB;
constexpr size_t WS_W1 = 164 * MiB, WS_W3 = 176 * MiB;
constexpr size_t WS_XN = 212 * MiB, WS_MX = 344 * MiB, WS_ASSM = 476 * MiB, WS_S = 566 * MiB, WS_P = 626 * MiB;
constexpr size_t WS_PART = WS_P + (size_t)M * NIN * 2 + MiB;
constexpr size_t WS_END = WS_PART + (size_t)8 * MC * D * 4;
constexpr size_t WS_UP = WS_P;
static_assert((size_t)M * FF * 2 <= (size_t)M * NIN * 2, "UP overlay");
constexpr int CW_BAR = 4096;

constexpr int LDS_BYTES = 147456, MISC_OFF = LDS_BYTES - 256;

#define RLX_AGENT __ATOMIC_RELAXED, __HIP_MEMORY_SCOPE_AGENT
#define LDS_WAIT() asm volatile("s_waitcnt lgkmcnt(0)" ::: "memory")
__device__ __forceinline__ unsigned cvt_pk_bf16(float lo, float hi) { unsigned r; asm volatile("v_cvt_pk_bf16_f32 %0, %1, %2" : "=v"(r) : "v"(lo), "v"(hi)); return r; }
__device__ __forceinline__ float bf_lo(unsigned w) { return __uint_as_float(w << 16); }
__device__ __forceinline__ float bf_hi(unsigned w) { return __uint_as_float(w & 0xffff0000u); }
__device__ __forceinline__ float wave_sum(float v) {
#pragma unroll
    for (int o = 1; o < 64; o <<= 1) v += __shfl_xor(v, o);
    return v;
}
__device__ __forceinline__ float sigmoidf_(float x) { return __builtin_amdgcn_rcpf(1.0f + __builtin_amdgcn_exp2f(-1.4426950408889634f * x)); }
__device__ __forceinline__ float gelu_tanh(float x) { const float u = 0.7978845608028654f * (x + 0.044715f * x * x * x); return x * sigmoidf_(2.0f * u); }

#define XB_TMO      128
#define XB_XCNT(j)  (256  + 64 * (j))
#define XB_XSUB(j)  (1280 + 64 * (j))
#define XB_XGEN(j)  (2304 + 64 * (j))
#define XB_TOP      3328
#define XB_TOPGEN   3392
#define XCD_BAR_WORDS 3456
#define XB_SPIN_CAP (1u << 22)
__device__ __forceinline__ unsigned xb_ld(unsigned* p)              { return __hip_atomic_load(p, __ATOMIC_RELAXED, __HIP_MEMORY_SCOPE_AGENT); }
__device__ __forceinline__ unsigned xb_add(unsigned* p, unsigned v) { return __hip_atomic_fetch_add(p, v, __ATOMIC_RELAXED, __HIP_MEMORY_SCOPE_AGENT); }
__device__ __forceinline__ unsigned xb_xcc_id() { return (unsigned)__builtin_amdgcn_s_getreg((3 << 11) | 20) & 0xFu; }
#define XB_SPIN(cond, bar) do { unsigned _sp = 0; while (cond) { __builtin_amdgcn_s_sleep(1); \
    if ((++_sp & 255u) == 0u) { if (xb_ld(&(bar)[XB_TMO])) break; if (_sp > XB_SPIN_CAP) { atomicAdd(&(bar)[XB_TMO], 1u); break; } } } } while (0)
struct XcdBarrier { unsigned* bar; unsigned x; volatile LAS unsigned* st; };
__device__ __forceinline__ XcdBarrier xcd_barrier_post(unsigned* bar, volatile LAS unsigned* st) {
    XcdBarrier b; b.bar = bar; b.x = xb_xcc_id(); b.st = st;
    if (threadIdx.x == 0) (void)xb_add(&bar[XB_XCNT(b.x)], 1u);
    return b;
}
__device__ __forceinline__ void xcd_barrier_complete(unsigned* bar, unsigned x, unsigned& nloc, unsigned& nx) {
    const unsigned G = gridDim.x * gridDim.y * gridDim.z;
    unsigned sum, cnt, mine, sp = 0u;
    for (;;) {
        sum = 0u; cnt = 0u; mine = 0u;
#pragma unroll
        for (unsigned j = 0; j < 16; ++j) { const unsigned c = xb_ld(&bar[XB_XCNT(j)]); sum += c; cnt += (c > 0u) ? 1u : 0u; mine = (j == x) ? c : mine; }
        if (sum == G) break;
        __builtin_amdgcn_s_sleep(1);
        if ((++sp & 255u) == 0u) { if (xb_ld(&bar[XB_TMO])) break; if (sp > XB_SPIN_CAP) { atomicAdd(&bar[XB_TMO], 1u); break; } }
    }
    nloc = mine > 0u ? mine : 1u; nx = cnt > 0u ? cnt : 1u;
}
__device__ __forceinline__ void xcd_barrier(const XcdBarrier& b) {
    asm volatile("s_waitcnt vmcnt(0)" ::: "memory");
    __syncthreads();
    if (threadIdx.x == 0) {
        unsigned* bar = b.bar;
        __builtin_amdgcn_s_waitcnt(0);
        unsigned nloc = b.st[0], nx = b.st[1];
        if (nloc == 0u) { xcd_barrier_complete(bar, b.x, nloc, nx); b.st[0] = nloc; b.st[1] = nx; }
        const unsigned old = xb_add(&bar[XB_XSUB(b.x)], 1u);
        const unsigned gen = old / nloc;
        if (old + 1u == (gen + 1u) * nloc) {
            __builtin_amdgcn_fence(__ATOMIC_RELEASE, "agent");
            asm volatile("s_waitcnt vmcnt(0)" ::: "memory");
            const unsigned og = xb_add(&bar[XB_TOP], 1u);
            const unsigned tg = og / nx;
            if (og + 1u == (tg + 1u) * nx) xb_add(&bar[XB_TOPGEN], 1u);
            else XB_SPIN(xb_ld(&bar[XB_TOPGEN]) == tg, bar);
            __builtin_amdgcn_fence(__ATOMIC_ACQUIRE, "agent");
            xb_add(&bar[XB_XGEN(b.x)], 1u);
            asm volatile("s_waitcnt vmcnt(0)" ::: "memory");
        } else {
            XB_SPIN(xb_ld(&bar[XB_XGEN(b.x)]) == gen, bar);
            __builtin_amdgcn_fence(__ATOMIC_ACQUIRE, "agent");
            asm volatile("s_waitcnt vmcnt(0)" ::: "memory");
        }
    }
    __syncthreads();
}

namespace pg8 {
constexpr int BM = 256, BK = 64, HALF = 128, HTB = HALF * BK * 2, STAGE_BYTES = 8 * HTB, NXCD = 8, WGM = 8;
__host__ __device__ __forceinline__ int lds_byte(int r, int c) { const int st = (r >> 4) * 2 + (c >> 5), rr = r & 15, cc = c & 31, ob = rr * 64 + cc * 2; return st * 1024 + (ob ^ (((ob >> 9) & 1) << 5)); }
__host__ __device__ __forceinline__ void stage_rc(int b, int& R, int& C) { const int st = b / 1024, sb = b % 1024, swz = sb ^ (((sb >> 9) & 1) << 5); R = (st >> 1) * 16 + swz / 64; C = (st & 1) * 32 + (swz % 64) / 2; }
__host__ __device__ __forceinline__ int perm32(int rho) { const int n = rho >> 4, i = rho & 15; return 8 * (i >> 2) + 4 * n + (i & 3); }
struct Unit { int pm, pn, koff, nt, kind; };
struct Gemm { const bf16_t* A; const bf16_t* Bt; int lda, ldb, K; };
struct StaticOrder {
    int nM, nN, nwg, G, c, ntk;
    __device__ __forceinline__ void init(int M_, int N_, int K_, int G_, int c_) { nM = M_ / BM; nN = N_ / BM; nwg = nM * nN; G = G_; c = c_; ntk = K_ / BK; }
    __device__ __forceinline__ bool next(int i, Unit& u) const {
        const long L = (long)i * G + c; if (L >= nwg) return false;
        u.koff = 0; u.nt = ntk; u.kind = 0;
        int wgid = (int)L; { const int q = nwg / NXCD, r = nwg % NXCD, xcd = wgid % NXCD, off = wgid / NXCD; wgid = (xcd < r ? xcd * (q + 1) : r * (q + 1) + (xcd - r) * q) + off; }
        const int nig = WGM * nN, gid = wgid / nig, fm = gid * WGM, gsz = (nM - fm) < WGM ? (nM - fm) : WGM;
        u.pm = fm + ((wgid % nig) % gsz); u.pn = (wgid % nig) / gsz; return true;
    }
};
struct GroupOrder {
    int nj, nunits, G, c, ntk;
    __device__ __forceinline__ void init(int nj_, int K_, int G_, int c_) { nj = nj_; nunits = SG * 5 * nj_; G = G_; c = c_; ntk = K_ / BK; }
    __device__ __forceinline__ bool next(int i, Unit& u) const {
        const int L = i * G + c; if (L >= nunits) return false;
        u.pm = L / nj; u.pn = (u.pm / 5) * nj + (L % nj); u.koff = 0; u.nt = ntk; u.kind = 0; return true;
    }
};
struct SplitCtxOrder {
    StaticOrder so; int nlat, nN, ntk8, kq, G, c; bool ctx;
    __device__ __forceinline__ void init(int N_, int K_, int G_, int c_, bool ctx_) { so.init(ML, N_, K_, G_, c_); nN = N_ / BM; G = G_; c = c_; ctx = ctx_; kq = K_ / 8; ntk8 = K_ / (8 * BK);
        nlat = c_ < so.nwg ? (so.nwg - c_ + G_ - 1) / G_ : 0; }
    __device__ __forceinline__ bool next(int i, Unit& u) const {
        Unit a; a.pm = 0; a.pn = 0; a.koff = 0; a.nt = 0; a.kind = 0;
        const bool la = so.next(i, a);
        const int L = (i - nlat) * G + c; const bool lc = ctx && !la && L >= 0 && L < 32 * nN;
        const int ks = L & 7;
        u.pm = la ? a.pm : ML / BM + (L >> 3) / nN; u.pn = la ? a.pn : (L >> 3) % nN; u.koff = la ? 0 : ks * kq; u.nt = la ? a.nt : ntk8; u.kind = la ? 0 : 1 + ks;
        return la || lc;
    }
};

template <class Epi, class Sched>
__device__ __forceinline__ void gemm_phase(LAS unsigned char* lds, const Gemm g, const Sched& S, const Epi& E) {
    int tid_ = threadIdx.x; asm volatile("" : "+v"(tid_));
    const int tid = tid_, wid = __builtin_amdgcn_readfirstlane(tid >> 6), lane = tid & 63, wr = wid >> 2, wc = wid & 3, fr = lane & 15, fq = lane >> 4;
    unsigned voffA[2], voffB[2];
#pragma unroll
    for (int i = 0; i < 2; ++i) { int R, C; stage_rc(tid * 16 + i * 8192, R, C); const int Rb = Epi::PERM ? ((R & ~31) + perm32(R & 31)) : R;
        voffA[i] = (unsigned)(R * g.lda + C) * 2u; voffB[i] = (unsigned)(Rb * g.ldb + C) * 2u; }
    const size_t kstep = (size_t)(BK * 2);
    const size_t hA = (size_t)HALF * g.lda * 2, hB = (size_t)HALF * g.ldb * 2, tA = 2 * hA, tB = 2 * hB;
    const unsigned ldsw = (unsigned)wid * 1024u;
    const int aoff = lds_byte(wr * 64 + fr, fq * 8), boff = lds_byte(wc * 32 + fr, fq * 8);
#define PG8_SA(b, h) (((b) * 2 + (h)) * HTB)
#define PG8_SB(b, h) ((4 + (b) * 2 + (h)) * HTB)
#define PG8_STAGE(bufoff, gbase, voff) do { _Pragma("unroll") for (int _i = 0; _i < 2; ++_i) \
        __builtin_amdgcn_global_load_lds((const unsigned*)((const char*)(gbase) + (voff)[_i]), (LAS unsigned*)(lds + (bufoff) + ldsw + _i * 8192), 16, 0, 0); } while (0)
#define PG8_LDA(dst, b, h) do { _Pragma("unroll") for (int m = 0; m < 4; ++m) _Pragma("unroll") for (int k = 0; k < 2; ++k) dst[m][k] = *(const LAS bf16x8*)(lds + PG8_SA(b, h) + aoff + m * 2048 + k * 1024); } while (0)
#define PG8_LDB(dst, b, h) do { _Pragma("unroll") for (int n = 0; n < 2; ++n) _Pragma("unroll") for (int k = 0; k < 2; ++k) dst[n][k] = *(const LAS bf16x8*)(lds + PG8_SB(b, h) + boff + n * 2048 + k * 1024); } while (0)
#define PG8_MMA(ai, bj, At, Bt) do { __builtin_amdgcn_s_setprio(1); _Pragma("unroll") for (int m = 0; m < 4; ++m) _Pragma("unroll") for (int n = 0; n < 2; ++n) _Pragma("unroll") for (int k = 0; k < 2; ++k) \
        acc[ai][bj][m][n] = __builtin_amdgcn_mfma_f32_16x16x32_bf16(Bt[n][k], At[m][k], acc[ai][bj][m][n], 0, 0, 0); __builtin_amdgcn_s_setprio(0); } while (0)
#define PG8_WAIT_V(n) asm volatile("s_waitcnt vmcnt(" #n ")" ::: "memory")
#define PG8_WAIT_L(n) asm volatile("s_waitcnt lgkmcnt(" #n ")" ::: "memory")
#define PG8_BAR __builtin_amdgcn_s_barrier()
#define PG8_SCHED __builtin_amdgcn_sched_barrier(0)
    Unit cur, nxt; int ui = 0;
    if (!S.next(0, cur)) return;
    f32x4 acc[2][2][4][2];
#pragma unroll
    for (int a = 0; a < 2; ++a)
#pragma unroll
        for (int b = 0; b < 2; ++b)
#pragma unroll
            for (int m = 0; m < 4; ++m)
#pragma unroll
                for (int n = 0; n < 2; ++n) acc[a][b][m][n] = (f32x4){0.f, 0.f, 0.f, 0.f};
    bf16x8 At[4][2], B0[2][2], B1[2][2];
    const char* cA = (const char*)g.A + (size_t)cur.pm * tA + (size_t)cur.koff * 2; const char* cB = (const char*)g.Bt + (size_t)cur.pn * tB + (size_t)cur.koff * 2;
    PG8_STAGE(PG8_SB(0, 0), cB, voffB); PG8_STAGE(PG8_SB(0, 1), cB + hB, voffB); PG8_STAGE(PG8_SA(0, 0), cA, voffA); PG8_STAGE(PG8_SA(0, 1), cA + hA, voffA);
    if (wr == 1) PG8_BAR;
    PG8_WAIT_V(2); PG8_BAR;
    PG8_STAGE(PG8_SB(1, 0), cB + kstep, voffB); PG8_STAGE(PG8_SA(1, 0), cA + kstep, voffA); PG8_STAGE(PG8_SB(1, 1), cB + hB + kstep, voffB);
    PG8_WAIT_V(6); PG8_BAR;
    for (;;) {
        const bool has_next = S.next(ui + 1, nxt);
        const char* nA = has_next ? (const char*)g.A + (size_t)nxt.pm * tA + (size_t)nxt.koff * 2 : cA; const char* nB = has_next ? (const char*)g.Bt + (size_t)nxt.pn * tB + (size_t)nxt.koff * 2 : cB;
        const int nt = cur.nt;
        for (int t = 0; t < nt; t += 2) {
            const bool last = (t == nt - 2);
            const char* a1 = cA + (size_t)(t + 1) * kstep;
            const char* a2 = last ? nA : cA + (size_t)(t + 2) * kstep; const char* b2 = last ? nB : cB + (size_t)(t + 2) * kstep;
            const char* a3 = a2 + kstep; const char* b3 = b2 + kstep;
            PG8_LDB(B0, 0, 0); PG8_LDB(B1, 0, 1); PG8_SCHED; PG8_LDA(At, 0, 0); PG8_STAGE(PG8_SA(1, 1), a1 + hA, voffA);
            PG8_WAIT_V(8); PG8_WAIT_L(0); PG8_BAR; PG8_MMA(0, 0, At, B0); PG8_MMA(0, 1, At, B1); PG8_BAR; PG8_SCHED;
            PG8_LDA(At, 0, 1); PG8_STAGE(PG8_SB(0, 0), b2, voffB); PG8_STAGE(PG8_SB(0, 1), b2 + hB, voffB); PG8_STAGE(PG8_SA(0, 0), a2, voffA);
            PG8_WAIT_V(8); PG8_WAIT_L(0); PG8_BAR; PG8_MMA(1, 0, At, B0); PG8_MMA(1, 1, At, B1); PG8_BAR; PG8_SCHED;
            PG8_LDB(B0, 1, 0); PG8_LDB(B1, 1, 1); PG8_SCHED; PG8_LDA(At, 1, 0); PG8_STAGE(PG8_SA(0, 1), a2 + hA, voffA);
            PG8_WAIT_V(8); PG8_WAIT_L(0); PG8_BAR; PG8_MMA(0, 0, At, B0); PG8_MMA(0, 1, At, B1); PG8_BAR; PG8_SCHED;
            PG8_LDA(At, 1, 1); PG8_STAGE(PG8_SB(1, 0), b3, voffB); PG8_STAGE(PG8_SB(1, 1), b3 + hB, voffB); PG8_STAGE(PG8_SA(1, 0), a3, voffA);
            PG8_WAIT_V(8); PG8_WAIT_L(0); PG8_BAR; PG8_MMA(1, 0, At, B0); PG8_MMA(1, 1, At, B1); PG8_BAR; PG8_SCHED;
        }
        if (wr == 0) PG8_BAR;
        E(acc, cur, wr, wc, fr, fq);
        if (!has_next) break;
#pragma unroll
        for (int a = 0; a < 2; ++a)
#pragma unroll
            for (int b = 0; b < 2; ++b)
#pragma unroll
                for (int m = 0; m < 4; ++m)
#pragma unroll
                    for (int n = 0; n < 2; ++n) acc[a][b][m][n] = (f32x4){0.f, 0.f, 0.f, 0.f};
        cur = nxt; cA = nA; cB = nB; ++ui;
        if (wr == 1) PG8_BAR;
    }
    PG8_WAIT_V(0);
    PG8_BAR;
#undef PG8_SA
#undef PG8_SB
#undef PG8_STAGE
#undef PG8_LDA
#undef PG8_LDB
#undef PG8_MMA
#undef PG8_WAIT_V
#undef PG8_WAIT_L
#undef PG8_BAR
#undef PG8_SCHED
}

typedef const f32x4 (&AccRef)[2][2][4][2];
__device__ __forceinline__ u32x4 pack8(const f32x4 v0, const f32x4 v1) { u32x4 w; w.x = cvt_pk_bf16(v0[0], v0[1]); w.y = cvt_pk_bf16(v0[2], v0[3]); w.z = cvt_pk_bf16(v1[0], v1[1]); w.w = cvt_pk_bf16(v1[2], v1[3]); return w; }
__device__ __forceinline__ void unpack8(const u32x4 w, f32x4& v0, f32x4& v1) { v0 = (f32x4){bf_lo(w.x), bf_hi(w.x), bf_lo(w.y), bf_hi(w.y)}; v1 = (f32x4){bf_lo(w.z), bf_hi(w.z), bf_lo(w.w), bf_hi(w.w)}; }

template <int ACT> struct EpiBf16 {
    static constexpr bool PERM = true;
    bf16_t* O; int ldc;
    __device__ __forceinline__ void operator()(AccRef acc, const Unit& u, int wr, int wc, int fr, int fq) const {
        const int row0 = u.pm * BM + wr * 64 + fr, col0 = u.pn * BM + wc * 32 + 8 * fq;
#pragma unroll
        for (int ai = 0; ai < 2; ++ai)
#pragma unroll
            for (int m = 0; m < 4; ++m) { bf16_t* rowp = O + (size_t)(row0 + ai * HALF + m * 16) * ldc + col0;
#pragma unroll
                for (int bj = 0; bj < 2; ++bj) { f32x4 v0 = acc[ai][bj][m][0], v1 = acc[ai][bj][m][1];
                    if (ACT == 1) {
#pragma unroll
                        for (int e = 0; e < 4; ++e) { const float a = fmaxf(v0[e], 0.f), b = fmaxf(v1[e], 0.f); v0[e] = a * a; v1[e] = b * b; } }
                    *(u32x4*)(rowp + bj * HALF) = pack8(v0, v1); } }
    }
};
struct EpiBf16Part {
    static constexpr bool PERM = true;
    bf16_t* O; float* PART;
    __device__ __forceinline__ void operator()(AccRef acc, const Unit& u, int wr, int wc, int fr, int fq) const {
        const int row0 = u.pm * BM + wr * 64 + fr, col0 = u.pn * BM + wc * 32 + 8 * fq;
        if (u.kind == 0) {
#pragma unroll
            for (int ai = 0; ai < 2; ++ai)
#pragma unroll
                for (int m = 0; m < 4; ++m) { bf16_t* rowp = O + (size_t)(row0 + ai * HALF + m * 16) * D + col0;
#pragma unroll
                    for (int bj = 0; bj < 2; ++bj) *(u32x4*)(rowp + bj * HALF) = pack8(acc[ai][bj][m][0], acc[ai][bj][m][1]); }
        } else {
            float* pb = PART + (size_t)(u.kind - 1) * MC * D;
#pragma unroll
            for (int ai = 0; ai < 2; ++ai)
#pragma unroll
                for (int m = 0; m < 4; ++m) { float* rowp = pb + (size_t)(row0 - ML + ai * HALF + m * 16) * D + col0;
#pragma unroll
                    for (int bj = 0; bj < 2; ++bj) { *(f32x4*)(rowp + bj * HALF) = acc[ai][bj][m][0]; *(f32x4*)(rowp + bj * HALF + 4) = acc[ai][bj][m][1]; } }
        }
    }
};
struct EpiProj {
    static constexpr bool PERM = true;
    bf16_t* P; bf16_t* Assm;
    __device__ __forceinline__ void operator()(AccRef acc, const Unit& u, int wr, int wc, int fr, int fq) const {
        const int row0 = u.pm * BM + wr * 64 + fr, col0 = u.pn * BM + wc * 32 + 8 * fq;
        if (u.pn >= 12 && u.pn < 15) {
#pragma unroll
            for (int ai = 0; ai < 2; ++ai)
#pragma unroll
                for (int m = 0; m < 4; ++m) { const int r = row0 + ai * HALF + m * 16;
#pragma unroll
                    for (int bj = 0; bj < 2; ++bj) { const int c = col0 + bj * HALF - C_SU, gq = c >> 4, p0 = c & 15;
                        bf16_t* dst = Assm + ((size_t)(gq * SGR + (r >> 5)) * 768 + (r & 31) * 16 + p0);
                        *(u32x4*)dst = pack8(acc[ai][bj][m][0], acc[ai][bj][m][1]); } }
        } else {
            const bool sg = u.pn >= 21;
#pragma unroll
            for (int ai = 0; ai < 2; ++ai)
#pragma unroll
                for (int m = 0; m < 4; ++m) { bf16_t* rowp = P + (size_t)(row0 + ai * HALF + m * 16) * NIN + col0;
#pragma unroll
                    for (int bj = 0; bj < 2; ++bj) { f32x4 v0 = acc[ai][bj][m][0], v1 = acc[ai][bj][m][1];
                        if (sg) {
#pragma unroll
                            for (int e = 0; e < 4; ++e) { v0[e] = sigmoidf_(v0[e]); v1[e] = sigmoidf_(v1[e]); } }
                        *(u32x4*)(rowp + bj * HALF) = pack8(v0, v1); } }
        }
    }
};
struct EpiState {
    static constexpr bool PERM = false;
    float* S;
    __device__ __forceinline__ void operator()(AccRef acc, const Unit& u, int wr, int wc, int fr, int fq) const {
        const int row0 = u.pm * BM + wr * 64 + fr, col0 = wc * 32 + 4 * fq;
#pragma unroll
        for (int ai = 0; ai < 2; ++ai)
#pragma unroll
            for (int m = 0; m < 4; ++m) { float* rowp = S + (size_t)(row0 + ai * HALF + m * 16) * 256 + col0;
#pragma unroll
                for (int bj = 0; bj < 2; ++bj)
#pragma unroll
                    for (int n = 0; n < 2; ++n) *(f32x4*)(rowp + bj * HALF + n * 16) = acc[ai][bj][m][n]; }
    }
};
struct EpiSsmY {
    static constexpr bool PERM = true;
    bf16_t* P;
    __device__ __forceinline__ void operator()(AccRef acc, const Unit& u, int wr, int wc, int fr, int fq) const {
        const int gq = u.pm / 5, rl0 = (u.pm % 5) * BM + wr * 64 + fr, cl0 = (u.pn & 1) * BM + wc * 32 + 8 * fq;
#pragma unroll
        for (int ai = 0; ai < 2; ++ai)
#pragma unroll
            for (int m = 0; m < 4; ++m) { const int rl = rl0 + ai * HALF + m * 16;
                if (rl < SGV) {
#pragma unroll
                    for (int bj = 0; bj < 2; ++bj) { const int cl = cl0 + bj * HALF, t = cl >> 4, p0 = cl & 15;
                        f32x4 v0 = acc[ai][bj][m][0], v1 = acc[ai][bj][m][1];
#pragma unroll
                        for (int e = 0; e < 4; ++e) { v0[e] = gelu_tanh(v0[e]); v1[e] = gelu_tanh(v1[e]); }
                        *(u32x4*)(P + (size_t)(rl * 32 + t) * NIN + C_Y + gq * 16 + p0) = pack8(v0, v1); } } }
    }
};
template <bool ACCUM> struct EpiMerge {
    static constexpr bool PERM = true;
    bf16_t* Mg; const bf16_t* P; int gcol;
    __device__ __forceinline__ void operator()(AccRef acc, const Unit& u, int wr, int wc, int fr, int fq) const {
        const int row0 = u.pm * BM + wr * 64 + fr, col0 = u.pn * BM + wc * 32 + 8 * fq;
#pragma unroll
        for (int ai = 0; ai < 2; ++ai)
#pragma unroll
            for (int m = 0; m < 4; ++m) { const size_t r = (size_t)(row0 + ai * HALF + m * 16);
#pragma unroll
                for (int bj = 0; bj < 2; ++bj) { const int c = col0 + bj * HALF;
                    f32x4 g0, g1; unpack8(*(const u32x4*)(P + r * NIN + gcol + c), g0, g1);
                    f32x4 v0 = acc[ai][bj][m][0] * g0, v1 = acc[ai][bj][m][1] * g1;
                    if (ACCUM) { f32x4 o0, o1; unpack8(*(const u32x4*)(Mg + r * D + c), o0, o1); v0 += o0; v1 += o1; }
                    *(u32x4*)(Mg + r * D + c) = pack8(v0, v1); } }
    }
};
struct EpiGlu {
    static constexpr bool PERM = true;
    bf16_t* Mg; const bf16_t* P;
    __device__ __forceinline__ void operator()(AccRef acc, const Unit& u, int wr, int wc, int fr, int fq) const {
        const int row0 = u.pm * BM + wr * 64 + fr, c = u.pn * HALF + wc * 32 + 8 * fq;
#pragma unroll
        for (int ai = 0; ai < 2; ++ai)
#pragma unroll
            for (int m = 0; m < 4; ++m) { const size_t r = (size_t)(row0 + ai * HALF + m * 16);
                f32x4 g0, g1; unpack8(*(const u32x4*)(P + r * NIN + C_GS + c), g0, g1);
                f32x4 o0, o1; unpack8(*(const u32x4*)(Mg + r * D + c), o0, o1);
                f32x4 a0 = acc[ai][0][m][0], a1 = acc[ai][0][m][1]; const f32x4 s0 = acc[ai][1][m][0], s1 = acc[ai][1][m][1];
#pragma unroll
                for (int e = 0; e < 4; ++e) { a0[e] = o0[e] + g0[e] * a0[e] * sigmoidf_(s0[e]); a1[e] = o1[e] + g1[e] * a1[e] * sigmoidf_(s1[e]); }
                *(u32x4*)(Mg + r * D + c) = pack8(a0, a1); }
    }
};
}

namespace attn {
constexpr int DH = 128, NW = 8, QBLK = 32, KVBLK = 64;
constexpr float SCALE = 0.088388347648318440f;
constexpr float THR = 8.f;
constexpr size_t SHM_V = KVBLK * DH * 2, SHM_K = KVBLK * DH * 2, SHM_ATTN = 2 * SHM_V + 2 * SHM_K + NW * 64 * 4;
#define KSWZ(row, colB) ((row) * 256 + ((colB) ^ (((row) & 7) << 4)))
#define SBAR() __builtin_amdgcn_sched_barrier(0)
__device__ __forceinline__ int crow(int r, int hi) { return (r & 3) + 8 * (r >> 2) + 4 * hi; }
__device__ __forceinline__ void partialSM(f32x16& p0, f32x16& p1, float& m_reg, float& mn, float& alpha) {
  constexpr float C = SCALE * 1.4426950408889634f;
  float pmax = p0[0];
#pragma unroll
  for (int r = 1; r < 16; ++r) pmax = fmaxf(pmax, p0[r]);
#pragma unroll
  for (int r = 0; r < 16; ++r) pmax = fmaxf(pmax, p1[r]);
  { auto rr = __builtin_amdgcn_permlane32_swap(__float_as_uint(pmax), __float_as_uint(pmax), false, false);
    pmax = fmaxf(__uint_as_float(rr[0]), __uint_as_float(rr[1])); }
  if (__builtin_expect(__all(pmax - m_reg <= THR / SCALE), 1)) { mn = m_reg; alpha = 1.f; }
  else { mn = fmaxf(m_reg, pmax); alpha = __builtin_amdgcn_exp2f((m_reg - mn) * C); m_reg = mn; }
  float mnC = -mn * C;
#pragma unroll
  for (int r = 0; r < 16; ++r) p0[r] = fmaf(p0[r], C, mnC);
#pragma unroll
  for (int r = 0; r < 16; ++r) p1[r] = fmaf(p1[r], C, mnC);
#pragma unroll
  for (int r = 0; r < 16; ++r) p0[r] = __builtin_amdgcn_exp2f(p0[r]);
}
__device__ __forceinline__ void finishSM(f32x16& p0, f32x16& p1, float alpha, float& l_reg, bf16x8& pa0, bf16x8& pa1, bf16x8& pa2, bf16x8& pa3) {
#pragma unroll
  for (int r = 0; r < 16; ++r) p1[r] = __builtin_amdgcn_exp2f(p1[r]);
  float ps = 0;
#pragma unroll
  for (int r = 0; r < 16; ++r) ps += p0[r];
#pragma unroll
  for (int r = 0; r < 16; ++r) ps += p1[r];
  { auto rr = __builtin_amdgcn_permlane32_swap(__float_as_uint(ps), __float_as_uint(ps), false, false);
    ps = __uint_as_float(rr[0]) + __uint_as_float(rr[1]); }
  l_reg = l_reg * alpha + ps;
#define PK4(P, BASE, OUT) do { unsigned a0 = cvt_pk_bf16(P[BASE + 0], P[BASE + 1]), a1 = cvt_pk_bf16(P[BASE + 2], P[BASE + 3]);   \
    unsigned b0 = cvt_pk_bf16(P[BASE + 4], P[BASE + 5]), b1 = cvt_pk_bf16(P[BASE + 6], P[BASE + 7]);                              \
    auto r0 = __builtin_amdgcn_permlane32_swap(a0, b0, false, false); auto r1 = __builtin_amdgcn_permlane32_swap(a1, b1, false, false); \
    u32x4 w = {r0[0], r1[0], r0[1], r1[1]}; OUT = *reinterpret_cast<bf16x8*>(&w); } while (0)
  PK4(p0, 0, pa0); PK4(p0, 8, pa1); PK4(p1, 0, pa2); PK4(p1, 8, pa3);
#undef PK4
}
__device__ __forceinline__ void qkt(f32x16& p0, f32x16& p1, const char* Ks, const bf16x8* qr, int r32, int hi) {
  p0 = f32x16{}; p1 = f32x16{};
#pragma unroll
  for (int d0 = 0; d0 < 8; ++d0) { int cb = (d0 * 16 + hi * 8) * 2;
    bf16x8 b0 = *reinterpret_cast<const bf16x8*>(Ks + KSWZ(r32, cb));
    bf16x8 b1 = *reinterpret_cast<const bf16x8*>(Ks + KSWZ(32 + r32, cb));
    p0 = __builtin_amdgcn_mfma_f32_32x32x16_bf16(b0, qr[d0], p0, 0, 0, 0);
    p1 = __builtin_amdgcn_mfma_f32_32x32x16_bf16(b1, qr[d0], p1, 0, 0, 0); }
}
__device__ __forceinline__ int v_st(int k, int c) { const int kk = (k & ~0xC) | ((k & 4) << 1) | ((k & 8) >> 1); return ((kk >> 3) * 4 + (c >> 5)) * 512 + ((kk & 7) * 32 + (c & 31)) * 2; }
__device__ __forceinline__ int v_rd_base(int lane) { return ((lane & 3) << 3) | (((lane >> 2) & 3) << 6) | (((lane >> 4) & 1) << 5) | (((lane >> 5) & 1) << 8); }
constexpr int v_rd_off(int d0, int ks, int half) { return d0 * 512 + ks * 4096 + half * 2048; }
template <int OFF> __device__ __forceinline__ s16x4 tr_read(int vb) {
  s16x4 r; asm volatile("ds_read_b64_tr_b16 %0, %1 offset:%2" : "=&v"(r) : "v"(vb), "i"(OFF) : "memory"); return r;
}
template <int D0> __device__ __forceinline__ void pv_one(f32x16& od, int vb, bf16x8 pa0, bf16x8 pa1, bf16x8 pa2, bf16x8 pa3) {
  const s16x4 l0 = tr_read<v_rd_off(D0, 0, 0)>(vb), h0 = tr_read<v_rd_off(D0, 0, 1)>(vb), l1 = tr_read<v_rd_off(D0, 1, 0)>(vb), h1 = tr_read<v_rd_off(D0, 1, 1)>(vb);
  const s16x4 l2 = tr_read<v_rd_off(D0, 2, 0)>(vb), h2 = tr_read<v_rd_off(D0, 2, 1)>(vb), l3 = tr_read<v_rd_off(D0, 3, 0)>(vb), h3 = tr_read<v_rd_off(D0, 3, 1)>(vb);
  asm volatile("s_waitcnt lgkmcnt(0)" ::: "memory"); SBAR();
#define PK(L, H) (bf16x8){L[0], L[1], L[2], L[3], H[0], H[1], H[2], H[3]}
  od = __builtin_amdgcn_mfma_f32_32x32x16_bf16(pa0, PK(l0, h0), od, 0, 0, 0);
  od = __builtin_amdgcn_mfma_f32_32x32x16_bf16(pa1, PK(l1, h1), od, 0, 0, 0);
  od = __builtin_amdgcn_mfma_f32_32x32x16_bf16(pa2, PK(l2, h2), od, 0, 0, 0);
  od = __builtin_amdgcn_mfma_f32_32x32x16_bf16(pa3, PK(l3, h3), od, 0, 0, 0);
#undef PK
}
__device__ __forceinline__ void pv_d0(f32x16* o, int vb, bf16x8 pa0, bf16x8 pa1, bf16x8 pa2, bf16x8 pa3) {
  pv_one<0>(o[0], vb, pa0, pa1, pa2, pa3); pv_one<1>(o[1], vb, pa0, pa1, pa2, pa3); pv_one<2>(o[2], vb, pa0, pa1, pa2, pa3); pv_one<3>(o[3], vb, pa0, pa1, pa2, pa3);
}
__device__ __forceinline__ void attn_unit(const bf16_t* __restrict__ Qb, const bf16_t* __restrict__ Kc, const bf16_t* __restrict__ Kl, bf16_t* __restrict__ Ob, int nkc, int seq, char* lds) {
  int tid_ = threadIdx.x; asm volatile("" : "+v"(tid_));
  const int tid = tid_, wid = tid >> 6, lane = tid & 63, r32 = lane & 31, hi = lane >> 5;
  char* V_lds = lds; char* K_lds = lds + 2 * SHM_V;
  float* ws = (float*)(lds + 2 * SHM_V + 2 * SHM_K) + wid * 64; float* li_l = ws; float* al_l = ws + 32;
  float m_reg = -1e30f, l_reg = 0; f32x16 o[4] = {}; bf16x8 qr[8];
  const bf16_t* Qw = Qb + (long)(wid * QBLK + r32) * NIN + hi * 8;
#pragma unroll
  for (int d0 = 0; d0 < 8; ++d0) qr[d0] = *reinterpret_cast<const bf16x8*>(Qw + d0 * 16);
  const int sr = tid >> 4, sc = (tid & 15) * 8, vst0 = v_st(sr, sc), vst1 = v_st(32 + sr, sc);
  const int vb0 = (int)(uintptr_t)V_lds + v_rd_base(lane);
  struct { bf16x8 vs0, vs1, ks0, ks1; } sr_[2];
#define KROWP(k0) (((k0) < nkc) ? (Kc + (long)(k0) * NIN) : (Kl + (long)((k0) - nkc) * NIN))
#define SLOAD(i, k0) do { const bf16_t* kb_ = KROWP(k0) + (long)sr * NIN + sc; \
    sr_[i].vs0 = *reinterpret_cast<const bf16x8*>(kb_ + 256); sr_[i].vs1 = *reinterpret_cast<const bf16x8*>(kb_ + 32L * NIN + 256); \
    sr_[i].ks0 = *reinterpret_cast<const bf16x8*>(kb_); sr_[i].ks1 = *reinterpret_cast<const bf16x8*>(kb_ + 32L * NIN); } while (0)
#define SWRITE(b, i) do { *(bf16x8*)(V_lds + (b) * SHM_V + vst0) = sr_[i].vs0;          \
    *(bf16x8*)(V_lds + (b) * SHM_V + vst1) = sr_[i].vs1; int kc = sc * 2;               \
    *(bf16x8*)(K_lds + (b) * SHM_K + KSWZ(sr, kc)) = sr_[i].ks0;                       \
    *(bf16x8*)(K_lds + (b) * SHM_K + KSWZ(32 + sr, kc)) = sr_[i].ks1; } while (0)
#define SWAIT() asm volatile("s_waitcnt vmcnt(4)" ::: "memory")
#define RESC(a) do { if (__any((a) < 1.f)) { if (hi == 0) al_l[r32] = (a); asm volatile("s_waitcnt lgkmcnt(0)" ::: "memory"); \
    _Pragma("unroll") for (int d = 0; d < 4; ++d) _Pragma("unroll") for (int r = 0; r < 16; ++r) o[d][r] *= al_l[crow(r, hi)]; } } while (0)
  f32x16 pA0, pA1, pB0, pB1; float mnA, mnB, alA, alB; bf16x8 pa0, pa1, pa2, pa3; const int NT = seq / KVBLK;
  constexpr int SE = 0, SO = 1;
  SLOAD(SE, 0); asm volatile("s_waitcnt vmcnt(0)" ::: "memory"); SWRITE(0, SE); __syncthreads();
  qkt(pA0, pA1, K_lds, qr, r32, hi); partialSM(pA0, pA1, m_reg, mnA, alA);
  SLOAD(SO, KVBLK); if (2 < NT) SLOAD(SE, 2 * KVBLK);
  SWAIT(); SWRITE(1, SO); __syncthreads();
  for (int j = 1; j + 1 < NT; j += 2) {
    SBAR(); qkt(pB0, pB1, K_lds + SHM_K, qr, r32, hi);
    finishSM(pA0, pA1, alA, l_reg, pa0, pa1, pa2, pa3); SBAR();
    SLOAD(SO, (j + 2) * KVBLK); SBAR();
    pv_d0(o, vb0, pa0, pa1, pa2, pa3); partialSM(pB0, pB1, m_reg, mnB, alB);
    __syncthreads(); SWAIT(); SWRITE(0, SE);
    RESC(alB); __syncthreads();
    SBAR(); qkt(pA0, pA1, K_lds, qr, r32, hi);
    finishSM(pB0, pB1, alB, l_reg, pa0, pa1, pa2, pa3); SBAR();
    if (j + 3 < NT) SLOAD(SE, (j + 3) * KVBLK); SBAR();
    pv_d0(o, vb0 + (int)SHM_V, pa0, pa1, pa2, pa3); partialSM(pA0, pA1, m_reg, mnA, alA);
    __syncthreads(); SWAIT(); SWRITE(1, SO);
    RESC(alA); __syncthreads();
  }
  SBAR(); qkt(pB0, pB1, K_lds + SHM_K, qr, r32, hi);
  finishSM(pA0, pA1, alA, l_reg, pa0, pa1, pa2, pa3); SBAR();
  pv_d0(o, vb0, pa0, pa1, pa2, pa3); partialSM(pB0, pB1, m_reg, mnB, alB);
  __syncthreads(); RESC(alB);
  finishSM(pB0, pB1, alB, l_reg, pa0, pa1, pa2, pa3); SBAR();
  pv_d0(o, vb0 + (int)SHM_V, pa0, pa1, pa2, pa3);
  if (hi == 0) li_l[r32] = l_reg; asm volatile("s_waitcnt lgkmcnt(0)" ::: "memory");
  float rli[16];
#pragma unroll
  for (int r = 0; r < 16; ++r) rli[r] = __builtin_amdgcn_rcpf(li_l[crow(r, hi)]);
  bf16_t* Ow = Ob + (long)(wid * QBLK) * NIN;
#pragma unroll
  for (int r = 0; r < 16; ++r) { int orow = crow(r, hi);
#pragma unroll
    for (int d0 = 0; d0 < 4; ++d0) Ow[(long)orow * NIN + d0 * 32 + r32] = (bf16_t)(cvt_pk_bf16(o[d0][r] * rli[r], 0.f) & 0xffffu); }
  __syncthreads();
#undef KROWP
#undef SLOAD
#undef SWRITE
#undef SWAIT
#undef RESC
}
}

struct Args { const float* in[28]; float* out; unsigned char* ws; int lo, hi; };
enum { I_X = 0, I_C, I_CTX, I_CCTX, I_WMOD, I_BMOD, I_GPREMIX, I_GPOSTMIX, I_GPREMLP, I_GPOSTMLP, I_WIN, I_CONVW, I_WCO, I_LRE, I_LIM, I_LDT, I_BRE, I_BIM, I_CRE, I_CIM, I_SD, I_WGLU, I_QG, I_KG, I_WAO, I_WOUT, I_WUP, I_WDN };

__device__ __forceinline__ void transpose_block(const float* W, int K, int N, int k0, int n0, bf16_t* dst, LAS float* scr, int lane) {
#pragma unroll 8
    for (int i = 0; i < 32; ++i) { const int kk = 2 * i + (lane >> 5); scr[kk * 33 + (lane & 31)] = W[(size_t)(k0 + kk) * N + n0 + (lane & 31)]; }
    LDS_WAIT(); asm volatile("" ::: "memory");
    const int c = lane & 7;
#pragma unroll
    for (int j = 0; j < 4; ++j) { const int n = (lane >> 3) + 8 * j; const LAS float* s = scr + (8 * c) * 33 + n;
        u32x4 o; o.x = cvt_pk_bf16(s[0 * 33], s[1 * 33]); o.y = cvt_pk_bf16(s[2 * 33], s[3 * 33]); o.z = cvt_pk_bf16(s[4 * 33], s[5 * 33]); o.w = cvt_pk_bf16(s[6 * 33], s[7 * 33]);
        *(u32x4*)(dst + (size_t)n * K + k0 + 8 * c) = o; }
    LDS_WAIT(); asm volatile("" ::: "memory");
}
__device__ __forceinline__ void convert_weights(const Args& a, int l, LAS unsigned char* lds, int gw, int NGW, int wave, int lane) {
    LAS float* scr = (LAS float*)(lds + wave * 16384);
    unsigned char* ws = a.ws;
    constexpr int I_IN = (D / 64) * (NIN / 32), I_CO = (1024 / 64) * (D / 32), I_GLU = (768 / 64) * (4096 / 32), I_AO = I_CO, I_OUT = (D / 64) * (D / 32), I_UP = (D / 64) * (FF / 32), I_DN = (FF / 64) * (D / 32);
    constexpr int NITEMS = I_IN + I_CO + I_GLU + I_AO + I_OUT + I_UP + I_DN;
    for (int it = gw; it < NITEMS; it += NGW) {
        int r = it;
        if (r < I_IN) { const int nb = r % (NIN / 32), kb = r / (NIN / 32); transpose_block(a.in[I_WIN] + (size_t)l * D * NIN, D, NIN, 64 * kb, 32 * nb, (bf16_t*)(ws + WS_WIN) + (size_t)(32 * nb) * D, scr, lane); continue; } r -= I_IN;
        if (r < I_CO) { const int nb = r % (D / 32), kb = r / (D / 32); transpose_block(a.in[I_WCO] + (size_t)l * 1024 * D, 1024, D, 64 * kb, 32 * nb, (bf16_t*)(ws + WS_WCO) + (size_t)(32 * nb) * 1024, scr, lane); continue; } r -= I_CO;
        if (r < I_GLU) { const int nb = r % 128, kb = r / 128; const int nq = nb & 63, drow = 256 * (nq >> 2) + 32 * (nq & 3) + (nb >= 64 ? 128 : 0);
            transpose_block(a.in[I_WGLU] + (size_t)l * 768 * 4096, 768, 4096, 64 * kb, 32 * nb, (bf16_t*)(ws + WS_WGLU) + (size_t)drow * 768, scr, lane); continue; } r -= I_GLU;
        if (r < I_AO) { const int nb = r % (D / 32), kb = r / (D / 32); transpose_block(a.in[I_WAO] + (size_t)l * 1024 * D, 1024, D, 64 * kb, 32 * nb, (bf16_t*)(ws + WS_WAO) + (size_t)(32 * nb) * 1024, scr, lane); continue; } r -= I_AO;
        if (r < I_OUT) { const int nb = r % (D / 32), kb = r / (D / 32); transpose_block(a.in[I_WOUT] + (size_t)l * D * D, D, D, 64 * kb, 32 * nb, (bf16_t*)(ws + WS_WOUT) + (size_t)(32 * nb) * D, scr, lane); continue; } r -= I_OUT;
        if (r < I_UP) { const int nb = r % (FF / 32), kb = r / (FF / 32); transpose_block(a.in[I_WUP] + (size_t)l * D * FF, D, FF, 64 * kb, 32 * nb, (bf16_t*)(ws + WS_WUP) + (size_t)(32 * nb) * D, scr, lane); continue; } r -= I_UP;
        { const int nb = r % (D / 32), kb = r / (D / 32); transpose_block(a.in[I_WDN] + (size_t)l * FF * D, FF, D, 64 * kb, 32 * nb, (bf16_t*)(ws + WS_WDN) + (size_t)(32 * nb) * FF, scr, lane); }
    }
}

__device__ __forceinline__ void mod_gemv(const Args& a, LAS unsigned char* lds, int bid, int G, int tid, int wave, int lane) {
    LAS float* SV = (LAS float*)lds;
    LAS float* RED = (LAS float*)(lds + 40960);
    float* MOD = (float*)(a.ws + WS_MOD);
    if (bid >= 384) return;
    for (int i = tid; i < 5 * D; i += 512) { const int j = i / D, k = i % D; const float v = j < 4 ? a.in[I_C][j * D + k] : a.in[I_CCTX][k]; SV[i] = v * sigmoidf_(v); }
    __syncthreads();
    for (int it = bid; it < 384; it += G) {
        const int l = it / 96, n0 = (it % 96) * 128;
        const float* W = a.in[I_WMOD] + (size_t)l * D * NMOD + n0 + 2 * lane;
        float acc[5][2];
#pragma unroll
        for (int j = 0; j < 5; ++j) { acc[j][0] = 0.f; acc[j][1] = 0.f; }
        const int kb = wave * 256;
#pragma unroll 8
        for (int k = 0; k < 256; ++k) { const f32x2 w = *(const f32x2*)(W + (size_t)(kb + k) * NMOD);
#pragma unroll
            for (int j = 0; j < 5; ++j) { const float s = SV[j * D + kb + k]; acc[j][0] += s * w.x; acc[j][1] += s * w.y; } }
#pragma unroll
        for (int j = 0; j < 5; ++j) { RED[(wave * 5 + j) * 128 + 2 * lane] = acc[j][0]; RED[(wave * 5 + j) * 128 + 2 * lane + 1] = acc[j][1]; }
        __syncthreads();
        for (int i = tid; i < 640; i += 512) { const int j = i >> 7, cn = i & 127; float s = 0.f;
#pragma unroll
            for (int w = 0; w < 8; ++w) s += RED[(w * 5 + j) * 128 + cn];
            MOD[((size_t)l * 5 + j) * NMOD + n0 + cn] = s + a.in[I_BMOD][l * NMOD + n0 + cn]; }
        __syncthreads();
    }
}

__device__ __forceinline__ void ssm_tables_t1(const Args& a, int gtid, int NT) {
    float* ETAB = (float*)(a.ws + WS_ETAB); float* BBT = (float*)(a.ws + WS_BB);
    for (int idx = gtid; idx < DEPTH * 2 * SG * 64; idx += NT) {
        const int n = idx & 63, gq = (idx >> 6) % SG, dir = (idx / (64 * SG)) & 1, l = idx / (64 * SG * 2);
        const double lr = fmin((double)a.in[I_LRE][idx], -1e-4), li = (double)a.in[I_LIM][idx], dt = exp((double)a.in[I_LDT][(l * 2 + dir) * SG + gq]);
        const double mag = exp(lr * dt), th = li * dt; double sn, cs; sincos(th, &sn, &cs);
        const double ab_re = mag * cs, ab_im = mag * sn, nr = ab_re - 1.0, den = lr * lr + li * li;
        const double f_re = (nr * lr + ab_im * li) / den, f_im = (ab_im * lr - nr * li) / den;
        const size_t o = (((size_t)(l * SG + gq) * 2 + dir) * 64 + n);
        float* e = ETAB + o * 66;
        for (int k = 0; k <= 32; ++k) { double s2, c2; sincos(th * k, &s2, &c2); const double mg = exp(lr * dt * k); e[2 * k] = (float)(mg * c2); e[2 * k + 1] = (float)(mg * s2); }
        float* bb = BBT + o * 32;
        for (int q = 0; q < 16; ++q) { const double br = (double)a.in[I_BRE][(size_t)idx * 16 + q], bi = (double)a.in[I_BIM][(size_t)idx * 16 + q];
            bb[2 * q] = (float)(f_re * br - f_im * bi); bb[2 * q + 1] = (float)(f_re * bi + f_im * br); }
    }
}
__device__ __forceinline__ void ssm_tables_t2(const Args& a, LAS unsigned char* lds, int bid, int G, int tid) {
    LAS float* Cs = (LAS float*)lds;
    LAS float* Es = (LAS float*)(lds + 16 * 65 * 8);
    LAS float* Bs = Es + 64 * 32 * 2;
    const float* ETAB = (const float*)(a.ws + WS_ETAB); const float* BBT = (const float*)(a.ws + WS_BB); float* MT = (float*)(a.ws + WS_MT);
    for (int it = bid; it < DEPTH * SG * 2; it += G) {
        const int dir = it & 1, gq = (it >> 1) % SG, l = it / (2 * SG);
        const size_t o = ((size_t)(l * SG + gq) * 2 + dir);
        const size_t ci = ((size_t)(l * 2 + dir) * SG + gq) * 1024;
        for (int i = tid; i < 1024; i += 512) { const int p = i >> 6, n = i & 63; Cs[(p * 65 + n) * 2] = a.in[I_CRE][ci + i]; Cs[(p * 65 + n) * 2 + 1] = a.in[I_CIM][ci + i]; }
        for (int i = tid; i < 64 * 32; i += 512) { const int n = i >> 5, lag = i & 31; Es[i * 2] = ETAB[(o * 64 + n) * 66 + 2 * lag]; Es[i * 2 + 1] = ETAB[(o * 64 + n) * 66 + 2 * lag + 1]; }
        for (int i = tid; i < 64 * 32; i += 512) Bs[i] = BBT[o * 64 * 32 + i];
        __syncthreads();
        const int lag = tid >> 4, p = tid & 15;
        float acc[16];
#pragma unroll
        for (int q = 0; q < 16; ++q) acc[q] = 0.f;
        for (int n = 0; n < 64; ++n) {
            const float cr = Cs[(p * 65 + n) * 2], cim = Cs[(p * 65 + n) * 2 + 1], er = Es[(n * 32 + lag) * 2], ei = Es[(n * 32 + lag) * 2 + 1];
            const float gr = cr * er - cim * ei, gi = cr * ei + cim * er;
#pragma unroll
            for (int q = 0; q < 16; ++q) acc[q] += gr * Bs[(n * 16 + q) * 2] - gi * Bs[(n * 16 + q) * 2 + 1];
        }
        float* dst = MT + (o * 32 + lag) * 256 + p * 16;
#pragma unroll
        for (int q = 0; q < 16; q += 4) *(f32x4*)(dst + q) = (f32x4){acc[q], acc[q + 1], acc[q + 2], acc[q + 3]};
        __syncthreads();
    }
}
__device__ __forceinline__ void ssm_fill(const Args& a, int l, LAS unsigned char* lds, int bid, int G, int tid) {
    LAS float* MTs = (LAS float*)lds;
    LAS float* Es = (LAS float*)(lds + 65536);
    LAS float* Cs = (LAS float*)(lds + 65536 + 33792);
    LAS float* Bs = (LAS float*)(lds + 65536 + 33792 + 16384);
    LAS float* Ds = (LAS float*)(lds + 65536 + 33792 + 32768);
    const float* ETAB = (const float*)(a.ws + WS_ETAB); const float* BBT = (const float*)(a.ws + WS_BB); const float* MT = (const float*)(a.ws + WS_MT);
    bf16_t* W1 = (bf16_t*)(a.ws + WS_W1); bf16_t* W3 = (bf16_t*)(a.ws + WS_W3);
    for (int it = bid; it < SG * 4; it += G) {
        const int gq = it >> 2, part = it & 3;
        const size_t o = (size_t)(l * SG + gq) * 2;
        for (int i = tid; i < 2 * 32 * 256; i += 512) MTs[i] = MT[o * 32 * 256 + i];
        for (int i = tid; i < 2 * 64 * 66; i += 512) Es[i] = ETAB[o * 64 * 66 + i];
        for (int i = tid; i < 2 * 64 * 32; i += 512) Bs[i] = BBT[o * 64 * 32 + i];
        for (int i = tid; i < 2 * 1024; i += 512) { const int dir = i >> 10, pn = i & 1023; const size_t ci = ((size_t)(l * 2 + dir) * SG + gq) * 1024 + pn;
            Cs[i * 2] = a.in[I_CRE][ci]; Cs[i * 2 + 1] = a.in[I_CIM][ci]; }
        if (tid < 16) Ds[tid] = a.in[I_SD][l * 768 + gq * 16 + tid];
        __syncthreads();
        for (int ch = tid; ch < 128 * 96; ch += 512) {
            const int ncol = part * 128 + ch / 96, kc = ch % 96, t = ncol >> 4, p = ncol & 15;
            float v[8];
            if (kc < 64) { const int s = kc >> 1, q0 = (kc & 1) * 8;
#pragma unroll
                for (int i = 0; i < 8; ++i) { const int q = q0 + i; float x = 0.f;
                    if (s <= t) x += MTs[((t - s) * 16 + p) * 16 + q];
                    if (s >= t) x += MTs[8192 + ((s - t) * 16 + p) * 16 + q];
                    if (s == t && p == q) x += Ds[p];
                    v[i] = x; }
            } else { const int dir = (kc - 64) >> 4, kk0 = ((kc - 64) & 15) * 8, e = dir == 0 ? t + 1 : 32 - t;
#pragma unroll
                for (int i = 0; i < 8; ++i) { const int kk = kk0 + i, prt = kk >> 6, n = kk & 63;
                    const float cr = Cs[((dir * 16 + p) * 64 + n) * 2], cim = Cs[((dir * 16 + p) * 64 + n) * 2 + 1], er = Es[((dir * 64 + n) * 33 + e) * 2], ei = Es[((dir * 64 + n) * 33 + e) * 2 + 1];
                    v[i] = prt == 0 ? (cr * er - cim * ei) : -(cr * ei + cim * er); }
            }
            u32x4 w; w.x = cvt_pk_bf16(v[0], v[1]); w.y = cvt_pk_bf16(v[2], v[3]); w.z = cvt_pk_bf16(v[4], v[5]); w.w = cvt_pk_bf16(v[6], v[7]);
            *(u32x4*)(W3 + ((size_t)(gq * 512 + ncol) * 768 + kc * 8)) = w;
        }
        for (int ch = tid; ch < 64 * 64; ch += 512) {
            const int ncol = part * 64 + (ch >> 6), kc = ch & 63, dir = ncol >> 7, prt = (ncol >> 6) & 1, n = ncol & 63, s = kc >> 1, q0 = (kc & 1) * 8, e = dir == 0 ? 31 - s : s;
            const float er = Es[((dir * 64 + n) * 33 + e) * 2], ei = Es[((dir * 64 + n) * 33 + e) * 2 + 1];
            float v[8];
#pragma unroll
            for (int i = 0; i < 8; ++i) { const float br = Bs[((dir * 64 + n) * 16 + q0 + i) * 2], bi = Bs[((dir * 64 + n) * 16 + q0 + i) * 2 + 1];
                v[i] = prt == 0 ? (er * br - ei * bi) : (er * bi + ei * br); }
            u32x4 w; w.x = cvt_pk_bf16(v[0], v[1]); w.y = cvt_pk_bf16(v[2], v[3]); w.z = cvt_pk_bf16(v[4], v[5]); w.w = cvt_pk_bf16(v[6], v[7]);
            *(u32x4*)(W1 + ((size_t)(gq * 256 + ncol) * 512 + kc * 8)) = w;
        }
        __syncthreads();
    }
}

template <int MODE>
__device__ __forceinline__ void row_pass(LAS unsigned char* lds, int bid, int G, int tid, int wave, int lane,
                                         const float* xin, float* xout, const float* cin, float* cout, const bf16_t* Y, const float* YP  , int nrows, bf16_t* XN,
                                         const float* gpost, const float* gpre, const float* modg  , int gate_off,
                                         const float* modn  , int shift_off, int scale_off) {
    LAS float* V = (LAS float*)lds;
    int cur = -1;
    const int nblk = nrows / 16;
    for (int blk = bid; blk < nblk; blk += G) {
        const int row0 = blk * 16, jb = row0 < ML ? row0 / SEQ : 4;
        if (jb != cur) {
            __syncthreads();
            for (int i = tid; i < D; i += 512) {
                if (cur < 0) { if (MODE != 0) V[i] = gpost[i]; if (MODE != 2) V[D + i] = gpre[i]; }
                if (MODE != 0) V[2 * D + i] = modg[(size_t)jb * NMOD + gate_off + i];
                if (MODE != 2) { V[3 * D + i] = modn[(size_t)jb * NMOD + shift_off + i]; V[4 * D + i] = 1.0f + modn[(size_t)jb * NMOD + scale_off + i]; }
            }
            cur = jb;
            __syncthreads();
        }
#pragma unroll 1
        for (int rr = 0; rr < 2; ++rr) {
            const int row = row0 + wave * 2 + rr;
            const float* xs = row < ML ? xin + (size_t)row * D : cin + (size_t)(row - ML) * D;
            float* xd = row < ML ? xout + (size_t)row * D : cout + (size_t)(row - ML) * D;
            f32x4 x[8];
#pragma unroll
            for (int j = 0; j < 8; ++j) x[j] = *(const f32x4*)(xs + 4 * lane + 256 * j);
            if (MODE != 0) {
                f32x4 y[8]; float ss = 0.f;
#pragma unroll
                for (int j = 0; j < 8; ++j) {
                    if (row < ML) { const u32x2 w = *(const u32x2*)(Y + (size_t)row * D + 4 * lane + 256 * j); y[j] = (f32x4){bf_lo(w.x), bf_hi(w.x), bf_lo(w.y), bf_hi(w.y)}; }
                    else { const float* yp = YP + (size_t)(row - ML) * D + 4 * lane + 256 * j; f32x4 s = *(const f32x4*)yp;
#pragma unroll
                        for (int ks = 1; ks < 8; ++ks) s += *(const f32x4*)(yp + (size_t)ks * MC * D);
                        y[j] = s; }
                    ss += (y[j].x * y[j].x + y[j].y * y[j].y) + (y[j].z * y[j].z + y[j].w * y[j].w); }
                const float rstd = rsqrtf(wave_sum(ss) * (1.f / D) + NORM_EPS);
#pragma unroll
                for (int j = 0; j < 8; ++j) { const f32x4 gp = *(const LAS f32x4*)(V + 4 * lane + 256 * j), gt = *(const LAS f32x4*)(V + 2 * D + 4 * lane + 256 * j);
                    x[j] = x[j] + gt * (y[j] * rstd * gp);
                    *(f32x4*)(xd + 4 * lane + 256 * j) = x[j]; }
            }
            if (MODE != 2) {
                float ss = 0.f;
#pragma unroll
                for (int j = 0; j < 8; ++j) ss += (x[j].x * x[j].x + x[j].y * x[j].y) + (x[j].z * x[j].z + x[j].w * x[j].w);
                const float rstd = rsqrtf(wave_sum(ss) * (1.f / D) + NORM_EPS);
#pragma unroll
                for (int j = 0; j < 8; ++j) { const f32x4 gp = *(const LAS f32x4*)(V + D + 4 * lane + 256 * j), sh = *(const LAS f32x4*)(V + 3 * D + 4 * lane + 256 * j), sc = *(const LAS f32x4*)(V + 4 * D + 4 * lane + 256 * j);
                    const f32x4 h = sh + sc * (x[j] * rstd * gp);
                    u32x2 w; w.x = cvt_pk_bf16(h.x, h.y); w.y = cvt_pk_bf16(h.z, h.w);
                    *(u32x2*)(XN + (size_t)row * D + 4 * lane + 256 * j) = w; }
            }
        }
    }
    __syncthreads();
}

__device__ __forceinline__ void conv_pass(const Args& a, int l, int wk, int nwk, int lane) {
    bf16_t* P = (bf16_t*)(a.ws + WS_P);
    const int c = (wk & 1) * 512 + 8 * lane;
    const float* cw = a.in[I_CONVW] + (size_t)l * 3 * 1024 + c;
    float w0[8], w1[8], w2[8];
#pragma unroll
    for (int i = 0; i < 8; ++i) { w0[i] = cw[i]; w1[i] = cw[1024 + i]; w2[i] = cw[2048 + i]; }
    for (int it = wk; it < (M / 16) * 8; it += nwk) {
        const int r0 = (it >> 3) * 16 + ((it >> 1) & 3) * 4;
        const int s0 = r0 < ML ? (r0 / SEQ) * SEQ : ML + ((r0 - ML) / CTXL) * CTXL, s1 = s0 + (r0 < ML ? SEQ : CTXL);
        float u[6][8];
#pragma unroll
        for (int k = 0; k < 6; ++k) { const int r = r0 - 1 + k;
            if (r >= s0 && r < s1) { f32x4 c0, c1, v0, v1; pg8::unpack8(*(const u32x4*)(P + (size_t)r * NIN + C_AC + c), c0, c1); pg8::unpack8(*(const u32x4*)(P + (size_t)r * NIN + C_AV + c), v0, v1);
#pragma unroll
                for (int i = 0; i < 4; ++i) { u[k][i] = c0[i] * v0[i]; u[k][4 + i] = c1[i] * v1[i]; } }
            else {
#pragma unroll
                for (int i = 0; i < 8; ++i) u[k][i] = 0.f; } }
#pragma unroll
        for (int k = 0; k < 4; ++k) { bf16_t* pb = P + (size_t)(r0 + k) * NIN + C_AB + c; f32x4 b0, b1; pg8::unpack8(*(const u32x4*)pb, b0, b1);
#pragma unroll
            for (int i = 0; i < 4; ++i) { b0[i] *= w0[i] * u[k][i] + w1[i] * u[k + 1][i] + w2[i] * u[k + 2][i]; b1[i] *= w0[4 + i] * u[k][4 + i] + w1[4 + i] * u[k + 1][4 + i] + w2[4 + i] * u[k + 2][4 + i]; }
            *(u32x4*)pb = pg8::pack8(b0, b1); }
    }
}
__device__ __forceinline__ void qk_pass(const Args& a, int l, int gw, int NGW, int lane) {
    bf16_t* P = (bf16_t*)(a.ws + WS_P);
    const float* ROPE = (const float*)(a.ws + WS_ROPE);
    const int j = lane & 15, hq = lane >> 4;
    float gq_[8], gk_[8];
#pragma unroll
    for (int i = 0; i < 8; ++i) { gq_[i] = a.in[I_QG][l * 128 + 8 * j + i]; gk_[i] = a.in[I_KG][l * 128 + 8 * j + i]; }
    for (int row = gw; row < M; row += NGW) {
        const bool lat = row < ML; const int t = row % SEQ, pos = (j < 8) ? (t >> 6) : (t & 63);
        float cs[8], sn[8];
        if (lat) {
#pragma unroll
            for (int i = 0; i < 8; ++i) { cs[i] = ROPE[pos * 32 + 8 * (j & 3) + i]; sn[i] = ROPE[4096 + pos * 32 + 8 * (j & 3) + i]; } }
#pragma unroll
        for (int st = 0; st < 3; ++st) {
            const bool act = st < 2 || hq < 2;
            bf16_t* p = P + (size_t)row * NIN + (st < 2 ? C_Q + (st * 4 + hq) * 128 : C_K + (hq & 1) * 128) + 8 * j;
            f32x4 v0 = {0.f, 0.f, 0.f, 0.f}, v1 = {0.f, 0.f, 0.f, 0.f};
            if (act) pg8::unpack8(*(const u32x4*)p, v0, v1);
            float x[8] = {v0[0], v0[1], v0[2], v0[3], v1[0], v1[1], v1[2], v1[3]};
            float ss = 0.f;
#pragma unroll
            for (int i = 0; i < 8; ++i) ss += x[i] * x[i];
            ss += __shfl_xor(ss, 1); ss += __shfl_xor(ss, 2); ss += __shfl_xor(ss, 4); ss += __shfl_xor(ss, 8);
            const float rstd = rsqrtf(ss * (1.f / 128.f) + NORM_EPS);
#pragma unroll
            for (int i = 0; i < 8; ++i) x[i] = x[i] * rstd * (st < 2 ? gq_[i] : gk_[i]);
            if (lat) {
#pragma unroll
                for (int i = 0; i < 8; ++i) { const float pr = __shfl_xor(x[i], 4); x[i] = x[i] * cs[i] + ((j & 4) ? pr : -pr) * sn[i]; } }
            if (act) *(u32x4*)p = pg8::pack8((f32x4){x[0], x[1], x[2], x[3]}, (f32x4){x[4], x[5], x[6], x[7]});
        }
    }
}
__device__ __forceinline__ void ssm_scan(const Args& a, int l, int bid, int G, int wave, int lane) {
    const float* S = (const float*)(a.ws + WS_S); bf16_t* As = (bf16_t*)(a.ws + WS_ASSM); const float* ETAB = (const float*)(a.ws + WS_ETAB);
    for (int ch = bid + G * wave; ch < NBATCH * SG * 2; ch += G * 8) {
        const int dir = ch & 1, gq = (ch >> 1) % SG, b = ch / (2 * SG);
        const float* e = ETAB + ((((size_t)(l * SG + gq) * 2 + dir) * 64 + lane) * 66 + 64);
        const float ar = e[0], ai = e[1];
        float hr = 0.f, hi = 0.f;
        for (int s0 = 0; s0 < 264; s0 += 8) {
            float sr[8], si[8]; int rows[8];
#pragma unroll
            for (int k = 0; k < 8; ++k) { const int s = s0 + k; int row;
                if (s < 8) row = 1024 + 8 * b + (dir == 0 ? s : 7 - s); else row = 256 * b + (dir == 0 ? s - 8 : 263 - s);
                rows[k] = row; const float* sp = S + ((size_t)(gq * SGR + row) * 256 + dir * 128 + lane); sr[k] = sp[0]; si[k] = sp[64]; }
#pragma unroll
            for (int k = 0; k < 8; ++k) { bf16_t* hp = As + ((size_t)(gq * SGR + rows[k]) * 768 + 512 + dir * 128 + lane);
                hp[0] = (bf16_t)(cvt_pk_bf16(hr, 0.f) & 0xffffu); hp[64] = (bf16_t)(cvt_pk_bf16(hi, 0.f) & 0xffffu);
                const float nr = ar * hr - ai * hi + sr[k], ni = ar * hi + ai * hr + si[k]; hr = nr; hi = ni; }
        }
    }
}

typedef const __attribute__((address_space(4))) unsigned long long* KArgP;
__device__ __forceinline__ Args load_args() {
    KArgP p = (KArgP)__builtin_amdgcn_kernarg_segment_ptr(); asm volatile("" : "+s"(p));
    Args r;
#pragma unroll
    for (int i = 0; i < 28; ++i) r.in[i] = (const float*)(const GAS float*)p[i];
    r.out = (float*)(GAS float*)p[28]; r.ws = (unsigned char*)(GAS unsigned char*)p[29]; const unsigned long long lh = p[30]; r.lo = (int)(unsigned)lh; r.hi = (int)(unsigned)(lh >> 32);
    return r;
}
__global__ void __launch_bounds__(512, 2) hybrid_fwd(Args ka) {
    extern __shared__ __attribute__((aligned(16))) unsigned char lds_raw[];
    LAS unsigned char* lds = (LAS unsigned char*)lds_raw;
    volatile LAS unsigned* MISC = (volatile LAS unsigned*)(lds + MISC_OFF);
    const int G = gridDim.x, bid = blockIdx.x;
    if (threadIdx.x < 64) MISC[threadIdx.x] = 0u;
    __syncthreads();
    XcdBarrier bar; bar.bar = (unsigned*)(ka.ws + WS_CTL) + CW_BAR; bar.x = 0; bar.st = nullptr;
    if (ka.hi - ka.lo > 1) bar = xcd_barrier_post((unsigned*)(ka.ws + WS_CTL) + CW_BAR, MISC + 8);
#define PH(k) (ka.lo <= (k) && (k) < ka.hi)
#define SEAM(k) do { if ((k) + 1 < ka.hi) xcd_barrier(bar); } while (0)
#define PHASE_ARGS const Args a = load_args(); unsigned char* const ws = a.ws; (void)ws; \
    int tid_ = threadIdx.x; asm volatile("" : "+v"(tid_)); const int tid = tid_, lane = tid & 63, wave = __builtin_amdgcn_readfirstlane(tid >> 6); \
    const int gw = bid * 8 + wave, NGW = G * 8, gtid = bid * 512 + tid, NTHR = G * 512; (void)lane; (void)gw; (void)NGW; (void)gtid; (void)NTHR; \
    bf16_t* const P = (bf16_t*)(ws + WS_P); bf16_t* const XN = (bf16_t*)(ws + WS_XN); bf16_t* const MX = (bf16_t*)(ws + WS_MX); bf16_t* const UP = (bf16_t*)(ws + WS_UP); \
    bf16_t* const ASSM = (bf16_t*)(ws + WS_ASSM); float* const SST = (float*)(ws + WS_S); float* const CTXR = (float*)(ws + WS_CTXR); float* const MOD = (float*)(ws + WS_MOD); \
    (void)P; (void)XN; (void)MX; (void)UP; (void)ASSM; (void)SST; (void)CTXR; (void)MOD;

    if (PH(0)) { PHASE_ARGS
        float* ROPE = (float*)(ws + WS_ROPE);
        for (int idx = gtid; idx < 4096; idx += NTHR) { const int pos = idx >> 5, i = idx & 31; const double inv = exp(-(double)i * (9.210340371976184 / 32.0)); double s, c; sincos((double)pos * inv, &s, &c); ROPE[idx] = (float)c; ROPE[4096 + idx] = (float)s; }
        ssm_tables_t1(a, gtid, NTHR);
        mod_gemv(a, lds, bid, G, tid, wave, lane);
        __syncthreads();
        convert_weights(a, 0, lds, gw, NGW, wave, lane);
        SEAM(0);
    }
    if (PH(1)) { PHASE_ARGS
        ssm_tables_t2(a, lds, bid, G, tid);
        row_pass<0>(lds, bid, G, tid, wave, lane, a.in[I_X], a.out, a.in[I_CTX], CTXR, MX, (const float*)(ws + WS_PART), M, XN, a.in[I_GPREMIX], a.in[I_GPREMIX], MOD, 0, MOD, 0, D);
        SEAM(1);
    }
    for (int l = 0; l < DEPTH; ++l) {
        const int pb = 2 + 12 * l;
        const int Meff = l + 1 < DEPTH ? M : ML;
        if (PH(pb + 0)) { PHASE_ARGS
            ssm_fill(a, l, lds, bid, G, tid);
            pg8::Gemm g{XN, (const bf16_t*)(ws + WS_WIN), D, D, D}; pg8::StaticOrder S; S.init(M, NIN, D, G, bid);
            pg8::EpiProj E{P, ASSM};
            for (int rep = 0; rep < REP_BIG; ++rep) pg8::gemm_phase(lds, g, S, E);
            SEAM(pb + 0);
        }
        if (PH(pb + 1)) { PHASE_ARGS
            { pg8::Gemm g{ASSM, (const bf16_t*)(ws + WS_W1), 768, 512, 512}; pg8::GroupOrder S; S.init(1, 512, G, bid); pg8::EpiState E{SST}; pg8::gemm_phase(lds, g, S, E); }
            SEAM(pb + 1);
        }
        if (PH(pb + 2)) { PHASE_ARGS
            if (wave < 2) ssm_scan(a, l, bid, G, wave, lane);
            else { const int wk = bid * 6 + (wave - 2), nwk = G * 6; conv_pass(a, l, wk, nwk, lane); qk_pass(a, l, wk, nwk, lane); }
            SEAM(pb + 2);
        }
        if (PH(pb + 3)) { PHASE_ARGS
            { pg8::Gemm g{ASSM, (const bf16_t*)(ws + WS_W3), 768, 768, 768}; pg8::GroupOrder S; S.init(2, 768, G, bid); pg8::EpiSsmY E{P}; pg8::gemm_phase(lds, g, S, E); }
            for (int rep = 0; rep < REP_ATT; ++rep)
            for (int u = bid; u < (l + 1 < DEPTH ? 1056 : 1024); u += G) {
                const bool lat = u < 1024; int b, hq, qb;
                if (lat) { const int xcd = u & 7, idx = (u >> 3) & 31, rnd = u >> 8; b = xcd >> 1; hq = (xcd & 1) * 4 + (idx >> 3); qb = (idx & 7) + 8 * rnd; }
                else { const int c = u - 1024; b = c >> 3; hq = c & 7; qb = 0; }
                const int kvh = hq >> 2;
                const size_t r0 = lat ? (size_t)b * SEQ + (size_t)qb * 256 : (size_t)(ML + b * CTXL);
                const bf16_t* Kc = P + (size_t)(ML + b * CTXL) * NIN + C_K + kvh * 128;
                const bf16_t* Kl = P + (size_t)b * SEQ * NIN + C_K + kvh * 128;
                attn::attn_unit(P + r0 * NIN + C_Q + hq * 128, Kc, Kl, P + r0 * NIN + C_O + hq * 128, CTXL, lat ? CTXL + SEQ : CTXL, (char*)lds_raw);
            }
            SEAM(pb + 3);
        }
        if (PH(pb + 4)) { PHASE_ARGS pg8::Gemm g{P + C_AB, (const bf16_t*)(ws + WS_WCO), NIN, 1024, 1024}; pg8::StaticOrder S; S.init(Meff, D, 1024, G, bid); pg8::EpiMerge<false> E{XN, P, C_GC}; pg8::gemm_phase(lds, g, S, E); SEAM(pb + 4); }
        if (PH(pb + 5)) { PHASE_ARGS pg8::Gemm g{P + C_Y, (const bf16_t*)(ws + WS_WGLU), NIN, 768, 768}; pg8::StaticOrder S; S.init(Meff, 4096, 768, G, bid); pg8::EpiGlu E{XN, P}; pg8::gemm_phase(lds, g, S, E); SEAM(pb + 5); }
        if (PH(pb + 6)) { PHASE_ARGS pg8::Gemm g{P + C_O, (const bf16_t*)(ws + WS_WAO), NIN, 1024, 1024}; pg8::StaticOrder S; S.init(Meff, D, 1024, G, bid); pg8::EpiMerge<true> E{XN, P, C_GA}; pg8::gemm_phase(lds, g, S, E); SEAM(pb + 6); }
        if (PH(pb + 7)) { PHASE_ARGS pg8::Gemm g{XN, (const bf16_t*)(ws + WS_WOUT), D, D, D}; pg8::SplitCtxOrder S; S.init(D, D, G, bid, l + 1 < DEPTH); pg8::EpiBf16Part E{MX, (float*)(ws + WS_PART)}; pg8::gemm_phase(lds, g, S, E); SEAM(pb + 7); }
        if (PH(pb + 8)) { PHASE_ARGS
            const float* modl = MOD + (size_t)l * 5 * NMOD;
            row_pass<1>(lds, bid, G, tid, wave, lane, l == 0 ? a.in[I_X] : a.out, a.out, l == 0 ? a.in[I_CTX] : CTXR, CTXR, MX, (const float*)(ws + WS_PART), Meff, XN, a.in[I_GPOSTMIX] + l * D, a.in[I_GPREMLP] + l * D, modl, 2 * D, modl, 3 * D, 4 * D);
            SEAM(pb + 8);
        }
        if (PH(pb + 9)) { PHASE_ARGS pg8::Gemm g{XN, (const bf16_t*)(ws + WS_WUP), D, D, D}; pg8::StaticOrder S; S.init(Meff, FF, D, G, bid); pg8::EpiBf16<1> E{UP, FF}; for (int rep = 0; rep < REP_BIG; ++rep) pg8::gemm_phase(lds, g, S, E); SEAM(pb + 9); }
        if (PH(pb + 10)) { PHASE_ARGS pg8::Gemm g{UP, (const bf16_t*)(ws + WS_WDN), FF, FF, FF}; pg8::SplitCtxOrder S; S.init(D, FF, G, bid, l + 1 < DEPTH); pg8::EpiBf16Part E{MX, (float*)(ws + WS_PART)}; for (int rep = 0; rep < REP_BIG; ++rep) pg8::gemm_phase(lds, g, S, E); SEAM(pb + 10); }
        if (PH(pb + 11)) { PHASE_ARGS
            const float* modl = MOD + (size_t)l * 5 * NMOD;
            if (l + 1 < DEPTH) {
                row_pass<1>(lds, bid, G, tid, wave, lane, a.out, a.out, CTXR, CTXR, MX, (const float*)(ws + WS_PART), M, XN, a.in[I_GPOSTMLP] + l * D, a.in[I_GPREMIX] + (l + 1) * D, modl, 5 * D, modl + 5 * NMOD, 0, D);
                convert_weights(a, l + 1, lds, gw, NGW, wave, lane);
                SEAM(pb + 11);
            } else {
                row_pass<2>(lds, bid, G, tid, wave, lane, a.out, a.out, CTXR, CTXR, MX, (const float*)(ws + WS_PART), ML, XN, a.in[I_GPOSTMLP] + l * D, a.in[I_GPOSTMLP] + l * D, modl, 5 * D, modl, 0, 0);
            }
        }
    }
#undef PH
#undef PHASE_ARGS
#undef SEAM
}

constexpr int N_PHASES = 2 + 12 * DEPTH;
extern "C" void kernel_launch(void* const* d_in, const int* in_sizes, int n_in, void* d_out, int out_size, void* d_ws, size_t ws_size, hipStream_t stream) {
    static int grid = 0;
    if (grid == 0) {
        if (n_in != 28 || in_sizes[0] != ML * D || out_size != ML * D || ws_size < WS_END) { fprintf(stderr, "kernel_launch: shape/workspace mismatch (n_in %d, ws %zu < %zu?)\n", n_in, ws_size, (size_t)WS_END); grid = -1; return; }
        int dev = 0, cus = 0, per_cu = 0;
        if (hipGetDevice(&dev) != hipSuccess || hipDeviceGetAttribute(&cus, hipDeviceAttributeMultiprocessorCount, dev) != hipSuccess) { grid = -1; return; }
        if (hipFuncSetAttribute((const void*)hybrid_fwd, hipFuncAttributeMaxDynamicSharedMemorySize, LDS_BYTES) != hipSuccess) { fprintf(stderr, "kernel_launch: hipFuncSetAttribute failed\n"); grid = -1; return; }
        if (hipOccupancyMaxActiveBlocksPerMultiprocessor(&per_cu, (const void*)hybrid_fwd, 512, LDS_BYTES) != hipSuccess || per_cu < 1) { fprintf(stderr, "kernel_launch: occupancy query says %d blocks per CU\n", per_cu); (void)hipGetLastError(); if (per_cu < 1) { grid = -1; return; } }
        grid = cus;
    }
    if (grid < 0) return;
    if (hipMemsetAsync((char*)d_ws + WS_CTL, 0, CTL_ZERO_BYTES, stream) != hipSuccess) return;
    Args a{};
    for (int i = 0; i < 28; ++i) a.in[i] = (const float*)d_in[i];
    a.out = (float*)d_out; a.ws = (unsigned char*)d_ws;
#if MK_PER_PHASE
    for (int p = 0; p < N_PHASES; ++p) { a.lo = p; a.hi = p + 1; hipLaunchKernelGGL(hybrid_fwd, dim3(grid), dim3(512), LDS_BYTES, stream, a); }
#else
    a.lo = 0; a.hi = N_PHASES;
    hipLaunchKernelGGL(hybrid_fwd, dim3(grid), dim3(512), LDS_BYTES, stream, a);
#endif
    const hipError_t le = hipPeekAtLastError();
    if (le != hipSuccess) fprintf(stderr, "kernel_launch: launch failed: %s\n", hipGetErrorName(le));
}
```

```cpp
#include <hip/hip_runtime.h>
#include <cstdio>
#include <cstdint>
#include <cmath>

#ifndef MK_PER_PHASE
#define MK_PER_PHASE 0
#endif
#ifndef REP_BIG
#define REP_BIG 1
#endif
#ifndef REP_ATT
#define REP_ATT 1
#endif

#define LAS __attribute__((address_space(3)))
#define GAS __attribute__((address_space(1)))
typedef unsigned short bf16_t;
typedef short bf16x8 __attribute__((ext_vector_type(8)));
typedef short s16x4 __attribute__((ext_vector_type(4)));
typedef float f32x2 __attribute__((ext_vector_type(2)));
typedef float f32x4 __attribute__((ext_vector_type(4)));
typedef float f32x16 __attribute__((ext_vector_type(16)));
typedef unsigned u32x2 __attribute__((ext_vector_type(2)));
typedef unsigned u32x4 __attribute__((ext_vector_type(4)));
typedef GAS unsigned gu32;

constexpr int D = 2048, NBATCH = 4, SEQ = 8192, CTXL = 256, DEPTH = 4;
constexpr int ML = NBATCH * SEQ, MC = NBATCH * CTXL, M = ML + MC;
constexpr int NIN = 11520, FF = 8192, NMOD = 6 * D;
constexpr int C_AB = 0, C_AC = 1024, C_AV = 2048, C_SU = 3072, C_Q = 3840, C_K = 4864, C_V = 5120, C_GC = 5376, C_GS = 7424, C_GA = 9472;
constexpr int C_O = C_AC, C_Y = C_SU;
constexpr int SG = 48, SGR = 1280, SGV = 1056;
constexpr float NORM_EPS = 1e-6f;

constexpr size_t MiB = 1u << 20;
constexpr size_t WS_CTL = 0, CTL_ZERO_BYTES = 1 * MiB;
constexpr size_t WS_MOD = 1 * MiB;
constexpr size_t WS_ROPE = 2 * MiB;
constexpr size_t WS_ETAB = 3 * MiB;
constexpr size_t WS_BB = 10 * MiB;
constexpr size_t WS_MT = 13 * MiB;
constexpr size_t WS_CTXR = 25 * MiB;
constexpr size_t WS_WIN = 33 * MiB, WS_WCO = 78 * MiB, WS_WGLU = 82 * MiB, WS_WAO = 88 * MiB, WS_WOUT = 92 * MiB, WS_WUP = 100 * MiB, WS_WDN = 132 * MiB;
constexpr size_t WS_W1 = 164 * MiB, WS_W3 = 176 * MiB;
constexpr size_t WS_XN = 212 * MiB, WS_MX = 344 * MiB, WS_ASSM = 476 * MiB, WS_S = 566 * MiB, WS_P = 626 * MiB;
constexpr size_t WS_PART = WS_P + (size_t)M * NIN * 2 + MiB;
constexpr size_t WS_END = WS_PART + (size_t)8 * MC * D * 4;
constexpr size_t WS_UP = WS_P;
static_assert((size_t)M * FF * 2 <= (size_t)M * NIN * 2, "UP overlay");
constexpr int CW_BAR = 4096;

constexpr int LDS_BYTES = 147456, MISC_OFF = LDS_BYTES - 256;

#define RLX_AGENT __ATOMIC_RELAXED, __HIP_MEMORY_SCOPE_AGENT
#define LDS_WAIT() asm volatile("s_waitcnt lgkmcnt(0)" ::: "memory")
__device__ __forceinline__ unsigned cvt_pk_bf16(float lo, float hi) { unsigned r; asm volatile("v_cvt_pk_bf16_f32 %0, %1, %2" : "=v"(r) : "v"(lo), "v"(hi)); return r; }
__device__ __forceinline__ float bf_lo(unsigned w) { return __uint_as_float(w << 16); }
__device__ __forceinline__ float bf_hi(unsigned w) { return __uint_as_float(w & 0xffff0000u); }
__device__ __forceinline__ float wave_sum(float v) {
#pragma unroll
    for (int o = 1; o < 64; o <<= 1) v += __shfl_xor(v, o);
    return v;
}
__device__ __forceinline__ float sigmoidf_(float x) { return __builtin_amdgcn_rcpf(1.0f + __builtin_amdgcn_exp2f(-1.4426950408889634f * x)); }
__device__ __forceinline__ float gelu_tanh(float x) { const float u = 0.7978845608028654f * (x + 0.044715f * x * x * x); return x * sigmoidf_(2.0f * u); }

#define XB_TMO      128
#define XB_XCNT(j)  (256  + 64 * (j))
#define XB_XSUB(j)  (1280 + 64 * (j))
#define XB_XGEN(j)  (2304 + 64 * (j))
#define XB_TOP      3328
#define XB_TOPGEN   3392
#define XCD_BAR_WORDS 3456
#define XB_SPIN_CAP (1u << 22)
__device__ __forceinline__ unsigned xb_ld(unsigned* p)              { return __hip_atomic_load(p, __ATOMIC_RELAXED, __HIP_MEMORY_SCOPE_AGENT); }
__device__ __forceinline__ unsigned xb_add(unsigned* p, unsigned v) { return __hip_atomic_fetch_add(p, v, __ATOMIC_RELAXED, __HIP_MEMORY_SCOPE_AGENT); }
__device__ __forceinline__ unsigned xb_xcc_id() { return (unsigned)__builtin_amdgcn_s_getreg((3 << 11) | 20) & 0xFu; }
#define XB_SPIN(cond, bar) do { unsigned _sp = 0; while (cond) { __builtin_amdgcn_s_sleep(1); \
    if ((++_sp & 255u) == 0u) { if (xb_ld(&(bar)[XB_TMO])) break; if (_sp > XB_SPIN_CAP) { atomicAdd(&(bar)[XB_TMO], 1u); break; } } } } while (0)
struct XcdBarrier { unsigned* bar; unsigned x; volatile LAS unsigned* st; };
__device__ __forceinline__ XcdBarrier xcd_barrier_post(unsigned* bar, volatile LAS unsigned* st) {
    XcdBarrier b; b.bar = bar; b.x = xb_xcc_id(); b.st = st;
    if (threadIdx.x == 0) (void)xb_add(&bar[XB_XCNT(b.x)], 1u);
    return b;
}
__device__ __forceinline__ void xcd_barrier_complete(unsigned* bar, unsigned x, unsigned& nloc, unsigned& nx) {
    const unsigned G = gridDim.x * gridDim.y * gridDim.z;
    unsigned sum, cnt, mine, sp = 0u;
    for (;;) {
        sum = 0u; cnt = 0u; mine = 0u;
#pragma unroll
        for (unsigned j = 0; j < 16; ++j) { const unsigned c = xb_ld(&bar[XB_XCNT(j)]); sum += c; cnt += (c > 0u) ? 1u : 0u; mine = (j == x) ? c : mine; }
        if (sum == G) break;
        __builtin_amdgcn_s_sleep(1);
        if ((++sp & 255u) == 0u) { if (xb_ld(&bar[XB_TMO])) break; if (sp > XB_SPIN_CAP) { atomicAdd(&bar[XB_TMO], 1u); break; } }
    }
    nloc = mine > 0u ? mine : 1u; nx = cnt > 0u ? cnt : 1u;
}
__device__ __forceinline__ void xcd_barrier(const XcdBarrier& b) {
    asm volatile("s_waitcnt vmcnt(0)" ::: "memory");
    __syncthreads();
    if (threadIdx.x == 0) {
        unsigned* bar = b.bar;
        __builtin_amdgcn_s_waitcnt(0);
        unsigned nloc = b.st[0], nx = b.st[1];
        if (nloc == 0u) { xcd_barrier_complete(bar, b.x, nloc, nx); b.st[0] = nloc; b.st[1] = nx; }
        const unsigned old = xb_add(&bar[XB_XSUB(b.x)], 1u);
        const unsigned gen = old / nloc;
        if (old + 1u == (gen + 1u) * nloc) {
            __builtin_amdgcn_fence(__ATOMIC_RELEASE, "agent");
            asm volatile("s_waitcnt vmcnt(0)" ::: "memory");
            const unsigned og = xb_add(&bar[XB_TOP], 1u);
            const unsigned tg = og / nx;
            if (og + 1u == (tg + 1u) * nx) xb_add(&bar[XB_TOPGEN], 1u);
            else XB_SPIN(xb_ld(&bar[XB_TOPGEN]) == tg, bar);
            __builtin_amdgcn_fence(__ATOMIC_ACQUIRE, "agent");
            xb_add(&bar[XB_XGEN(b.x)], 1u);
            asm volatile("s_waitcnt vmcnt(0)" ::: "memory");
        } else {
            XB_SPIN(xb_ld(&bar[XB_XGEN(b.x)]) == gen, bar);
            __builtin_amdgcn_fence(__ATOMIC_ACQUIRE, "agent");
            asm volatile("s_waitcnt vmcnt(0)" ::: "memory");
        }
    }
    __syncthreads();
}

namespace pg8 {
constexpr int BM = 256, BK = 64, HALF = 128, HTB = HALF * BK * 2, STAGE_BYTES = 8 * HTB, NXCD = 8, WGM = 8;
__host__ __device__ __forceinline__ int lds_byte(int r, int c) { const int st = (r >> 4) * 2 + (c >> 5), rr = r & 15, cc = c & 31, ob = rr * 64 + cc * 2; return st * 1024 + (ob ^ (((ob >> 9) & 1) << 5)); }
__host__ __device__ __forceinline__ void stage_rc(int b, int& R, int& C) { const int st = b / 1024, sb = b % 1024, swz = sb ^ (((sb >> 9) & 1) << 5); R = (st >> 1) * 16 + swz / 64; C = (st & 1) * 32 + (swz % 64) / 2; }
__host__ __device__ __forceinline__ int perm32(int rho) { const int n = rho >> 4, i = rho & 15; return 8 * (i >> 2) + 4 * n + (i & 3); }
struct Unit { int pm, pn, koff, nt, kind; };
struct Gemm { const bf16_t* A; const bf16_t* Bt; int lda, ldb, K; };
struct StaticOrder {
    int nM, nN, nwg, G, c, ntk;
    __device__ __forceinline__ void init(int M_, int N_, int K_, int G_, int c_) { nM = M_ / BM; nN = N_ / BM; nwg = nM * nN; G = G_; c = c_; ntk = K_ / BK; }
    __device__ __forceinline__ bool next(int i, Unit& u) const {
        const long L = (long)i * G + c; if (L >= nwg) return false;
        u.koff = 0; u.nt = ntk; u.kind = 0;
        int wgid = (int)L; { const int q = nwg / NXCD, r = nwg % NXCD, xcd = wgid % NXCD, off = wgid / NXCD; wgid = (xcd < r ? xcd * (q + 1) : r * (q + 1) + (xcd - r) * q) + off; }
        const int nig = WGM * nN, gid = wgid / nig, fm = gid * WGM, gsz = (nM - fm) < WGM ? (nM - fm) : WGM;
        u.pm = fm + ((wgid % nig) % gsz); u.pn = (wgid % nig) / gsz; return true;
    }
};
struct GroupOrder {
    int nj, nunits, G, c, ntk;
    __device__ __forceinline__ void init(int nj_, int K_, int G_, int c_) { nj = nj_; nunits = SG * 5 * nj_; G = G_; c = c_; ntk = K_ / BK; }
    __device__ __forceinline__ bool next(int i, Unit& u) const {
        const int L = i * G + c; if (L >= nunits) return false;
        u.pm = L / nj; u.pn = (u.pm / 5) * nj + (L % nj); u.koff = 0; u.nt = ntk; u.kind = 0; return true;
    }
};
struct SplitCtxOrder {
    StaticOrder so; int nlat, nN, ntk8, kq, G, c; bool ctx;
    __device__ __forceinline__ void init(int N_, int K_, int G_, int c_, bool ctx_) { so.init(ML, N_, K_, G_, c_); nN = N_ / BM; G = G_; c = c_; ctx = ctx_; kq = K_ / 8; ntk8 = K_ / (8 * BK);
        nlat = c_ < so.nwg ? (so.nwg - c_ + G_ - 1) / G_ : 0; }
    __device__ __forceinline__ bool next(int i, Unit& u) const {
        Unit a; a.pm = 0; a.pn = 0; a.koff = 0; a.nt = 0; a.kind = 0;
        const bool la = so.next(i, a);
        const int L = (i - nlat) * G + c; const bool lc = ctx && !la && L >= 0 && L < 32 * nN;
        const int ks = L & 7;
        u.pm = la ? a.pm : ML / BM + (L >> 3) / nN; u.pn = la ? a.pn : (L >> 3) % nN; u.koff = la ? 0 : ks * kq; u.nt = la ? a.nt : ntk8; u.kind = la ? 0 : 1 + ks;
        return la || lc;
    }
};

template <class Epi, class Sched>
__device__ __forceinline__ void gemm_phase(LAS unsigned char* lds, const Gemm g, const Sched& S, const Epi& E) {
    int tid_ = threadIdx.x; asm volatile("" : "+v"(tid_));
    const int tid = tid_, wid = __builtin_amdgcn_readfirstlane(tid >> 6), lane = tid & 63, wr = wid >> 2, wc = wid & 3, fr = lane & 15, fq = lane >> 4;
    unsigned voffA[2], voffB[2];
#pragma unroll
    for (int i = 0; i < 2; ++i) { int R, C; stage_rc(tid * 16 + i * 8192, R, C); const int Rb = Epi::PERM ? ((R & ~31) + perm32(R & 31)) : R;
        voffA[i] = (unsigned)(R * g.lda + C) * 2u; voffB[i] = (unsigned)(Rb * g.ldb + C) * 2u; }
    const size_t kstep = (size_t)(BK * 2);
    const size_t hA = (size_t)HALF * g.lda * 2, hB = (size_t)HALF * g.ldb * 2, tA = 2 * hA, tB = 2 * hB;
    const unsigned ldsw = (unsigned)wid * 1024u;
    const int aoff = lds_byte(wr * 64 + fr, fq * 8), boff = lds_byte(wc * 32 + fr, fq * 8);
#define PG8_SA(b, h) (((b) * 2 + (h)) * HTB)
#define PG8_SB(b, h) ((4 + (b) * 2 + (h)) * HTB)
#define PG8_STAGE(bufoff, gbase, voff) do { _Pragma("unroll") for (int _i = 0; _i < 2; ++_i) \
        __builtin_amdgcn_global_load_lds((const unsigned*)((const char*)(gbase) + (voff)[_i]), (LAS unsigned*)(lds + (bufoff) + ldsw + _i * 8192), 16, 0, 0); } while (0)
#define PG8_LDA(dst, b, h) do { _Pragma("unroll") for (int m = 0; m < 4; ++m) _Pragma("unroll") for (int k = 0; k < 2; ++k) dst[m][k] = *(const LAS bf16x8*)(lds + PG8_SA(b, h) + aoff + m * 2048 + k * 1024); } while (0)
#define PG8_LDB(dst, b, h) do { _Pragma("unroll") for (int n = 0; n < 2; ++n) _Pragma("unroll") for (int k = 0; k < 2; ++k) dst[n][k] = *(const LAS bf16x8*)(lds + PG8_SB(b, h) + boff + n * 2048 + k * 1024); } while (0)
#define PG8_MMA(ai, bj, At, Bt) do { __builtin_amdgcn_s_setprio(1); _Pragma("unroll") for (int m = 0; m < 4; ++m) _Pragma("unroll") for (int n = 0; n < 2; ++n) _Pragma("unroll") for (int k = 0; k < 2; ++k) \
        acc[ai][bj][m][n] = __builtin_amdgcn_mfma_f32_16x16x32_bf16(Bt[n][k], At[m][k], acc[ai][bj][m][n], 0, 0, 0); __builtin_amdgcn_s_setprio(0); } while (0)
#define PG8_WAIT_V(n) asm volatile("s_waitcnt vmcnt(" #n ")" ::: "memory")
#define PG8_WAIT_L(n) asm volatile("s_waitcnt lgkmcnt(" #n ")" ::: "memory")
#define PG8_BAR __builtin_amdgcn_s_barrier()
#define PG8_SCHED __builtin_amdgcn_sched_barrier(0)
    Unit cur, nxt; int ui = 0;
    if (!S.next(0, cur)) return;
    f32x4 acc[2][2][4][2];
#pragma unroll
    for (int a = 0; a < 2; ++a)
#pragma unroll
        for (int b = 0; b < 2; ++b)
#pragma unroll
            for (int m = 0; m < 4; ++m)
#pragma unroll
                for (int n = 0; n < 2; ++n) acc[a][b][m][n] = (f32x4){0.f, 0.f, 0.f, 0.f};
    bf16x8 At[4][2], B0[2][2], B1[2][2];
    const char* cA = (const char*)g.A + (size_t)cur.pm * tA + (size_t)cur.koff * 2; const char* cB = (const char*)g.Bt + (size_t)cur.pn * tB + (size_t)cur.koff * 2;
    PG8_STAGE(PG8_SB(0, 0), cB, voffB); PG8_STAGE(PG8_SB(0, 1), cB + hB, voffB); PG8_STAGE(PG8_SA(0, 0), cA, voffA); PG8_STAGE(PG8_SA(0, 1), cA + hA, voffA);
    if (wr == 1) PG8_BAR;
    PG8_WAIT_V(2); PG8_BAR;
    PG8_STAGE(PG8_SB(1, 0), cB + kstep, voffB); PG8_STAGE(PG8_SA(1, 0), cA + kstep, voffA); PG8_STAGE(PG8_SB(1, 1), cB + hB + kstep, voffB);
    PG8_WAIT_V(6); PG8_BAR;
    for (;;) {
        const bool has_next = S.next(ui + 1, nxt);
        const char* nA = has_next ? (const char*)g.A + (size_t)nxt.pm * tA + (size_t)nxt.koff * 2 : cA; const char* nB = has_next ? (const char*)g.Bt + (size_t)nxt.pn * tB + (size_t)nxt.koff * 2 : cB;
        const int nt = cur.nt;
        for (int t = 0; t < nt; t += 2) {
            const bool last = (t == nt - 2);
            const char* a1 = cA + (size_t)(t + 1) * kstep;
            const char* a2 = last ? nA : cA + (size_t)(t + 2) * kstep; const char* b2 = last ? nB : cB + (size_t)(t + 2) * kstep;
            const char* a3 = a2 + kstep; const char* b3 = b2 + kstep;
            PG8_LDB(B0, 0, 0); PG8_LDB(B1, 0, 1); PG8_SCHED; PG8_LDA(At, 0, 0); PG8_STAGE(PG8_SA(1, 1), a1 + hA, voffA);
            PG8_WAIT_V(8); PG8_WAIT_L(0); PG8_BAR; PG8_MMA(0, 0, At, B0); PG8_MMA(0, 1, At, B1); PG8_BAR; PG8_SCHED;
            PG8_LDA(At, 0, 1); PG8_STAGE(PG8_SB(0, 0), b2, voffB); PG8_STAGE(PG8_SB(0, 1), b2 + hB, voffB); PG8_STAGE(PG8_SA(0, 0), a2, voffA);
            PG8_WAIT_V(8); PG8_WAIT_L(0); PG8_BAR; PG8_MMA(1, 0, At, B0); PG8_MMA(1, 1, At, B1); PG8_BAR; PG8_SCHED;
            PG8_LDB(B0, 1, 0); PG8_LDB(B1, 1, 1); PG8_SCHED; PG8_LDA(At, 1, 0); PG8_STAGE(PG8_SA(0, 1), a2 + hA, voffA);
            PG8_WAIT_V(8); PG8_WAIT_L(0); PG8_BAR; PG8_MMA(0, 0, At, B0); PG8_MMA(0, 1, At, B1); PG8_BAR; PG8_SCHED;
            PG8_LDA(At, 1, 1); PG8_STAGE(PG8_SB(1, 0), b3, voffB); PG8_STAGE(PG8_SB(1, 1), b3 + hB, voffB); PG8_STAGE(PG8_SA(1, 0), a3, voffA);
            PG8_WAIT_V(8); PG8_WAIT_L(0); PG8_BAR; PG8_MMA(1, 0, At, B0); PG8_MMA(1, 1, At, B1); PG8_BAR; PG8_SCHED;
        }
        if (wr == 0) PG8_BAR;
        E(acc, cur, wr, wc, fr, fq);
        if (!has_next) break;
#pragma unroll
        for (int a = 0; a < 2; ++a)
#pragma unroll
            for (int b = 0; b < 2; ++b)
#pragma unroll
                for (int m = 0; m < 4; ++m)
#pragma unroll
                    for (int n = 0; n < 2; ++n) acc[a][b][m][n] = (f32x4){0.f, 0.f, 0.f, 0.f};
        cur = nxt; cA = nA; cB = nB; ++ui;
        if (wr == 1) PG8_BAR;
    }
    PG8_WAIT_V(0);
    PG8_BAR;
#undef PG8_SA
#undef PG8_SB
#undef PG8_STAGE
#undef PG8_LDA
#undef PG8_LDB
#undef PG8_MMA
#undef PG8_WAIT_V
#undef PG8_WAIT_L
#undef PG8_BAR
#undef PG8_SCHED
}

typedef const f32x4 (&AccRef)[2][2][4][2];
__device__ __forceinline__ u32x4 pack8(const f32x4 v0, const f32x4 v1) { u32x4 w; w.x = cvt_pk_bf16(v0[0], v0[1]); w.y = cvt_pk_bf16(v0[2], v0[3]); w.z = cvt_pk_bf16(v1[0], v1[1]); w.w = cvt_pk_bf16(v1[2], v1[3]); return w; }
__device__ __forceinline__ void unpack8(const u32x4 w, f32x4& v0, f32x4& v1) { v0 = (f32x4){bf_lo(w.x), bf_hi(w.x), bf_lo(w.y), bf_hi(w.y)}; v1 = (f32x4){bf_lo(w.z), bf_hi(w.z), bf_lo(w.w), bf_hi(w.w)}; }

template <int ACT> struct EpiBf16 {
    static constexpr bool PERM = true;
    bf16_t* O; int ldc;
    __device__ __forceinline__ void operator()(AccRef acc, const Unit& u, int wr, int wc, int fr, int fq) const {
        const int row0 = u.pm * BM + wr * 64 + fr, col0 = u.pn * BM + wc * 32 + 8 * fq;
#pragma unroll
        for (int ai = 0; ai < 2; ++ai)
#pragma unroll
            for (int m = 0; m < 4; ++m) { bf16_t* rowp = O + (size_t)(row0 + ai * HALF + m * 16) * ldc + col0;
#pragma unroll
                for (int bj = 0; bj < 2; ++bj) { f32x4 v0 = acc[ai][bj][m][0], v1 = acc[ai][bj][m][1];
                    if (ACT == 1) {
#pragma unroll
                        for (int e = 0; e < 4; ++e) { const float a = fmaxf(v0[e], 0.f), b = fmaxf(v1[e], 0.f); v0[e] = a * a; v1[e] = b * b; } }
                    *(u32x4*)(rowp + bj * HALF) = pack8(v0, v1); } }
    }
};
struct EpiBf16Part {
    static constexpr bool PERM = true;
    bf16_t* O; float* PART;
    __device__ __forceinline__ void operator()(AccRef acc, const Unit& u, int wr, int wc, int fr, int fq) const {
        const int row0 = u.pm * BM + wr * 64 + fr, col0 = u.pn * BM + wc * 32 + 8 * fq;
        if (u.kind == 0) {
#pragma unroll
            for (int ai = 0; ai < 2; ++ai)
#pragma unroll
                for (int m = 0; m < 4; ++m) { bf16_t* rowp = O + (size_t)(row0 + ai * HALF + m * 16) * D + col0;
#pragma unroll
                    for (int bj = 0; bj < 2; ++bj) *(u32x4*)(rowp + bj * HALF) = pack8(acc[ai][bj][m][0], acc[ai][bj][m][1]); }
        } else {
            float* pb = PART + (size_t)(u.kind - 1) * MC * D;
#pragma unroll
            for (int ai = 0; ai < 2; ++ai)
#pragma unroll
                for (int m = 0; m < 4; ++m) { float* rowp = pb + (size_t)(row0 - ML + ai * HALF + m * 16) * D + col0;
#pragma unroll
                    for (int bj = 0; bj < 2; ++bj) { *(f32x4*)(rowp + bj * HALF) = acc[ai][bj][m][0]; *(f32x4*)(rowp + bj * HALF + 4) = acc[ai][bj][m][1]; } }
        }
    }
};
struct EpiProj {
    static constexpr bool PERM = true;
    bf16_t* P; bf16_t* Assm;
    __device__ __forceinline__ void operator()(AccRef acc, const Unit& u, int wr, int wc, int fr, int fq) const {
        const int row0 = u.pm * BM + wr * 64 + fr, col0 = u.pn * BM + wc * 32 + 8 * fq;
        if (u.pn >= 12 && u.pn < 15) {
#pragma unroll
            for (int ai = 0; ai < 2; ++ai)
#pragma unroll
                for (int m = 0; m < 4; ++m) { const int r = row0 + ai * HALF + m * 16;
#pragma unroll
                    for (int bj = 0; bj < 2; ++bj) { const int c = col0 + bj * HALF - C_SU, gq = c >> 4, p0 = c & 15;
                        bf16_t* dst = Assm + ((size_t)(gq * SGR + (r >> 5)) * 768 + (r & 31) * 16 + p0);
                        *(u32x4*)dst = pack8(acc[ai][bj][m][0], acc[ai][bj][m][1]); } }
        } else {
            const bool sg = u.pn >= 21;
#pragma unroll
            for (int ai = 0; ai < 2; ++ai)
#pragma unroll
                for (int m = 0; m < 4; ++m) { bf16_t* rowp = P + (size_t)(row0 + ai * HALF + m * 16) * NIN + col0;
#pragma unroll
                    for (int bj = 0; bj < 2; ++bj) { f32x4 v0 = acc[ai][bj][m][0], v1 = acc[ai][bj][m][1];
                        if (sg) {
#pragma unroll
                            for (int e = 0; e < 4; ++e) { v0[e] = sigmoidf_(v0[e]); v1[e] = sigmoidf_(v1[e]); } }
                        *(u32x4*)(rowp + bj * HALF) = pack8(v0, v1); } }
        }
    }
};
struct EpiState {
    static constexpr bool PERM = false;
    float* S;
    __device__ __forceinline__ void operator()(AccRef acc, const Unit& u, int wr, int wc, int fr, int fq) const {
        const int row0 = u.pm * BM + wr * 64 + fr, col0 = wc * 32 + 4 * fq;
#pragma unroll
        for (int ai = 0; ai < 2; ++ai)
#pragma unroll
            for (int m = 0; m < 4; ++m) { float* rowp = S + (size_t)(row0 + ai * HALF + m * 16) * 256 + col0;
#pragma unroll
                for (int bj = 0; bj < 2; ++bj)
#pragma unroll
                    for (int n = 0; n < 2; ++n) *(f32x4*)(rowp + bj * HALF + n * 16) = acc[ai][bj][m][n]; }
    }
};
struct EpiSsmY {
    static constexpr bool PERM = true;
    bf16_t* P;
    __device__ __forceinline__ void operator()(AccRef acc, const Unit& u, int wr, int wc, int fr, int fq) const {
        const int gq = u.pm / 5, rl0 = (u.pm % 5) * BM + wr * 64 + fr, cl0 = (u.pn & 1) * BM + wc * 32 + 8 * fq;
#pragma unroll
        for (int ai = 0; ai < 2; ++ai)
#pragma unroll
            for (int m = 0; m < 4; ++m) { const int rl = rl0 + ai * HALF + m * 16;
                if (rl < SGV) {
#pragma unroll
                    for (int bj = 0; bj < 2; ++bj) { const int cl = cl0 + bj * HALF, t = cl >> 4, p0 = cl & 15;
                        f32x4 v0 = acc[ai][bj][m][0], v1 = acc[ai][bj][m][1];
#pragma unroll
                        for (int e = 0; e < 4; ++e) { v0[e] = gelu_tanh(v0[e]); v1[e] = gelu_tanh(v1[e]); }
                        *(u32x4*)(P + (size_t)(rl * 32 + t) * NIN + C_Y + gq * 16 + p0) = pack8(v0, v1); } } }
    }
};
template <bool ACCUM> struct EpiMerge {
    static constexpr bool PERM = true;
    bf16_t* Mg; const bf16_t* P; int gcol;
    __device__ __forceinline__ void operator()(AccRef acc, const Unit& u, int wr, int wc, int fr, int fq) const {
        const int row0 = u.pm * BM + wr * 64 + fr, col0 = u.pn * BM + wc * 32 + 8 * fq;
#pragma unroll
        for (int ai = 0; ai < 2; ++ai)
#pragma unroll
            for (int m = 0; m < 4; ++m) { const size_t r = (size_t)(row0 + ai * HALF + m * 16);
#pragma unroll
                for (int bj = 0; bj < 2; ++bj) { const int c = col0 + bj * HALF;
                    f32x4 g0, g1; unpack8(*(const u32x4*)(P + r * NIN + gcol + c), g0, g1);
                    f32x4 v0 = acc[ai][bj][m][0] * g0, v1 = acc[ai][bj][m][1] * g1;
                    if (ACCUM) { f32x4 o0, o1; unpack8(*(const u32x4*)(Mg + r * D + c), o0, o1); v0 += o0; v1 += o1; }
                    *(u32x4*)(Mg + r * D + c) = pack8(v0, v1); } }
    }
};
struct EpiGlu {
    static constexpr bool PERM = true;
    bf16_t* Mg; const bf16_t* P;
    __device__ __forceinline__ void operator()(AccRef acc, const Unit& u, int wr, int wc, int fr, int fq) const {
        const int row0 = u.pm * BM + wr * 64 + fr, c = u.pn * HALF + wc * 32 + 8 * fq;
#pragma unroll
        for (int ai = 0; ai < 2; ++ai)
#pragma unroll
            for (int m = 0; m < 4; ++m) { const size_t r = (size_t)(row0 + ai * HALF + m * 16);
                f32x4 g0, g1; unpack8(*(const u32x4*)(P + r * NIN + C_GS + c), g0, g1);
                f32x4 o0, o1; unpack8(*(const u32x4*)(Mg + r * D + c), o0, o1);
                f32x4 a0 = acc[ai][0][m][0], a1 = acc[ai][0][m][1]; const f32x4 s0 = acc[ai][1][m][0], s1 = acc[ai][1][m][1];
#pragma unroll
                for (int e = 0; e < 4; ++e) { a0[e] = o0[e] + g0[e] * a0[e] * sigmoidf_(s0[e]); a1[e] = o1[e] + g1[e] * a1[e] * sigmoidf_(s1[e]); }
                *(u32x4*)(Mg + r * D + c) = pack8(a0, a1); }
    }
};
}

namespace attn {
constexpr int DH = 128, NW = 8, QBLK = 32, KVBLK = 64;
constexpr float SCALE = 0.088388347648318440f;
constexpr float THR = 8.f;
constexpr size_t SHM_V = KVBLK * DH * 2, SHM_K = KVBLK * DH * 2, SHM_ATTN = 2 * SHM_V + 2 * SHM_K + NW * 64 * 4;
#define KSWZ(row, colB) ((row) * 256 + ((colB) ^ (((row) & 7) << 4)))
#define SBAR() __builtin_amdgcn_sched_barrier(0)
__device__ __forceinline__ int crow(int r, int hi) { return (r & 3) + 8 * (r >> 2) + 4 * hi; }
__device__ __forceinline__ void partialSM(f32x16& p0, f32x16& p1, float& m_reg, float& mn, float& alpha) {
  constexpr float C = SCALE * 1.4426950408889634f;
  float pmax = p0[0];
#pragma unroll
  for (int r = 1; r < 16; ++r) pmax = fmaxf(pmax, p0[r]);
#pragma unroll
  for (int r = 0; r < 16; ++r) pmax = fmaxf(pmax, p1[r]);
  { auto rr = __builtin_amdgcn_permlane32_swap(__float_as_uint(pmax), __float_as_uint(pmax), false, false);
    pmax = fmaxf(__uint_as_float(rr[0]), __uint_as_float(rr[1])); }
  if (__builtin_expect(__all(pmax - m_reg <= THR / SCALE), 1)) { mn = m_reg; alpha = 1.f; }
  else { mn = fmaxf(m_reg, pmax); alpha = __builtin_amdgcn_exp2f((m_reg - mn) * C); m_reg = mn; }
  float mnC = -mn * C;
#pragma unroll
  for (int r = 0; r < 16; ++r) p0[r] = fmaf(p0[r], C, mnC);
#pragma unroll
  for (int r = 0; r < 16; ++r) p1[r] = fmaf(p1[r], C, mnC);
#pragma unroll
  for (int r = 0; r < 16; ++r) p0[r] = __builtin_amdgcn_exp2f(p0[r]);
}
__device__ __forceinline__ void finishSM(f32x16& p0, f32x16& p1, float alpha, float& l_reg, bf16x8& pa0, bf16x8& pa1, bf16x8& pa2, bf16x8& pa3) {
#pragma unroll
  for (int r = 0; r < 16; ++r) p1[r] = __builtin_amdgcn_exp2f(p1[r]);
  float ps = 0;
#pragma unroll
  for (int r = 0; r < 16; ++r) ps += p0[r];
#pragma unroll
  for (int r = 0; r < 16; ++r) ps += p1[r];
  { auto rr = __builtin_amdgcn_permlane32_swap(__float_as_uint(ps), __float_as_uint(ps), false, false);
    ps = __uint_as_float(rr[0]) + __uint_as_float(rr[1]); }
  l_reg = l_reg * alpha + ps;
#define PK4(P, BASE, OUT) do { unsigned a0 = cvt_pk_bf16(P[BASE + 0], P[BASE + 1]), a1 = cvt_pk_bf16(P[BASE + 2], P[BASE + 3]);   \
    unsigned b0 = cvt_pk_bf16(P[BASE + 4], P[BASE + 5]), b1 = cvt_pk_bf16(P[BASE + 6], P[BASE + 7]);                              \
    auto r0 = __builtin_amdgcn_permlane32_swap(a0, b0, false, false); auto r1 = __builtin_amdgcn_permlane32_swap(a1, b1, false, false); \
    u32x4 w = {r0[0], r1[0], r0[1], r1[1]}; OUT = *reinterpret_cast<bf16x8*>(&w); } while (0)
  PK4(p0, 0, pa0); PK4(p0, 8, pa1); PK4(p1, 0, pa2); PK4(p1, 8, pa3);
#undef PK4
}
__device__ __forceinline__ void qkt(f32x16& p0, f32x16& p1, const char* Ks, const bf16x8* qr, int r32, int hi) {
  p0 = f32x16{}; p1 = f32x16{};
#pragma unroll
  for (int d0 = 0; d0 < 8; ++d0) { int cb = (d0 * 16 + hi * 8) * 2;
    bf16x8 b0 = *reinterpret_cast<const bf16x8*>(Ks + KSWZ(r32, cb));
    bf16x8 b1 = *reinterpret_cast<const bf16x8*>(Ks + KSWZ(32 + r32, cb));
    p0 = __builtin_amdgcn_mfma_f32_32x32x16_bf16(b0, qr[d0], p0, 0, 0, 0);
    p1 = __builtin_amdgcn_mfma_f32_32x32x16_bf16(b1, qr[d0], p1, 0, 0, 0); }
}
__device__ __forceinline__ int v_st(int k, int c) { const int kk = (k & ~0xC) | ((k & 4) << 1) | ((k & 8) >> 1); return ((kk >> 3) * 4 + (c >> 5)) * 512 + ((kk & 7) * 32 + (c & 31)) * 2; }
__device__ __forceinline__ int v_rd_base(int lane) { return ((lane & 3) << 3) | (((lane >> 2) & 3) << 6) | (((lane >> 4) & 1) << 5) | (((lane >> 5) & 1) << 8); }
constexpr int v_rd_off(int d0, int ks, int half) { return d0 * 512 + ks * 4096 + half * 2048; }
template <int OFF> __device__ __forceinline__ s16x4 tr_read(int vb) {
  s16x4 r; asm volatile("ds_read_b64_tr_b16 %0, %1 offset:%2" : "=&v"(r) : "v"(vb), "i"(OFF) : "memory"); return r;
}
template <int D0> __device__ __forceinline__ void pv_one(f32x16& od, int vb, bf16x8 pa0, bf16x8 pa1, bf16x8 pa2, bf16x8 pa3) {
  const s16x4 l0 = tr_read<v_rd_off(D0, 0, 0)>(vb), h0 = tr_read<v_rd_off(D0, 0, 1)>(vb), l1 = tr_read<v_rd_off(D0, 1, 0)>(vb), h1 = tr_read<v_rd_off(D0, 1, 1)>(vb);
  const s16x4 l2 = tr_read<v_rd_off(D0, 2, 0)>(vb), h2 = tr_read<v_rd_off(D0, 2, 1)>(vb), l3 = tr_read<v_rd_off(D0, 3, 0)>(vb), h3 = tr_read<v_rd_off(D0, 3, 1)>(vb);
  asm volatile("s_waitcnt lgkmcnt(0)" ::: "memory"); SBAR();
#define PK(L, H) (bf16x8){L[0], L[1], L[2], L[3], H[0], H[1], H[2], H[3]}
  od = __builtin_amdgcn_mfma_f32_32x32x16_bf16(pa0, PK(l0, h0), od, 0, 0, 0);
  od = __builtin_amdgcn_mfma_f32_32x32x16_bf16(pa1, PK(l1, h1), od, 0, 0, 0);
  od = __builtin_amdgcn_mfma_f32_32x32x16_bf16(pa2, PK(l2, h2), od, 0, 0, 0);
  od = __builtin_amdgcn_mfma_f32_32x32x16_bf16(pa3, PK(l3, h3), od, 0, 0, 0);
#undef PK
}
__device__ __forceinline__ void pv_d0(f32x16* o, int vb, bf16x8 pa0, bf16x8 pa1, bf16x8 pa2, bf16x8 pa3) {
  pv_one<0>(o[0], vb, pa0, pa1, pa2, pa3); pv_one<1>(o[1], vb, pa0, pa1, pa2, pa3); pv_one<2>(o[2], vb, pa0, pa1, pa2, pa3); pv_one<3>(o[3], vb, pa0, pa1, pa2, pa3);
}
__device__ __forceinline__ void attn_unit(const bf16_t* __restrict__ Qb, const bf16_t* __restrict__ Kc, const bf16_t* __restrict__ Kl, bf16_t* __restrict__ Ob, int nkc, int seq, char* lds) {
  int tid_ = threadIdx.x; asm volatile("" : "+v"(tid_));
  const int tid = tid_, wid = tid >> 6, lane = tid & 63, r32 = lane & 31, hi = lane >> 5;
  char* V_lds = lds; char* K_lds = lds + 2 * SHM_V;
  float* ws = (float*)(lds + 2 * SHM_V + 2 * SHM_K) + wid * 64; float* li_l = ws; float* al_l = ws + 32;
  float m_reg = -1e30f, l_reg = 0; f32x16 o[4] = {}; bf16x8 qr[8];
  const bf16_t* Qw = Qb + (long)(wid * QBLK + r32) * NIN + hi * 8;
#pragma unroll
  for (int d0 = 0; d0 < 8; ++d0) qr[d0] = *reinterpret_cast<const bf16x8*>(Qw + d0 * 16);
  const int sr = tid >> 4, sc = (tid & 15) * 8, vst0 = v_st(sr, sc), vst1 = v_st(32 + sr, sc);
  const int vb0 = (int)(uintptr_t)V_lds + v_rd_base(lane);
  struct { bf16x8 vs0, vs1, ks0, ks1; } sr_[2];
#define KROWP(k0) (((k0) < nkc) ? (Kc + (long)(k0) * NIN) : (Kl + (long)((k0) - nkc) * NIN))
#define SLOAD(i, k0) do { const bf16_t* kb_ = KROWP(k0) + (long)sr * NIN + sc; \
    sr_[i].vs0 = *reinterpret_cast<const bf16x8*>(kb_ + 256); sr_[i].vs1 = *reinterpret_cast<const bf16x8*>(kb_ + 32L * NIN + 256); \
    sr_[i].ks0 = *reinterpret_cast<const bf16x8*>(kb_); sr_[i].ks1 = *reinterpret_cast<const bf16x8*>(kb_ + 32L * NIN); } while (0)
#define SWRITE(b, i) do { *(bf16x8*)(V_lds + (b) * SHM_V + vst0) = sr_[i].vs0;          \
    *(bf16x8*)(V_lds + (b) * SHM_V + vst1) = sr_[i].vs1; int kc = sc * 2;               \
    *(bf16x8*)(K_lds + (b) * SHM_K + KSWZ(sr, kc)) = sr_[i].ks0;                       \
    *(bf16x8*)(K_lds + (b) * SHM_K + KSWZ(32 + sr, kc)) = sr_[i].ks1; } while (0)
#define SWAIT() asm volatile("s_waitcnt vmcnt(4)" ::: "memory")
#define RESC(a) do { if (__any((a) < 1.f)) { if (hi == 0) al_l[r32] = (a); asm volatile("s_waitcnt lgkmcnt(0)" ::: "memory"); \
    _Pragma("unroll") for (int d = 0; d < 4; ++d) _Pragma("unroll") for (int r = 0; r < 16; ++r) o[d][r] *= al_l[crow(r, hi)]; } } while (0)
  f32x16 pA0, pA1, pB0, pB1; float mnA, mnB, alA, alB; bf16x8 pa0, pa1, pa2, pa3; const int NT = seq / KVBLK;
  constexpr int SE = 0, SO = 1;
  SLOAD(SE, 0); asm volatile("s_waitcnt vmcnt(0)" ::: "memory"); SWRITE(0, SE); __syncthreads();
  qkt(pA0, pA1, K_lds, qr, r32, hi); partialSM(pA0, pA1, m_reg, mnA, alA);
  SLOAD(SO, KVBLK); if (2 < NT) SLOAD(SE, 2 * KVBLK);
  SWAIT(); SWRITE(1, SO); __syncthreads();
  for (int j = 1; j + 1 < NT; j += 2) {
    SBAR(); qkt(pB0, pB1, K_lds + SHM_K, qr, r32, hi);
    finishSM(pA0, pA1, alA, l_reg, pa0, pa1, pa2, pa3); SBAR();
    SLOAD(SO, (j + 2) * KVBLK); SBAR();
    pv_d0(o, vb0, pa0, pa1, pa2, pa3); partialSM(pB0, pB1, m_reg, mnB, alB);
    __syncthreads(); SWAIT(); SWRITE(0, SE);
    RESC(alB); __syncthreads();
    SBAR(); qkt(pA0, pA1, K_lds, qr, r32, hi);
    finishSM(pB0, pB1, alB, l_reg, pa0, pa1, pa2, pa3); SBAR();
    if (j + 3 < NT) SLOAD(SE, (j + 3) * KVBLK); SBAR();
    pv_d0(o, vb0 + (int)SHM_V, pa0, pa1, pa2, pa3); partialSM(pA0, pA1, m_reg, mnA, alA);
    __syncthreads(); SWAIT(); SWRITE(1, SO);
    RESC(alA); __syncthreads();
  }
  SBAR(); qkt(pB0, pB1, K_lds + SHM_K, qr, r32, hi);
  finishSM(pA0, pA1, alA, l_reg, pa0, pa1, pa2, pa3); SBAR();
  pv_d0(o, vb0, pa0, pa1, pa2, pa3); partialSM(pB0, pB1, m_reg, mnB, alB);
  __syncthreads(); RESC(alB);
  finishSM(pB0, pB1, alB, l_reg, pa0, pa1, pa2, pa3); SBAR();
  pv_d0(o, vb0 + (int)SHM_V, pa0, pa1, pa2, pa3);
  if (hi == 0) li_l[r32] = l_reg; asm volatile("s_waitcnt lgkmcnt(0)" ::: "memory");
  float rli[16];
#pragma unroll
  for (int r = 0; r < 16; ++r) rli[r] = __builtin_amdgcn_rcpf(li_l[crow(r, hi)]);
  bf16_t* Ow = Ob + (long)(wid * QBLK) * NIN;
#pragma unroll
  for (int r = 0; r < 16; ++r) { int orow = crow(r, hi);
#pragma unroll
    for (int d0 = 0; d0 < 4; ++d0) Ow[(long)orow * NIN + d0 * 32 + r32] = (bf16_t)(cvt_pk_bf16(o[d0][r] * rli[r], 0.f) & 0xffffu); }
  __syncthreads();
#undef KROWP
#undef SLOAD
#undef SWRITE
#undef SWAIT
#undef RESC
}
}

struct Args { const float* in[28]; float* out; unsigned char* ws; int lo, hi; };
enum { I_X = 0, I_C, I_CTX, I_CCTX, I_WMOD, I_BMOD, I_GPREMIX, I_GPOSTMIX, I_GPREMLP, I_GPOSTMLP, I_WIN, I_CONVW, I_WCO, I_LRE, I_LIM, I_LDT, I_BRE, I_BIM, I_CRE, I_CIM, I_SD, I_WGLU, I_QG, I_KG, I_WAO, I_WOUT, I_WUP, I_WDN };

__device__ __forceinline__ void transpose_block(const float* W, int K, int N, int k0, int n0, bf16_t* dst, LAS float* scr, int lane) {
    f32x4 v[8];
    const int lr = lane >> 3, lc = (lane & 7) * 4;
#pragma unroll
    for (int i = 0; i < 8; ++i) v[i] = *(const f32x4*)(W + (size_t)(k0 + 8 * i + lr) * N + n0 + lc);
#pragma unroll
    for (int i = 0; i < 8; ++i) { LAS float* s = scr + (8 * i + lr) * 33 + lc; s[0] = v[i].x; s[1] = v[i].y; s[2] = v[i].z; s[3] = v[i].w; }
    LDS_WAIT(); asm volatile("" ::: "memory");
    const int c = lane & 7;
#pragma unroll
    for (int j = 0; j < 4; ++j) { const int n = (lane >> 3) + 8 * j; const LAS float* s = scr + (8 * c) * 33 + n;
        u32x4 o; o.x = cvt_pk_bf16(s[0 * 33], s[1 * 33]); o.y = cvt_pk_bf16(s[2 * 33], s[3 * 33]); o.z = cvt_pk_bf16(s[4 * 33], s[5 * 33]); o.w = cvt_pk_bf16(s[6 * 33], s[7 * 33]);
        *(u32x4*)(dst + (size_t)n * K + k0 + 8 * c) = o; }
    LDS_WAIT(); asm volatile("" ::: "memory");
}
__device__ __forceinline__ void convert_weights(const Args& a, int l, LAS unsigned char* lds, int gw, int NGW, int wave, int lane) {
    LAS float* scr = (LAS float*)(lds + wave * 16384);
    unsigned char* ws = a.ws;
    constexpr int I_IN = (D / 64) * (NIN / 32), I_CO = (1024 / 64) * (D / 32), I_GLU = (768 / 64) * (4096 / 32), I_AO = I_CO, I_OUT = (D / 64) * (D / 32), I_UP = (D / 64) * (FF / 32), I_DN = (FF / 64) * (D / 32);
    constexpr int NITEMS = I_IN + I_CO + I_GLU + I_AO + I_OUT + I_UP + I_DN;
    for (int it = gw; it < NITEMS; it += NGW) {
        int r = it;
        if (r < I_IN) { const int nb = r % (NIN / 32), kb = r / (NIN / 32); transpose_block(a.in[I_WIN] + (size_t)l * D * NIN, D, NIN, 64 * kb, 32 * nb, (bf16_t*)(ws + WS_WIN) + (size_t)(32 * nb) * D, scr, lane); continue; } r -= I_IN;
        if (r < I_CO) { const int nb = r % (D / 32), kb = r / (D / 32); transpose_block(a.in[I_WCO] + (size_t)l * 1024 * D, 1024, D, 64 * kb, 32 * nb, (bf16_t*)(ws + WS_WCO) + (size_t)(32 * nb) * 1024, scr, lane); continue; } r -= I_CO;
        if (r < I_GLU) { const int nb = r % 128, kb = r / 128; const int nq = nb & 63, drow = 256 * (nq >> 2) + 32 * (nq & 3) + (nb >= 64 ? 128 : 0);
            transpose_block(a.in[I_WGLU] + (size_t)l * 768 * 4096, 768, 4096, 64 * kb, 32 * nb, (bf16_t*)(ws + WS_WGLU) + (size_t)drow * 768, scr, lane); continue; } r -= I_GLU;
        if (r < I_AO) { const int nb = r % (D / 32), kb = r / (D / 32); transpose_block(a.in[I_WAO] + (size_t)l * 1024 * D, 1024, D, 64 * kb, 32 * nb, (bf16_t*)(ws + WS_WAO) + (size_t)(32 * nb) * 1024, scr, lane); continue; } r -= I_AO;
        if (r < I_OUT) { const int nb = r % (D / 32), kb = r / (D / 32); transpose_block(a.in[I_WOUT] + (size_t)l * D * D, D, D, 64 * kb, 32 * nb, (bf16_t*)(ws + WS_WOUT) + (size_t)(32 * nb) * D, scr, lane); continue; } r -= I_OUT;
        if (r < I_UP) { const int nb = r % (FF / 32), kb = r / (FF / 32); transpose_block(a.in[I_WUP] + (size_t)l * D * FF, D, FF, 64 * kb, 32 * nb, (bf16_t*)(ws + WS_WUP) + (size_t)(32 * nb) * D, scr, lane); continue; } r -= I_UP;
        { const int nb = r % (D / 32), kb = r / (D / 32); transpose_block(a.in[I_WDN] + (size_t)l * FF * D, FF, D, 64 * kb, 32 * nb, (bf16_t*)(ws + WS_WDN) + (size_t)(32 * nb) * FF, scr, lane); }
    }
}

__device__ __forceinline__ void mod_gemv(const Args& a, LAS unsigned char* lds, int bid, int G, int tid, int wave, int lane) {
    LAS float* SV = (LAS float*)lds;
    LAS float* RED = (LAS float*)(lds + 40960);
    float* MOD = (float*)(a.ws + WS_MOD);
    if (bid >= 384) return;
    for (int i = tid; i < 5 * D; i += 512) { const int j = i / D, k = i % D; const float v = j < 4 ? a.in[I_C][j * D + k] : a.in[I_CCTX][k]; SV[i] = v * sigmoidf_(v); }
    __syncthreads();
    for (int it = bid; it < 384; it += G) {
        const int l = it / 96, n0 = (it % 96) * 128;
        const float* W = a.in[I_WMOD] + (size_t)l * D * NMOD + n0 + 2 * lane;
        float acc[5][2];
#pragma unroll
        for (int j = 0; j < 5; ++j) { acc[j][0] = 0.f; acc[j][1] = 0.f; }
        const int kb = wave * 256;
#pragma unroll 16
        for (int k = 0; k < 256; ++k) { const f32x2 w = *(const f32x2*)(W + (size_t)(kb + k) * NMOD);
#pragma unroll
            for (int j = 0; j < 5; ++j) { const float s = SV[j * D + kb + k]; acc[j][0] += s * w.x; acc[j][1] += s * w.y; } }
#pragma unroll
        for (int j = 0; j < 5; ++j) { RED[(wave * 5 + j) * 128 + 2 * lane] = acc[j][0]; RED[(wave * 5 + j) * 128 + 2 * lane + 1] = acc[j][1]; }
        __syncthreads();
        for (int i = tid; i < 640; i += 512) { const int j = i >> 7, cn = i & 127; float s = 0.f;
#pragma unroll
            for (int w = 0; w < 8; ++w) s += RED[(w * 5 + j) * 128 + cn];
            MOD[((size_t)l * 5 + j) * NMOD + n0 + cn] = s + a.in[I_BMOD][l * NMOD + n0 + cn]; }
        __syncthreads();
    }
}

__device__ __forceinline__ void ssm_tables_t1(const Args& a, int gtid, int NT) {
    float* ETAB = (float*)(a.ws + WS_ETAB); float* BBT = (float*)(a.ws + WS_BB);
    for (int idx = gtid; idx < DEPTH * 2 * SG * 64; idx += NT) {
        const int n = idx & 63, gq = (idx >> 6) % SG, dir = (idx / (64 * SG)) & 1, l = idx / (64 * SG * 2);
        const double lr = fmin((double)a.in[I_LRE][idx], -1e-4), li = (double)a.in[I_LIM][idx], dt = exp((double)a.in[I_LDT][(l * 2 + dir) * SG + gq]);
        const double mag = exp(lr * dt), th = li * dt; double sn, cs; sincos(th, &sn, &cs);
        const double ab_re = mag * cs, ab_im = mag * sn, nr = ab_re - 1.0, den = lr * lr + li * li;
        const double f_re = (nr * lr + ab_im * li) / den, f_im = (ab_im * lr - nr * li) / den;
        const size_t o = (((size_t)(l * SG + gq) * 2 + dir) * 64 + n);
        float* e = ETAB + o * 66;
        for (int k = 0; k <= 32; ++k) { double s2, c2; sincos(th * k, &s2, &c2); const double mg = exp(lr * dt * k); e[2 * k] = (float)(mg * c2); e[2 * k + 1] = (float)(mg * s2); }
        float* bb = BBT + o * 32;
        for (int q = 0; q < 16; ++q) { const double br = (double)a.in[I_BRE][(size_t)idx * 16 + q], bi = (double)a.in[I_BIM][(size_t)idx * 16 + q];
            bb[2 * q] = (float)(f_re * br - f_im * bi); bb[2 * q + 1] = (float)(f_re * bi + f_im * br); }
    }
}
__device__ __forceinline__ void ssm_tables_t2(const Args& a, LAS unsigned char* lds, int bid, int G, int tid) {
    LAS float* Cs = (LAS float*)lds;
    LAS float* Es = (LAS float*)(lds + 16 * 65 * 8);
    LAS float* Bs = Es + 64 * 32 * 2;
    const float* ETAB = (const float*)(a.ws + WS_ETAB); const float* BBT = (const float*)(a.ws + WS_BB); float* MT = (float*)(a.ws + WS_MT);
    for (int it = bid; it < DEPTH * SG * 2; it += G) {
        const int dir = it & 1, gq = (it >> 1) % SG, l = it / (2 * SG);
        const size_t o = ((size_t)(l * SG + gq) * 2 + dir);
        const size_t ci = ((size_t)(l * 2 + dir) * SG + gq) * 1024;
        for (int i = tid; i < 1024; i += 512) { const int p = i >> 6, n = i & 63; Cs[(p * 65 + n) * 2] = a.in[I_CRE][ci + i]; Cs[(p * 65 + n) * 2 + 1] = a.in[I_CIM][ci + i]; }
        for (int i = tid; i < 64 * 32; i += 512) { const int n = i >> 5, lag = i & 31; Es[i * 2] = ETAB[(o * 64 + n) * 66 + 2 * lag]; Es[i * 2 + 1] = ETAB[(o * 64 + n) * 66 + 2 * lag + 1]; }
        for (int i = tid; i < 64 * 32; i += 512) Bs[i] = BBT[o * 64 * 32 + i];
        __syncthreads();
        const int lag = tid >> 4, p = tid & 15;
        float acc[16];
#pragma unroll
        for (int q = 0; q < 16; ++q) acc[q] = 0.f;
        for (int n = 0; n < 64; ++n) {
            const float cr = Cs[(p * 65 + n) * 2], cim = Cs[(p * 65 + n) * 2 + 1], er = Es[(n * 32 + lag) * 2], ei = Es[(n * 32 + lag) * 2 + 1];
            const float gr = cr * er - cim * ei, gi = cr * ei + cim * er;
#pragma unroll
            for (int q = 0; q < 16; ++q) acc[q] += gr * Bs[(n * 16 + q) * 2] - gi * Bs[(n * 16 + q) * 2 + 1];
        }
        float* dst = MT + (o * 32 + lag) * 256 + p * 16;
#pragma unroll
        for (int q = 0; q < 16; q += 4) *(f32x4*)(dst + q) = (f32x4){acc[q], acc[q + 1], acc[q + 2], acc[q + 3]};
        __syncthreads();
    }
}
__device__ __forceinline__ void ssm_fill(const Args& a, int l, LAS unsigned char* lds, int bid, int G, int tid) {
    LAS float* MTs = (LAS float*)lds;
    LAS float* Es = (LAS float*)(lds + 65536);
    LAS float* Cs = (LAS float*)(lds + 65536 + 33792);
    LAS float* Bs = (LAS float*)(lds + 65536 + 33792 + 16384);
    LAS float* Ds = (LAS float*)(lds + 65536 + 33792 + 32768);
    const float* ETAB = (const float*)(a.ws + WS_ETAB); const float* BBT = (const float*)(a.ws + WS_BB); const float* MT = (const float*)(a.ws + WS_MT);
    bf16_t* W1 = (bf16_t*)(a.ws + WS_W1); bf16_t* W3 = (bf16_t*)(a.ws + WS_W3);
    for (int it = bid; it < SG * 4; it += G) {
        const int gq = it >> 2, part = it & 3;
        const size_t o = (size_t)(l * SG + gq) * 2;
        for (int i = tid; i < 2 * 32 * 256; i += 512) MTs[i] = MT[o * 32 * 256 + i];
        for (int i = tid; i < 2 * 64 * 66; i += 512) Es[i] = ETAB[o * 64 * 66 + i];
        for (int i = tid; i < 2 * 64 * 32; i += 512) Bs[i] = BBT[o * 64 * 32 + i];
        for (int i = tid; i < 2 * 1024; i += 512) { const int dir = i >> 10, pn = i & 1023; const size_t ci = ((size_t)(l * 2 + dir) * SG + gq) * 1024 + pn;
            Cs[i * 2] = a.in[I_CRE][ci]; Cs[i * 2 + 1] = a.in[I_CIM][ci]; }
        if (tid < 16) Ds[tid] = a.in[I_SD][l * 768 + gq * 16 + tid];
        __syncthreads();
        for (int ch = tid; ch < 128 * 96; ch += 512) {
            const int ncol = part * 128 + ch / 96, kc = ch % 96, t = ncol >> 4, p = ncol & 15;
            float v[8];
            if (kc < 64) { const int s = kc >> 1, q0 = (kc & 1) * 8;
#pragma unroll
                for (int i = 0; i < 8; ++i) { const int q = q0 + i; float x = 0.f;
                    if (s <= t) x += MTs[((t - s) * 16 + p) * 16 + q];
                    if (s >= t) x += MTs[8192 + ((s - t) * 16 + p) * 16 + q];
                    if (s == t && p == q) x += Ds[p];
                    v[i] = x; }
            } else { const int dir = (kc - 64) >> 4, kk0 = ((kc - 64) & 15) * 8, e = dir == 0 ? t + 1 : 32 - t;
#pragma unroll
                for (int i = 0; i < 8; ++i) { const int kk = kk0 + i, prt = kk >> 6, n = kk & 63;
                    const float cr = Cs[((dir * 16 + p) * 64 + n) * 2], cim = Cs[((dir * 16 + p) * 64 + n) * 2 + 1], er = Es[((dir * 64 + n) * 33 + e) * 2], ei = Es[((dir * 64 + n) * 33 + e) * 2 + 1];
                    v[i] = prt == 0 ? (cr * er - cim * ei) : -(cr * ei + cim * er); }
            }
            u32x4 w; w.x = cvt_pk_bf16(v[0], v[1]); w.y = cvt_pk_bf16(v[2], v[3]); w.z = cvt_pk_bf16(v[4], v[5]); w.w = cvt_pk_bf16(v[6], v[7]);
            *(u32x4*)(W3 + ((size_t)(gq * 512 + ncol) * 768 + kc * 8)) = w;
        }
        for (int ch = tid; ch < 64 * 64; ch += 512) {
            const int ncol = part * 64 + (ch >> 6), kc = ch & 63, dir = ncol >> 7, prt = (ncol >> 6) & 1, n = ncol & 63, s = kc >> 1, q0 = (kc & 1) * 8, e = dir == 0 ? 31 - s : s;
            const float er = Es[((dir * 64 + n) * 33 + e) * 2], ei = Es[((dir * 64 + n) * 33 + e) * 2 + 1];
            float v[8];
#pragma unroll
            for (int i = 0; i < 8; ++i) { const float br = Bs[((dir * 64 + n) * 16 + q0 + i) * 2], bi = Bs[((dir * 64 + n) * 16 + q0 + i) * 2 + 1];
                v[i] = prt == 0 ? (er * br - ei * bi) : (er * bi + ei * br); }
            u32x4 w; w.x = cvt_pk_bf16(v[0], v[1]); w.y = cvt_pk_bf16(v[2], v[3]); w.z = cvt_pk_bf16(v[4], v[5]); w.w = cvt_pk_bf16(v[6], v[7]);
            *(u32x4*)(W1 + ((size_t)(gq * 256 + ncol) * 512 + kc * 8)) = w;
        }
        __syncthreads();
    }
}

template <int MODE>
__device__ __forceinline__ void row_pass(LAS unsigned char* lds, int bid, int G, int tid, int wave, int lane,
                                         const float* xin, float* xout, const float* cin, float* cout, const bf16_t* Y, const float* YP  , int nrows, bf16_t* XN,
                                         const float* gpost, const float* gpre, const float* modg  , int gate_off,
                                         const float* modn  , int shift_off, int scale_off) {
    LAS float* V = (LAS float*)lds;
    int cur = -1;
    const int nblk = nrows / 16;
    for (int blk = bid; blk < nblk; blk += G) {
        const int row0 = blk * 16, jb = row0 < ML ? row0 / SEQ : 4;
        if (jb != cur) {
            __syncthreads();
            for (int i = tid; i < D; i += 512) {
                if (cur < 0) { if (MODE != 0) V[i] = gpost[i]; if (MODE != 2) V[D + i] = gpre[i]; }
                if (MODE != 0) V[2 * D + i] = modg[(size_t)jb * NMOD + gate_off + i];
                if (MODE != 2) { V[3 * D + i] = modn[(size_t)jb * NMOD + shift_off + i]; V[4 * D + i] = 1.0f + modn[(size_t)jb * NMOD + scale_off + i]; }
            }
            cur = jb;
            __syncthreads();
        }
#pragma unroll
        for (int rr = 0; rr < 2; ++rr) {
            const int row = row0 + wave * 2 + rr;
            const float* xs = row < ML ? xin + (size_t)row * D : cin + (size_t)(row - ML) * D;
            float* xd = row < ML ? xout + (size_t)row * D : cout + (size_t)(row - ML) * D;
            f32x4 x[8];
#pragma unroll
            for (int j = 0; j < 8; ++j) x[j] = *(const f32x4*)(xs + 4 * lane + 256 * j);
            if (MODE != 0) {
                f32x4 y[8]; float ss = 0.f;
#pragma unroll
                for (int j = 0; j < 8; ++j) {
                    if (row < ML) { const u32x2 w = *(const u32x2*)(Y + (size_t)row * D + 4 * lane + 256 * j); y[j] = (f32x4){bf_lo(w.x), bf_hi(w.x), bf_lo(w.y), bf_hi(w.y)}; }
                    else { const float* yp = YP + (size_t)(row - ML) * D + 4 * lane + 256 * j; f32x4 s = *(const f32x4*)yp;
#pragma unroll
                        for (int ks = 1; ks < 8; ++ks) s += *(const f32x4*)(yp + (size_t)ks * MC * D);
                        y[j] = s; }
                    ss += (y[j].x * y[j].x + y[j].y * y[j].y) + (y[j].z * y[j].z + y[j].w * y[j].w); }
                const float rstd = rsqrtf(wave_sum(ss) * (1.f / D) + NORM_EPS);
#pragma unroll
                for (int j = 0; j < 8; ++j) { const f32x4 gp = *(const LAS f32x4*)(V + 4 * lane + 256 * j), gt = *(const LAS f32x4*)(V + 2 * D + 4 * lane + 256 * j);
                    x[j] = x[j] + gt * (y[j] * rstd * gp);
                    *(f32x4*)(xd + 4 * lane + 256 * j) = x[j]; }
            }
            if (MODE != 2) {
                float ss = 0.f;
#pragma unroll
                for (int j = 0; j < 8; ++j) ss += (x[j].x * x[j].x + x[j].y * x[j].y) + (x[j].z * x[j].z + x[j].w * x[j].w);
                const float rstd = rsqrtf(wave_sum(ss) * (1.f / D) + NORM_EPS);
#pragma unroll
                for (int j = 0; j < 8; ++j) { const f32x4 gp = *(const LAS f32x4*)(V + D + 4 * lane + 256 * j), sh = *(const LAS f32x4*)(V + 3 * D + 4 * lane + 256 * j), sc = *(const LAS f32x4*)(V + 4 * D + 4 * lane + 256 * j);
                    const f32x4 h = sh + sc * (x[j] * rstd * gp);
                    u32x2 w; w.x = cvt_pk_bf16(h.x, h.y); w.y = cvt_pk_bf16(h.z, h.w);
                    *(u32x2*)(XN + (size_t)row * D + 4 * lane + 256 * j) = w; }
            }
        }
    }
    __syncthreads();
}

__device__ __forceinline__ void conv_pass(const Args& a, int l, int wk, int nwk, int lane) {
    bf16_t* P = (bf16_t*)(a.ws + WS_P);
    const int c = (wk & 1) * 512 + 8 * lane;
    const float* cw = a.in[I_CONVW] + (size_t)l * 3 * 1024 + c;
    float w0[8], w1[8], w2[8];
#pragma unroll
    for (int i = 0; i < 8; ++i) { w0[i] = cw[i]; w1[i] = cw[1024 + i]; w2[i] = cw[2048 + i]; }
    for (int it = wk; it < (M / 16) * 8; it += nwk) {
        const int r0 = (it >> 3) * 16 + ((it >> 1) & 3) * 4;
        const int s0 = r0 < ML ? (r0 / SEQ) * SEQ : ML + ((r0 - ML) / CTXL) * CTXL, s1 = s0 + (r0 < ML ? SEQ : CTXL);
        float u[6][8];
#pragma unroll
        for (int k = 0; k < 6; ++k) { const int r = r0 - 1 + k;
            if (r >= s0 && r < s1) { f32x4 c0, c1, v0, v1; pg8::unpack8(*(const u32x4*)(P + (size_t)r * NIN + C_AC + c), c0, c1); pg8::unpack8(*(const u32x4*)(P + (size_t)r * NIN + C_AV + c), v0, v1);
#pragma unroll
                for (int i = 0; i < 4; ++i) { u[k][i] = c0[i] * v0[i]; u[k][4 + i] = c1[i] * v1[i]; } }
            else {
#pragma unroll
                for (int i = 0; i < 8; ++i) u[k][i] = 0.f; } }
#pragma unroll
        for (int k = 0; k < 4; ++k) { bf16_t* pb = P + (size_t)(r0 + k) * NIN + C_AB + c; f32x4 b0, b1; pg8::unpack8(*(const u32x4*)pb, b0, b1);
#pragma unroll
            for (int i = 0; i < 4; ++i) { b0[i] *= w0[i] * u[k][i] + w1[i] * u[k + 1][i] + w2[i] * u[k + 2][i]; b1[i] *= w0[4 + i] * u[k][4 + i] + w1[4 + i] * u[k + 1][4 + i] + w2[4 + i] * u[k + 2][4 + i]; }
            *(u32x4*)pb = pg8::pack8(b0, b1); }
    }
}
__device__ __forceinline__ void qk_pass(const Args& a, int l, int gw, int NGW, int lane) {
    bf16_t* P = (bf16_t*)(a.ws + WS_P);
    const float* ROPE = (const float*)(a.ws + WS_ROPE);
    const int j = lane & 15, hq = lane >> 4;
    float gq_[8], gk_[8];
#pragma unroll
    for (int i = 0; i < 8; ++i) { gq_[i] = a.in[I_QG][l * 128 + 8 * j + i]; gk_[i] = a.in[I_KG][l * 128 + 8 * j + i]; }
    const bool kact = hq < 2;
    for (int r0 = 4 * gw; r0 < M; r0 += 4 * NGW) {
        const bool lat = r0 < ML;
        u32x4 raw[4][3]; f32x4 cs[4][2], sn[4][2];
#pragma unroll
        for (int rr = 0; rr < 4; ++rr) { const size_t rb = (size_t)(r0 + rr) * NIN;
            raw[rr][0] = *(const u32x4*)(P + rb + C_Q + hq * 128 + 8 * j); raw[rr][1] = *(const u32x4*)(P + rb + C_Q + (4 + hq) * 128 + 8 * j);
            raw[rr][2] = kact ? *(const u32x4*)(P + rb + C_K + (hq & 1) * 128 + 8 * j) : (u32x4){0u, 0u, 0u, 0u};
            if (lat) { const int t = (r0 + rr) % SEQ, pos = (j < 8) ? (t >> 6) : (t & 63); const float* rp = ROPE + pos * 32 + 8 * (j & 3);
                cs[rr][0] = *(const f32x4*)rp; cs[rr][1] = *(const f32x4*)(rp + 4); sn[rr][0] = *(const f32x4*)(rp + 4096); sn[rr][1] = *(const f32x4*)(rp + 4100); } }
#pragma unroll
        for (int rr = 0; rr < 4; ++rr) { const size_t rb = (size_t)(r0 + rr) * NIN;
#pragma unroll
            for (int st = 0; st < 3; ++st) {
                f32x4 v0, v1; pg8::unpack8(raw[rr][st], v0, v1);
                float x[8] = {v0[0], v0[1], v0[2], v0[3], v1[0], v1[1], v1[2], v1[3]};
                float ss = 0.f;
#pragma unroll
                for (int i = 0; i < 8; ++i) ss += x[i] * x[i];
                ss += __shfl_xor(ss, 1); ss += __shfl_xor(ss, 2); ss += __shfl_xor(ss, 4); ss += __shfl_xor(ss, 8);
                const float rstd = rsqrtf(ss * (1.f / 128.f) + NORM_EPS);
#pragma unroll
                for (int i = 0; i < 8; ++i) x[i] = x[i] * rstd * (st < 2 ? gq_[i] : gk_[i]);
                if (lat) {
#pragma unroll
                    for (int i = 0; i < 8; ++i) { const float pr = __shfl_xor(x[i], 4); x[i] = x[i] * cs[rr][i >> 2][i & 3] + ((j & 4) ? pr : -pr) * sn[rr][i >> 2][i & 3]; } }
                bf16_t* p = P + rb + (st < 2 ? C_Q + (st * 4 + hq) * 128 : C_K + (hq & 1) * 128) + 8 * j;
                if (st < 2 || kact) *(u32x4*)p = pg8::pack8((f32x4){x[0], x[1], x[2], x[3]}, (f32x4){x[4], x[5], x[6], x[7]});
            } }
    }
}
__device__ __forceinline__ void ssm_scan(const Args& a, int l, int bid, int G, int wave, int lane) {
    const float* S = (const float*)(a.ws + WS_S); bf16_t* As = (bf16_t*)(a.ws + WS_ASSM); const float* ETAB = (const float*)(a.ws + WS_ETAB);
    for (int ch = bid + G * wave; ch < NBATCH * SG * 2; ch += G * 8) {
        const int dir = ch & 1, gq = (ch >> 1) % SG, b = ch / (2 * SG);
        const float* e = ETAB + ((((size_t)(l * SG + gq) * 2 + dir) * 64 + lane) * 66 + 64);
        const float ar = e[0], ai = e[1];
        float hr = 0.f, hi = 0.f;
        for (int s0 = 0; s0 < 264; s0 += 8) {
            float sr[8], si[8]; int rows[8];
#pragma unroll
            for (int k = 0; k < 8; ++k) { const int s = s0 + k; int row;
                if (s < 8) row = 1024 + 8 * b + (dir == 0 ? s : 7 - s); else row = 256 * b + (dir == 0 ? s - 8 : 263 - s);
                rows[k] = row; const float* sp = S + ((size_t)(gq * SGR + row) * 256 + dir * 128 + lane); sr[k] = sp[0]; si[k] = sp[64]; }
#pragma unroll
            for (int k = 0; k < 8; ++k) { bf16_t* hp = As + ((size_t)(gq * SGR + rows[k]) * 768 + 512 + dir * 128 + lane);
                hp[0] = (bf16_t)(cvt_pk_bf16(hr, 0.f) & 0xffffu); hp[64] = (bf16_t)(cvt_pk_bf16(hi, 0.f) & 0xffffu);
                const float nr = ar * hr - ai * hi + sr[k], ni = ar * hi + ai * hr + si[k]; hr = nr; hi = ni; }
        }
    }
}

typedef const __attribute__((address_space(4))) unsigned long long* KArgP;
__device__ __forceinline__ Args load_args() {
    KArgP p = (KArgP)__builtin_amdgcn_kernarg_segment_ptr(); asm volatile("" : "+s"(p));
    Args r;
#pragma unroll
    for (int i = 0; i < 28; ++i) r.in[i] = (const float*)(const GAS float*)p[i];
    r.out = (float*)(GAS float*)p[28]; r.ws = (unsigned char*)(GAS unsigned char*)p[29]; const unsigned long long lh = p[30]; r.lo = (int)(unsigned)lh; r.hi = (int)(unsigned)(lh >> 32);
    return r;
}
__global__ void __launch_bounds__(512, 2) hybrid_fwd(Args ka) {
    extern __shared__ __attribute__((aligned(16))) unsigned char lds_raw[];
    LAS unsigned char* lds = (LAS unsigned char*)lds_raw;
    volatile LAS unsigned* MISC = (volatile LAS unsigned*)(lds + MISC_OFF);
    const int G = gridDim.x, bid = blockIdx.x;
    if (threadIdx.x < 64) MISC[threadIdx.x] = 0u;
    __syncthreads();
    XcdBarrier bar; bar.bar = (unsigned*)(ka.ws + WS_CTL) + CW_BAR; bar.x = 0; bar.st = nullptr;
    if (ka.hi - ka.lo > 1) bar = xcd_barrier_post((unsigned*)(ka.ws + WS_CTL) + CW_BAR, MISC + 8);
#define PH(k) (ka.lo <= (k) && (k) < ka.hi)
#define SEAM(k) do { if ((k) + 1 < ka.hi) xcd_barrier(bar); } while (0)
#define PHASE_ARGS const Args a = load_args(); unsigned char* const ws = a.ws; (void)ws; \
    int tid_ = threadIdx.x; asm volatile("" : "+v"(tid_)); const int tid = tid_, lane = tid & 63, wave = __builtin_amdgcn_readfirstlane(tid >> 6); \
    const int gw = bid * 8 + wave, NGW = G * 8, gtid = bid * 512 + tid, NTHR = G * 512; (void)lane; (void)gw; (void)NGW; (void)gtid; (void)NTHR; \
    bf16_t* const P = (bf16_t*)(ws + WS_P); bf16_t* const XN = (bf16_t*)(ws + WS_XN); bf16_t* const MX = (bf16_t*)(ws + WS_MX); bf16_t* const UP = (bf16_t*)(ws + WS_UP); \
    bf16_t* const ASSM = (bf16_t*)(ws + WS_ASSM); float* const SST = (float*)(ws + WS_S); float* const CTXR = (float*)(ws + WS_CTXR); float* const MOD = (float*)(ws + WS_MOD); \
    (void)P; (void)XN; (void)MX; (void)UP; (void)ASSM; (void)SST; (void)CTXR; (void)MOD;

    if (PH(0)) { PHASE_ARGS
        float* ROPE = (float*)(ws + WS_ROPE);
        for (int idx = gtid; idx < 4096; idx += NTHR) { const int pos = idx >> 5, i = idx & 31; const double inv = exp(-(double)i * (9.210340371976184 / 32.0)); double s, c; sincos((double)pos * inv, &s, &c); ROPE[idx] = (float)c; ROPE[4096 + idx] = (float)s; }
        ssm_tables_t1(a, gtid, NTHR);
        mod_gemv(a, lds, bid, G, tid, wave, lane);
        __syncthreads();
        convert_weights(a, 0, lds, gw, NGW, wave, lane);
        SEAM(0);
    }
    if (PH(1)) { PHASE_ARGS
        ssm_tables_t2(a, lds, bid, G, tid);
        row_pass<0>(lds, bid, G, tid, wave, lane, a.in[I_X], a.out, a.in[I_CTX], CTXR, MX, (const float*)(ws + WS_PART), M, XN, a.in[I_GPREMIX], a.in[I_GPREMIX], MOD, 0, MOD, 0, D);
        SEAM(1);
    }
    for (int l = 0; l < DEPTH; ++l) {
        const int pb = 2 + 12 * l;
        const int Meff = l + 1 < DEPTH ? M : ML;
        if (PH(pb + 0)) { PHASE_ARGS
            ssm_fill(a, l, lds, bid, G, tid);
            pg8::Gemm g{XN, (const bf16_t*)(ws + WS_WIN), D, D, D}; pg8::StaticOrder S; S.init(M, NIN, D, G, bid);
            pg8::EpiProj E{P, ASSM};
            for (int rep = 0; rep < REP_BIG; ++rep) pg8::gemm_phase(lds, g, S, E);
            SEAM(pb + 0);
        }
        if (PH(pb + 1)) { PHASE_ARGS
            { pg8::Gemm g{ASSM, (const bf16_t*)(ws + WS_W1), 768, 512, 512}; pg8::GroupOrder S; S.init(1, 512, G, bid); pg8::EpiState E{SST}; pg8::gemm_phase(lds, g, S, E); }
            SEAM(pb + 1);
        }
        if (PH(pb + 2)) { PHASE_ARGS
            if (wave < 2) ssm_scan(a, l, bid, G, wave, lane);
            else { const int wk = bid * 6 + (wave - 2), nwk = G * 6; conv_pass(a, l, wk, nwk, lane); qk_pass(a, l, wk, nwk, lane); }
            SEAM(pb + 2);
        }
        if (PH(pb + 3)) { PHASE_ARGS
            { pg8::Gemm g{ASSM, (const bf16_t*)(ws + WS_W3), 768, 768, 768}; pg8::GroupOrder S; S.init(2, 768, G, bid); pg8::EpiSsmY E{P}; pg8::gemm_phase(lds, g, S, E); }
            for (int rep = 0; rep < REP_ATT; ++rep)
            for (int u = bid; u < (l + 1 < DEPTH ? 1056 : 1024); u += G) {
                const bool lat = u < 1024; int b, hq, qb;
                if (lat) { const int xcd = u & 7, idx = (u >> 3) & 31, rnd = u >> 8; b = xcd >> 1; hq = (xcd & 1) * 4 + (idx >> 3); qb = (idx & 7) + 8 * rnd; }
                else { const int c = u - 1024; b = c >> 3; hq = c & 7; qb = 0; }
                const int kvh = hq >> 2;
                const size_t r0 = lat ? (size_t)b * SEQ + (size_t)qb * 256 : (size_t)(ML + b * CTXL);
                const bf16_t* Kc = P + (size_t)(ML + b * CTXL) * NIN + C_K + kvh * 128;
                const bf16_t* Kl = P + (size_t)b * SEQ * NIN + C_K + kvh * 128;
                attn::attn_unit(P + r0 * NIN + C_Q + hq * 128, Kc, Kl, P + r0 * NIN + C_O + hq * 128, CTXL, lat ? CTXL + SEQ : CTXL, (char*)lds_raw);
            }
            SEAM(pb + 3);
        }
        if (PH(pb + 4)) { PHASE_ARGS pg8::Gemm g{P + C_AB, (const bf16_t*)(ws + WS_WCO), NIN, 1024, 1024}; pg8::StaticOrder S; S.init(Meff, D, 1024, G, bid); pg8::EpiMerge<false> E{XN, P, C_GC}; pg8::gemm_phase(lds, g, S, E); SEAM(pb + 4); }
        if (PH(pb + 5)) { PHASE_ARGS pg8::Gemm g{P + C_Y, (const bf16_t*)(ws + WS_WGLU), NIN, 768, 768}; pg8::StaticOrder S; S.init(Meff, 4096, 768, G, bid); pg8::EpiGlu E{XN, P}; pg8::gemm_phase(lds, g, S, E); SEAM(pb + 5); }
        if (PH(pb + 6)) { PHASE_ARGS pg8::Gemm g{P + C_O, (const bf16_t*)(ws + WS_WAO), NIN, 1024, 1024}; pg8::StaticOrder S; S.init(Meff, D, 1024, G, bid); pg8::EpiMerge<true> E{XN, P, C_GA}; pg8::gemm_phase(lds, g, S, E); SEAM(pb + 6); }
        if (PH(pb + 7)) { PHASE_ARGS pg8::Gemm g{XN, (const bf16_t*)(ws + WS_WOUT), D, D, D}; pg8::SplitCtxOrder S; S.init(D, D, G, bid, l + 1 < DEPTH); pg8::EpiBf16Part E{MX, (float*)(ws + WS_PART)}; pg8::gemm_phase(lds, g, S, E); SEAM(pb + 7); }
        if (PH(pb + 8)) { PHASE_ARGS
            const float* modl = MOD + (size_t)l * 5 * NMOD;
            row_pass<1>(lds, bid, G, tid, wave, lane, l == 0 ? a.in[I_X] : a.out, a.out, l == 0 ? a.in[I_CTX] : CTXR, CTXR, MX, (const float*)(ws + WS_PART), Meff, XN, a.in[I_GPOSTMIX] + l * D, a.in[I_GPREMLP] + l * D, modl, 2 * D, modl, 3 * D, 4 * D);
            SEAM(pb + 8);
        }
        if (PH(pb + 9)) { PHASE_ARGS pg8::Gemm g{XN, (const bf16_t*)(ws + WS_WUP), D, D, D}; pg8::StaticOrder S; S.init(Meff, FF, D, G, bid); pg8::EpiBf16<1> E{UP, FF}; for (int rep = 0; rep < REP_BIG; ++rep) pg8::gemm_phase(lds, g, S, E); SEAM(pb + 9); }
        if (PH(pb + 10)) { PHASE_ARGS pg8::Gemm g{UP, (const bf16_t*)(ws + WS_WDN), FF, FF, FF}; pg8::SplitCtxOrder S; S.init(D, FF, G, bid, l + 1 < DEPTH); pg8::EpiBf16Part E{MX, (float*)(ws + WS_PART)}; for (int rep = 0; rep < REP_BIG; ++rep) pg8::gemm_phase(lds, g, S, E); SEAM(pb + 10); }
        if (PH(pb + 11)) { PHASE_ARGS
            const float* modl = MOD + (size_t)l * 5 * NMOD;
            if (l + 1 < DEPTH) {
                row_pass<1>(lds, bid, G, tid, wave, lane, a.out, a.out, CTXR, CTXR, MX, (const float*)(ws + WS_PART), M, XN, a.in[I_GPOSTMLP] + l * D, a.in[I_GPREMIX] + (l + 1) * D, modl, 5 * D, modl + 5 * NMOD, 0, D);
                convert_weights(a, l + 1, lds, gw, NGW, wave, lane);
                SEAM(pb + 11);
            } else {
                row_pass<2>(lds, bid, G, tid, wave, lane, a.out, a.out, CTXR, CTXR, MX, (const float*)(ws + WS_PART), ML, XN, a.in[I_GPOSTMLP] + l * D, a.in[I_GPOSTMLP] + l * D, modl, 5 * D, modl, 0, 0);
            }
        }
    }
#undef PH
#undef PHASE_ARGS
#undef SEAM
}

constexpr int N_PHASES = 2 + 12 * DEPTH;
extern "C" void kernel_launch(void* const* d_in, const int* in_sizes, int n_in, void* d_out, int out_size, void* d_ws, size_t ws_size, hipStream_t stream) {
    static int grid = 0;
    if (grid == 0) {
        if (n_in != 28 || in_sizes[0] != ML * D || out_size != ML * D || ws_size < WS_END) { fprintf(stderr, "kernel_launch: shape/workspace mismatch (n_in %d, ws %zu < %zu?)\n", n_in, ws_size, (size_t)WS_END); grid = -1; return; }
        int dev = 0, cus = 0, per_cu = 0;
        if (hipGetDevice(&dev) != hipSuccess || hipDeviceGetAttribute(&cus, hipDeviceAttributeMultiprocessorCount, dev) != hipSuccess) { grid = -1; return; }
        if (hipFuncSetAttribute((const void*)hybrid_fwd, hipFuncAttributeMaxDynamicSharedMemorySize, LDS_BYTES) != hipSuccess) { fprintf(stderr, "kernel_launch: hipFuncSetAttribute failed\n"); grid = -1; return; }
        if (hipOccupancyMaxActiveBlocksPerMultiprocessor(&per_cu, (const void*)hybrid_fwd, 512, LDS_BYTES) != hipSuccess || per_cu < 1) { fprintf(stderr, "kernel_launch: occupancy query says %d blocks per CU\n", per_cu); (void)hipGetLastError(); if (per_cu < 1) { grid = -1; return; } }
        grid = cus;
    }
    if (grid < 0) return;
    if (hipMemsetAsync((char*)d_ws + WS_CTL, 0, CTL_ZERO_BYTES, stream) != hipSuccess) return;
    Args a{};
    for (int i = 0; i < 28; ++i) a.in[i] = (const float*)d_in[i];
    a.out = (float*)d_out; a.ws = (unsigned char*)d_ws;
#if MK_PER_PHASE
    for (int p = 0; p < N_PHASES; ++p) { a.lo = p; a.hi = p + 1; hipLaunchKernelGGL(hybrid_fwd, dim3(grid), dim3(512), LDS_BYTES, stream, a); }
#else
    a.lo = 0; a.hi = N_PHASES;
    hipLaunchKernelGGL(hybrid_fwd, dim3(grid), dim3(512), LDS_BYTES, stream, a);
#endif
    const hipError_t le = hipPeekAtLastError();
    if (le != hipSuccess) fprintf(stderr, "kernel_launch: launch failed: %s\n", hipGetErrorName(le));
}
```

```cpp
#include <hip/hip_runtime.h>
#include <cstdio>
#include <cstdint>
#include <cmath>

#ifndef MK_PER_PHASE
#define MK_PER_PHASE 0
#endif
#ifndef REP_BIG
#define REP_BIG 1
#endif
#ifndef STAGGER
#define STAGGER 0
#endif
#ifndef REP_UP
#define REP_UP 0
#endif
#ifndef OVL_EXP
#define OVL_EXP 0
#endif
#ifndef REP_SCAN
#define REP_SCAN 1
#endif
#ifndef REP_PROJ
#define REP_PROJ 1
#endif
#ifndef REP_DOWN
#define REP_DOWN 1
#endif
#ifndef REP_RG
#define REP_RG 1
#endif
#ifndef REP_RP
#define REP_RP 1
#endif
#ifndef REP_CV
#define REP_CV 1
#endif
#ifndef REP_ATT
#define REP_ATT 1
#endif

#define LAS __attribute__((address_space(3)))
#define GAS __attribute__((address_space(1)))
typedef unsigned short bf16_t;
typedef short bf16x8 __attribute__((ext_vector_type(8)));
typedef short s16x4 __attribute__((ext_vector_type(4)));
typedef float f32x2 __attribute__((ext_vector_type(2)));
typedef float f32x4 __attribute__((ext_vector_type(4)));
typedef float f32x16 __attribute__((ext_vector_type(16)));
typedef unsigned u32x2 __attribute__((ext_vector_type(2)));
typedef unsigned u32x4 __attribute__((ext_vector_type(4)));
typedef GAS unsigned gu32;
typedef int v4i __attribute__((ext_vector_type(4)));
typedef int v8i __attribute__((ext_vector_type(8)));
constexpr float WG8_SCALE = 64.0f;

constexpr int D = 2048, NBATCH = 4, SEQ = 8192, CTXL = 256, DEPTH = 4;
constexpr int ML = NBATCH * SEQ, MC = NBATCH * CTXL, M = ML + MC;
constexpr int NIN = 11520, FF = 8192, NMOD = 6 * D;
constexpr int C_AB = 0, C_AC = 1024, C_AV = 2048, C_SU = 3072, C_Q = 3840, C_K = 4864, C_V = 5120, C_GC = 5376, C_GS = 7424, C_GA = 9472;
constexpr int C_O = C_AC, C_Y = C_SU;
constexpr int C_F8 = C_Q;
constexpr int SG = 48, SGR = 1280, SGV = 1056;
constexpr float NORM_EPS = 1e-6f;

constexpr size_t MiB = 1u << 20;
constexpr size_t WS_CTL = 0, CTL_ZERO_BYTES = 1 * MiB;
constexpr size_t WS_MOD = 1 * MiB;
constexpr size_t WS_ROPE = 2 * MiB;
constexpr size_t WS_ETAB = 3 * MiB;
constexpr size_t WS_BB = 10 * MiB;
constexpr size_t WS_MT = 13 * MiB;
constexpr size_t WS_CTXR = 25 * MiB;
constexpr size_t WS_WIN = 33 * MiB, WS_WCO = 78 * MiB, WS_WGLU = 82 * MiB, WS_WAO = 88 * MiB, WS_WOUT = 92 * MiB, WS_WUP = 100 * MiB, WS_WDN = 132 * MiB;
constexpr size_t WS_W1 = 164 * MiB, WS_W3 = 176 * MiB;
constexpr size_t WS_XN = 212 * MiB, WS_MX = 344 * MiB, WS_ASSM = 476 * MiB, WS_S = 566 * MiB, WS_P = 626 * MiB;
constexpr size_t WS_PART = WS_P + (size_t)M * NIN * 2 + MiB;
constexpr size_t WS_XN8 = WS_PART + (size_t)8 * MC * D * 4;
constexpr size_t WS_WG8 = WS_XN8 + (size_t)M * D;
constexpr size_t WS_K8 = WS_WG8 + (size_t)(NIN - C_Q) * D;
constexpr size_t WS_VT8 = WS_K8 + (size_t)NBATCH * 2 * (CTXL + SEQ) * 128;
constexpr size_t WS_END = WS_VT8 + (size_t)NBATCH * 2 * (CTXL + SEQ) * 128;
constexpr size_t WS_UP = WS_P;
static_assert((size_t)M * FF * 2 <= (size_t)M * NIN * 2, "UP overlay");
constexpr int CW_BAR = 4096;

constexpr int LDS_BYTES = 147456, MISC_OFF = LDS_BYTES - 256;

#define RLX_AGENT __ATOMIC_RELAXED, __HIP_MEMORY_SCOPE_AGENT
#define LDS_WAIT() asm volatile("s_waitcnt lgkmcnt(0)" ::: "memory")
__device__ __forceinline__ unsigned cvt_pk_bf16(float lo, float hi) { unsigned r; asm volatile("v_cvt_pk_bf16_f32 %0, %1, %2" : "=v"(r) : "v"(lo), "v"(hi)); return r; }
__device__ __forceinline__ float bf_lo(unsigned w) { return __uint_as_float(w << 16); }
__device__ __forceinline__ float bf_hi(unsigned w) { return __uint_as_float(w & 0xffff0000u); }
__device__ __forceinline__ float wave_sum(float v) {
#pragma unroll
    for (int o = 1; o < 64; o <<= 1) v += __shfl_xor(v, o);
    return v;
}
__device__ __forceinline__ float sigmoidf_(float x) { return __builtin_amdgcn_rcpf(1.0f + __builtin_amdgcn_exp2f(-1.4426950408889634f * x)); }
__device__ __forceinline__ unsigned gate_q4_(const f32x4 s) { unsigned w = (unsigned)(s[0] * 255.f + 0.5f); w |= (unsigned)(s[1] * 255.f + 0.5f) << 8; w |= (unsigned)(s[2] * 255.f + 0.5f) << 16; w |= (unsigned)(s[3] * 255.f + 0.5f) << 24; return w; }
__device__ __forceinline__ f32x4 gate_u4_(unsigned w) { return (f32x4){(float)(w & 255u), (float)((w >> 8) & 255u), (float)((w >> 16) & 255u), (float)(w >> 24)} * (1.0f / 255.f); }
__device__ __forceinline__ float sigmoid_pre_(float z) { return __builtin_amdgcn_rcpf(1.0f + __builtin_amdgcn_exp2f(z)); }
__device__ __forceinline__ float gelu_tanh(float x) { const float u = 0.7978845608028654f * (x + 0.044715f * x * x * x); return x * sigmoidf_(2.0f * u); }

#define XB_TMO      128
#define XB_XCNT(j)  (256  + 64 * (j))
#define XB_XSUB(j)  (1280 + 64 * (j))
#define XB_XGEN(j)  (2304 + 64 * (j))
#define XB_TOP      3328
#define XB_TOPGEN   3392
#define XCD_BAR_WORDS 3456
#define XB_SPIN_CAP (1u << 22)
__device__ __forceinline__ unsigned xb_ld(unsigned* p)              { return __hip_atomic_load(p, __ATOMIC_RELAXED, __HIP_MEMORY_SCOPE_AGENT); }
__device__ __forceinline__ unsigned xb_add(unsigned* p, unsigned v) { return __hip_atomic_fetch_add(p, v, __ATOMIC_RELAXED, __HIP_MEMORY_SCOPE_AGENT); }
__device__ __forceinline__ unsigned xb_xcc_id() { return (unsigned)__builtin_amdgcn_s_getreg((3 << 11) | 20) & 0xFu; }
#define XB_SPIN(cond, bar) do { unsigned _sp = 0; while (cond) { __builtin_amdgcn_s_sleep(1); \
    if ((++_sp & 255u) == 0u) { if (xb_ld(&(bar)[XB_TMO])) break; if (_sp > XB_SPIN_CAP) { atomicAdd(&(bar)[XB_TMO], 1u); break; } } } } while (0)
struct XcdBarrier { unsigned* bar; unsigned x; volatile LAS unsigned* st; };
__device__ __forceinline__ XcdBarrier xcd_barrier_post(unsigned* bar, volatile LAS unsigned* st) {
    XcdBarrier b; b.bar = bar; b.x = xb_xcc_id(); b.st = st;
    if (threadIdx.x == 0) (void)xb_add(&bar[XB_XCNT(b.x)], 1u);
    return b;
}
__device__ __forceinline__ void xcd_barrier_complete(unsigned* bar, unsigned x, unsigned& nloc, unsigned& nx) {
    const unsigned G = gridDim.x * gridDim.y * gridDim.z;
    unsigned sum, cnt, mine, sp = 0u;
    for (;;) {
        sum = 0u; cnt = 0u; mine = 0u;
#pragma unroll
        for (unsigned j = 0; j < 16; ++j) { const unsigned c = xb_ld(&bar[XB_XCNT(j)]); sum += c; cnt += (c > 0u) ? 1u : 0u; mine = (j == x) ? c : mine; }
        if (sum == G) break;
        __builtin_amdgcn_s_sleep(1);
        if ((++sp & 255u) == 0u) { if (xb_ld(&bar[XB_TMO])) break; if (sp > XB_SPIN_CAP) { atomicAdd(&bar[XB_TMO], 1u); break; } }
    }
    nloc = mine > 0u ? mine : 1u; nx = cnt > 0u ? cnt : 1u;
}
__device__ __forceinline__ void xcd_barrier(const XcdBarrier& b) {
    asm volatile("s_waitcnt vmcnt(0)" ::: "memory");
    __syncthreads();
    if (threadIdx.x == 0) {
        unsigned* bar = b.bar;
        __builtin_amdgcn_s_waitcnt(0);
        unsigned nloc = b.st[0], nx = b.st[1];
        if (nloc == 0u) { xcd_barrier_complete(bar, b.x, nloc, nx); b.st[0] = nloc; b.st[1] = nx; }
        const unsigned old = xb_add(&bar[XB_XSUB(b.x)], 1u);
        const unsigned gen = old / nloc;
        if (old + 1u == (gen + 1u) * nloc) {
            __builtin_amdgcn_fence(__ATOMIC_RELEASE, "agent");
            asm volatile("s_waitcnt vmcnt(0)" ::: "memory");
            const unsigned og = xb_add(&bar[XB_TOP], 1u);
            const unsigned tg = og / nx;
            if (og + 1u == (tg + 1u) * nx) xb_add(&bar[XB_TOPGEN], 1u);
            else XB_SPIN(xb_ld(&bar[XB_TOPGEN]) == tg, bar);
            __builtin_amdgcn_fence(__ATOMIC_ACQUIRE, "agent");
            xb_add(&bar[XB_XGEN(b.x)], 1u);
            asm volatile("s_waitcnt vmcnt(0)" ::: "memory");
        } else {
            XB_SPIN(xb_ld(&bar[XB_XGEN(b.x)]) == gen, bar);
            __builtin_amdgcn_fence(__ATOMIC_ACQUIRE, "agent");
            asm volatile("s_waitcnt vmcnt(0)" ::: "memory");
        }
    }
    __syncthreads();
}

namespace pg8 {
constexpr int BM = 256, BK = 64, HALF = 128, HTB = HALF * BK * 2, STAGE_BYTES = 8 * HTB, NXCD = 8, WGM = 8;
__host__ __device__ __forceinline__ int lds_byte(int r, int c) { const int st = (r >> 4) * 2 + (c >> 5), rr = r & 15, cc = c & 31, ob = rr * 64 + cc * 2; return st * 1024 + (ob ^ (((ob >> 9) & 1) << 5)); }
__host__ __device__ __forceinline__ void stage_rc(int b, int& R, int& C) { const int st = b / 1024, sb = b % 1024, swz = sb ^ (((sb >> 9) & 1) << 5); R = (st >> 1) * 16 + swz / 64; C = (st & 1) * 32 + (swz % 64) / 2; }
__host__ __device__ __forceinline__ int perm32(int rho) { const int n = rho >> 4, i = rho & 15; return 8 * (i >> 2) + 4 * n + (i & 3); }
struct Unit { int pm, pn, koff, nt, kind; };
struct Gemm { const bf16_t* A; const bf16_t* Bt; int lda, ldb, K; };
struct StaticOrder {
    int nM, nN, nwg, G, c, ntk, ibeg, iend, wgm;
    __device__ __forceinline__ void init(int M_, int N_, int K_, int G_, int c_) { nM = M_ / BM; nN = N_ / BM; nwg = nM * nN; G = G_; c = c_; ntk = K_ / BK; ibeg = 0; iend = 1 << 30; wgm = WGM; }
    __device__ __forceinline__ int stagger() const { const int rem = nwg % G; return (STAGGER && rem != 0 && c >= rem) ? ((c >> 3) & 3) * ntk * 36 : 0; }
    __device__ __forceinline__ bool next(int i, Unit& u) const {
        if (i + ibeg >= iend) return false;
        const long L = (long)(i + ibeg) * G + c; if (L >= nwg) return false;
        u.koff = 0; u.nt = ntk; u.kind = 0;
        int wgid = (int)L; { const int q = nwg / NXCD, r = nwg % NXCD, xcd = wgid % NXCD, off = wgid / NXCD; wgid = (xcd < r ? xcd * (q + 1) : r * (q + 1) + (xcd - r) * q) + off; }
        const int nig = wgm * nN, gid = wgid / nig, fm = gid * wgm, gsz = (nM - fm) < wgm ? (nM - fm) : wgm;
        u.pm = fm + ((wgid % nig) % gsz); u.pn = (wgid % nig) / gsz; return true;
    }
};
struct GroupOrder {
    int nj, nunits, G, c, ntk;
    __device__ __forceinline__ void init(int nj_, int K_, int G_, int c_) { nj = nj_; nunits = SG * 5 * nj_; G = G_; c = c_; ntk = K_ / BK; }
    __device__ __forceinline__ bool next(int i, Unit& u) const {
        const int L = i * G + c; if (L >= nunits) return false;
        u.pm = L / nj; u.pn = (u.pm / 5) * nj + (L % nj); u.koff = 0; u.nt = ntk; u.kind = 0; return true;
    }
};
struct SplitCtxOrder {
    StaticOrder so; int nlat, nN, ntk8, kq, G, c; bool ctx;
    __device__ __forceinline__ void init(int N_, int K_, int G_, int c_, bool ctx_) { so.init(ML, N_, K_, G_, c_); nN = N_ / BM; G = G_; c = c_; ctx = ctx_; kq = K_ / 8; ntk8 = K_ / (8 * BK);
        nlat = c_ < so.nwg ? (so.nwg - c_ + G_ - 1) / G_ : 0; }
    __device__ __forceinline__ bool next(int i, Unit& u) const {
        Unit a; a.pm = 0; a.pn = 0; a.koff = 0; a.nt = 0; a.kind = 0;
        const bool la = so.next(i, a);
        const int L = (i - nlat) * G + c; const bool lc = ctx && !la && L >= 0 && L < 32 * nN;
        const int ks = L & 7;
        u.pm = la ? a.pm : ML / BM + (L >> 3) / nN; u.pn = la ? a.pn : (L >> 3) % nN; u.koff = la ? 0 : ks * kq; u.nt = la ? a.nt : ntk8; u.kind = la ? 0 : 1 + ks;
        return la || lc;
    }
};

template <class Epi, class Sched, bool F8 = false>
__device__ __forceinline__ void gemm_phase(LAS unsigned char* lds, const Gemm g, const Sched& S, const Epi& E, int stag_ticks = 0) {
    int tid_ = threadIdx.x; asm volatile("" : "+v"(tid_));
    const int tid = tid_, wid = __builtin_amdgcn_readfirstlane(tid >> 6), lane = tid & 63, wr = wid >> 2, wc = wid & 3, fr = lane & 15, fq = lane >> 4;
    unsigned voffA[2], voffB[2];
#pragma unroll
    for (int i = 0; i < 2; ++i) { int R, C; stage_rc(tid * 16 + i * 8192, R, C); const int Rb = Epi::PERM ? ((R & ~31) + perm32(R & 31)) : R;
        voffA[i] = (unsigned)(R * g.lda + C) * 2u; voffB[i] = (unsigned)(Rb * g.ldb + C) * 2u; }
    const size_t kstep = (size_t)(BK * 2);
    const size_t hA = (size_t)HALF * g.lda * 2, hB = (size_t)HALF * g.ldb * 2, tA = 2 * hA, tB = 2 * hB;
    const unsigned ldsw = (unsigned)wid * 1024u;
    const int aoff = lds_byte(wr * 64 + fr, fq * 8), boff = lds_byte(wc * 32 + fr, fq * 8);
#define PG8_SA(b, h) (((b) * 2 + (h)) * HTB)
#define PG8_SB(b, h) ((4 + (b) * 2 + (h)) * HTB)
#define PG8_STAGE(bufoff, gbase, voff) do { _Pragma("unroll") for (int _i = 0; _i < 2; ++_i) \
        __builtin_amdgcn_global_load_lds((const unsigned*)((const char*)(gbase) + (voff)[_i]), (LAS unsigned*)(lds + (bufoff) + ldsw + _i * 8192), 16, 0, 0); } while (0)
#define PG8_LDA(dst, b, h) do { _Pragma("unroll") for (int m = 0; m < 4; ++m) _Pragma("unroll") for (int k = 0; k < 2; ++k) dst[m][k] = *(const LAS bf16x8*)(lds + PG8_SA(b, h) + aoff + m * 2048 + k * 1024); } while (0)
#define PG8_LDB(dst, b, h) do { _Pragma("unroll") for (int n = 0; n < 2; ++n) _Pragma("unroll") for (int k = 0; k < 2; ++k) dst[n][k] = *(const LAS bf16x8*)(lds + PG8_SB(b, h) + boff + n * 2048 + k * 1024); } while (0)
#define PG8_MMA(ai, bj, At, Bt) do { __builtin_amdgcn_s_setprio(1); _Pragma("unroll") for (int m = 0; m < 4; ++m) _Pragma("unroll") for (int n = 0; n < 2; ++n) { \
        if constexpr (F8) { const v8i a8_ = __builtin_shufflevector(__builtin_bit_cast(v4i, At[m][0]), __builtin_bit_cast(v4i, At[m][1]), 0, 1, 2, 3, 4, 5, 6, 7); \
                            const v8i b8_ = __builtin_shufflevector(__builtin_bit_cast(v4i, Bt[n][0]), __builtin_bit_cast(v4i, Bt[n][1]), 0, 1, 2, 3, 4, 5, 6, 7); \
                            asm("s_nop 1\n\tv_mfma_scale_f32_16x16x128_f8f6f4 %0, %1, %2, %0, %3, %3 op_sel_hi:[0,0,0]" : "+v"(acc[ai][bj][m][n]) : "v"(b8_), "v"(a8_), "v"(f8_scale_)); } \
        else { _Pragma("unroll") for (int k = 0; k < 2; ++k) acc[ai][bj][m][n] = __builtin_amdgcn_mfma_f32_16x16x32_bf16(Bt[n][k], At[m][k], acc[ai][bj][m][n], 0, 0, 0); } } \
        __builtin_amdgcn_s_setprio(0); } while (0)
#define PG8_WAIT_V(n) asm volatile("s_waitcnt vmcnt(" #n ")" ::: "memory")
#define PG8_WAIT_L(n) asm volatile("s_waitcnt lgkmcnt(" #n ")" ::: "memory")
#define PG8_BAR __builtin_amdgcn_s_barrier()
#define PG8_SCHED __builtin_amdgcn_sched_barrier(0)
    const int f8_scale_ = 0x7f7f7f7f; (void)f8_scale_;
    Unit cur, nxt; int ui = 0;
    if (!S.next(0, cur)) return;
    if (stag_ticks > 0) {
        const unsigned long long t0 = __builtin_amdgcn_s_memrealtime(); while (__builtin_amdgcn_s_memrealtime() - t0 < (unsigned long long)stag_ticks) __builtin_amdgcn_s_sleep(16); }
    f32x4 acc[2][2][4][2];
#pragma unroll
    for (int a = 0; a < 2; ++a)
#pragma unroll
        for (int b = 0; b < 2; ++b)
#pragma unroll
            for (int m = 0; m < 4; ++m)
#pragma unroll
                for (int n = 0; n < 2; ++n) acc[a][b][m][n] = (f32x4){0.f, 0.f, 0.f, 0.f};
    bf16x8 At[4][2], B0[2][2], B1[2][2];
    const char* cA = (const char*)g.A + (size_t)cur.pm * tA + (size_t)cur.koff * 2; const char* cB = (const char*)g.Bt + (size_t)cur.pn * tB + (size_t)cur.koff * 2;
    PG8_STAGE(PG8_SB(0, 0), cB, voffB); PG8_STAGE(PG8_SB(0, 1), cB + hB, voffB); PG8_STAGE(PG8_SA(0, 0), cA, voffA); PG8_STAGE(PG8_SA(0, 1), cA + hA, voffA);
    if (wr == 1) PG8_BAR;
    PG8_WAIT_V(2); PG8_BAR;
    PG8_STAGE(PG8_SB(1, 0), cB + kstep, voffB); PG8_STAGE(PG8_SA(1, 0), cA + kstep, voffA); PG8_STAGE(PG8_SB(1, 1), cB + hB + kstep, voffB);
    PG8_WAIT_V(6); PG8_BAR;
    for (;;) {
        const bool has_next = S.next(ui + 1, nxt);
        const char* nA = has_next ? (const char*)g.A + (size_t)nxt.pm * tA + (size_t)nxt.koff * 2 : cA; const char* nB = has_next ? (const char*)g.Bt + (size_t)nxt.pn * tB + (size_t)nxt.koff * 2 : cB;
        const int nt = cur.nt;
        for (int t = 0; t < nt; t += 2) {
            const bool last = (t == nt - 2);
            const char* a1 = cA + (size_t)(t + 1) * kstep;
            const char* a2 = last ? nA : cA + (size_t)(t + 2) * kstep; const char* b2 = last ? nB : cB + (size_t)(t + 2) * kstep;
            const char* a3 = a2 + kstep; const char* b3 = b2 + kstep;
            PG8_LDB(B0, 0, 0); PG8_LDB(B1, 0, 1); PG8_SCHED; PG8_LDA(At, 0, 0); PG8_STAGE(PG8_SA(1, 1), a1 + hA, voffA);
            PG8_WAIT_V(8); PG8_WAIT_L(0); PG8_BAR; PG8_MMA(0, 0, At, B0); PG8_MMA(0, 1, At, B1); PG8_BAR; PG8_SCHED;
            PG8_LDA(At, 0, 1); PG8_STAGE(PG8_SB(0, 0), b2, voffB); PG8_STAGE(PG8_SB(0, 1), b2 + hB, voffB); PG8_STAGE(PG8_SA(0, 0), a2, voffA);
            PG8_WAIT_V(8); PG8_WAIT_L(0); PG8_BAR; PG8_MMA(1, 0, At, B0); PG8_MMA(1, 1, At, B1); PG8_BAR; PG8_SCHED;
            PG8_LDB(B0, 1, 0); PG8_LDB(B1, 1, 1); PG8_SCHED; PG8_LDA(At, 1, 0); PG8_STAGE(PG8_SA(0, 1), a2 + hA, voffA);
            PG8_WAIT_V(8); PG8_WAIT_L(0); PG8_BAR; PG8_MMA(0, 0, At, B0); PG8_MMA(0, 1, At, B1); PG8_BAR; PG8_SCHED;
            PG8_LDA(At, 1, 1); PG8_STAGE(PG8_SB(1, 0), b3, voffB); PG8_STAGE(PG8_SB(1, 1), b3 + hB, voffB); PG8_STAGE(PG8_SA(1, 0), a3, voffA);
            PG8_WAIT_V(8); PG8_WAIT_L(0); PG8_BAR; PG8_MMA(1, 0, At, B0); PG8_MMA(1, 1, At, B1); PG8_BAR; PG8_SCHED;
        }
        if (wr == 0) PG8_BAR;
        if constexpr (F8) asm volatile("s_nop 15\n\ts_nop 15" : "+v"(acc[1][1][3][1]), "+v"(acc[1][0][3][1]));
        E(acc, cur, wr, wc, fr, fq);
        if (!has_next) break;
#pragma unroll
        for (int a = 0; a < 2; ++a)
#pragma unroll
            for (int b = 0; b < 2; ++b)
#pragma unroll
                for (int m = 0; m < 4; ++m)
#pragma unroll
                    for (int n = 0; n < 2; ++n) acc[a][b][m][n] = (f32x4){0.f, 0.f, 0.f, 0.f};
        cur = nxt; cA = nA; cB = nB; ++ui;
        if (wr == 1) PG8_BAR;
    }
    PG8_WAIT_V(0);
    PG8_BAR;
#undef PG8_SA
#undef PG8_SB
#undef PG8_STAGE
#undef PG8_LDA
#undef PG8_LDB
#undef PG8_MMA
#undef PG8_WAIT_V
#undef PG8_WAIT_L
#undef PG8_BAR
#undef PG8_SCHED
}

typedef const f32x4 (&AccRef)[2][2][4][2];
__device__ __forceinline__ u32x4 pack8(const f32x4 v0, const f32x4 v1) { u32x4 w; w.x = cvt_pk_bf16(v0[0], v0[1]); w.y = cvt_pk_bf16(v0[2], v0[3]); w.z = cvt_pk_bf16(v1[0], v1[1]); w.w = cvt_pk_bf16(v1[2], v1[3]); return w; }
__device__ __forceinline__ void unpack8(const u32x4 w, f32x4& v0, f32x4& v1) { v0 = (f32x4){bf_lo(w.x), bf_hi(w.x), bf_lo(w.y), bf_hi(w.y)}; v1 = (f32x4){bf_lo(w.z), bf_hi(w.z), bf_lo(w.w), bf_hi(w.w)}; }

template <int ACT> struct EpiBf16 {
    static constexpr bool PERM = true;
    bf16_t* O; int ldc; int skip_below;
    __device__ __forceinline__ void operator()(AccRef acc, const Unit& u, int wr, int wc, int fr, int fq) const {
        const int row0 = u.pm * BM + wr * 64 + fr, col0 = u.pn * BM + wc * 32 + 8 * fq;
        if (u.pm < skip_below) return;
#pragma unroll
        for (int ai = 0; ai < 2; ++ai)
#pragma unroll
            for (int m = 0; m < 4; ++m) { bf16_t* rowp = O + (size_t)(row0 + ai * HALF + m * 16) * ldc + col0;
#pragma unroll
                for (int bj = 0; bj < 2; ++bj) { f32x4 v0 = acc[ai][bj][m][0], v1 = acc[ai][bj][m][1];
                    if (ACT == 1) {
#pragma unroll
                        for (int e = 0; e < 4; ++e) { const float a = fmaxf(v0[e], 0.f), b = fmaxf(v1[e], 0.f); v0[e] = a * a; v1[e] = b * b; } }
                    *(u32x4*)(rowp + bj * HALF) = pack8(v0, v1); } }
    }
};
struct EpiBf16Part {
    static constexpr bool PERM = true;
    bf16_t* O; float* PART;
    __device__ __forceinline__ void operator()(AccRef acc, const Unit& u, int wr, int wc, int fr, int fq) const {
        const int row0 = u.pm * BM + wr * 64 + fr, col0 = u.pn * BM + wc * 32 + 8 * fq;
        if (u.kind == 0) {
#pragma unroll
            for (int ai = 0; ai < 2; ++ai)
#pragma unroll
                for (int m = 0; m < 4; ++m) { bf16_t* rowp = O + (size_t)(row0 + ai * HALF + m * 16) * D + col0;
#pragma unroll
                    for (int bj = 0; bj < 2; ++bj) *(u32x4*)(rowp + bj * HALF) = pack8(acc[ai][bj][m][0], acc[ai][bj][m][1]); }
        } else {
            float* pb = PART + (size_t)(u.kind - 1) * MC * D;
#pragma unroll
            for (int ai = 0; ai < 2; ++ai)
#pragma unroll
                for (int m = 0; m < 4; ++m) { float* rowp = pb + (size_t)(row0 - ML + ai * HALF + m * 16) * D + col0;
#pragma unroll
                    for (int bj = 0; bj < 2; ++bj) { *(f32x4*)(rowp + bj * HALF) = acc[ai][bj][m][0]; *(f32x4*)(rowp + bj * HALF + 4) = acc[ai][bj][m][1]; } }
        }
    }
};
struct EpiProj {
    static constexpr bool PERM = true;
    bf16_t* P; bf16_t* Assm;
    __device__ __forceinline__ void operator()(AccRef acc, const Unit& u, int wr, int wc, int fr, int fq) const {
        const int row0 = u.pm * BM + wr * 64 + fr, col0 = u.pn * BM + wc * 32 + 8 * fq;
        if (u.pn >= 4 && u.pn < 12) {
            const int c = C_AC + (u.pn - 4) * HALF + wc * 32 + 8 * fq;
#pragma unroll
            for (int ai = 0; ai < 2; ++ai)
#pragma unroll
                for (int m = 0; m < 4; ++m) *(u32x4*)(P + (size_t)(row0 + ai * HALF + m * 16) * NIN + c) = pack8(acc[ai][0][m][0] * acc[ai][1][m][0], acc[ai][0][m][1] * acc[ai][1][m][1]);
        } else if (u.pn >= 12 && u.pn < 15) {
#pragma unroll
            for (int ai = 0; ai < 2; ++ai)
#pragma unroll
                for (int m = 0; m < 4; ++m) { const int r = row0 + ai * HALF + m * 16;
#pragma unroll
                    for (int bj = 0; bj < 2; ++bj) { const int c = col0 + bj * HALF - C_SU, gq = c >> 4, p0 = c & 15;
                        bf16_t* dst = Assm + ((size_t)(gq * SGR + (r >> 5)) * 768 + (r & 31) * 16 + p0);
                        *(u32x4*)dst = pack8(acc[ai][bj][m][0], acc[ai][bj][m][1]); } }
        } else {
#pragma unroll
            for (int ai = 0; ai < 2; ++ai)
#pragma unroll
                for (int m = 0; m < 4; ++m) { bf16_t* rowp = P + (size_t)(row0 + ai * HALF + m * 16) * NIN + col0;
#pragma unroll
                    for (int bj = 0; bj < 2; ++bj) *(u32x4*)(rowp + bj * HALF) = pack8(acc[ai][bj][m][0], acc[ai][bj][m][1]); }
        }
    }
};
struct EpiGate {
    static constexpr bool PERM = true;
    bf16_t* P;
    __device__ __forceinline__ void operator()(AccRef acc, const Unit& u, int wr, int wc, int fr, int fq) const {
        const int row0 = u.pm * BM + wr * 64 + fr, col0 = C_F8 + u.pn * BM + wc * 32 + 8 * fq;
        const bool isgate = col0 >= C_GC; const float sc = isgate ? -1.4426950408889634f / WG8_SCALE : 1.0f / WG8_SCALE;
#pragma unroll
        for (int ai = 0; ai < 2; ++ai)
#pragma unroll
            for (int m = 0; m < 4; ++m) { bf16_t* rowp = P + (size_t)(row0 + ai * HALF + m * 16) * NIN + col0;
#pragma unroll
                for (int bj = 0; bj < 2; ++bj) { f32x4 v0 = acc[ai][bj][m][0] * sc, v1 = acc[ai][bj][m][1] * sc;
                    if (isgate) {
#pragma unroll
                        for (int e = 0; e < 4; ++e) { v0[e] = sigmoid_pre_(v0[e]); v1[e] = sigmoid_pre_(v1[e]); }
                        *(u32x2*)((unsigned char*)(P + (size_t)(row0 + ai * HALF + m * 16) * NIN + C_GC) + (col0 + bj * HALF - C_GC)) = (u32x2){gate_q4_(v0), gate_q4_(v1)}; }
                    else *(u32x4*)(rowp + bj * HALF) = pack8(v0, v1); } }
    }
};
struct EpiState {
    static constexpr bool PERM = false;
    bf16_t* S;
    __device__ __forceinline__ void operator()(AccRef acc, const Unit& u, int wr, int wc, int fr, int fq) const {
        const int row0 = u.pm * BM + wr * 64 + fr, col0 = wc * 32 + 4 * fq;
#pragma unroll
        for (int ai = 0; ai < 2; ++ai)
#pragma unroll
            for (int m = 0; m < 4; ++m) { bf16_t* rowp = S + (size_t)(row0 + ai * HALF + m * 16) * 256 + col0;
#pragma unroll
                for (int bj = 0; bj < 2; ++bj)
#pragma unroll
                    for (int n = 0; n < 2; ++n) { const f32x4 v = acc[ai][bj][m][n]; *(u32x2*)(rowp + bj * HALF + n * 16) = (u32x2){cvt_pk_bf16(v[0], v[1]), cvt_pk_bf16(v[2], v[3])}; } }
    }
};
struct EpiSsmY {
    static constexpr bool PERM = true;
    bf16_t* P;
    __device__ __forceinline__ void operator()(AccRef acc, const Unit& u, int wr, int wc, int fr, int fq) const {
        const int gq = u.pm / 5, rl0 = (u.pm % 5) * BM + wr * 64 + fr, cl0 = (u.pn & 1) * BM + wc * 32 + 8 * fq;
#pragma unroll
        for (int ai = 0; ai < 2; ++ai)
#pragma unroll
            for (int m = 0; m < 4; ++m) { const int rl = rl0 + ai * HALF + m * 16;
                if (rl < SGV) {
#pragma unroll
                    for (int bj = 0; bj < 2; ++bj) { const int cl = cl0 + bj * HALF, t = cl >> 4, p0 = cl & 15;
                        f32x4 v0 = acc[ai][bj][m][0], v1 = acc[ai][bj][m][1];
#pragma unroll
                        for (int e = 0; e < 4; ++e) { v0[e] = gelu_tanh(v0[e]); v1[e] = gelu_tanh(v1[e]); }
                        *(u32x4*)(P + (size_t)(rl * 32 + t) * NIN + C_Y + gq * 16 + p0) = pack8(v0, v1); } } }
    }
};
template <bool ACCUM> struct EpiMerge {
    static constexpr bool PERM = true;
    bf16_t* Mg; const bf16_t* P; int gcol;
    __device__ __forceinline__ void operator()(AccRef acc, const Unit& u, int wr, int wc, int fr, int fq) const {
        const int row0 = u.pm * BM + wr * 64 + fr, col0 = u.pn * BM + wc * 32 + 8 * fq;
#pragma unroll
        for (int ai = 0; ai < 2; ++ai) {
            u32x2 gq[4][2]; u32x4 oq[4][2];
#pragma unroll
            for (int m = 0; m < 4; ++m) { const size_t r = (size_t)(row0 + ai * HALF + m * 16);
#pragma unroll
                for (int bj = 0; bj < 2; ++bj) { const int c = col0 + bj * HALF;
                    gq[m][bj] = *(const u32x2*)((const unsigned char*)(P + r * NIN + C_GC) + (gcol - C_GC) + c);
                    if (ACCUM) oq[m][bj] = *(const u32x4*)(Mg + r * D + c); } }
#pragma unroll
            for (int m = 0; m < 4; ++m) { const size_t r = (size_t)(row0 + ai * HALF + m * 16);
#pragma unroll
                for (int bj = 0; bj < 2; ++bj) { const int c = col0 + bj * HALF;
                    const f32x4 g0 = gate_u4_(gq[m][bj].x), g1 = gate_u4_(gq[m][bj].y);
                    f32x4 v0 = acc[ai][bj][m][0] * g0, v1 = acc[ai][bj][m][1] * g1;
                    if (ACCUM) { f32x4 o0, o1; unpack8(oq[m][bj], o0, o1); v0 += o0; v1 += o1; }
                    *(u32x4*)(Mg + r * D + c) = pack8(v0, v1); } }
        }
    }
};
struct EpiGlu {
    static constexpr bool PERM = true;
    bf16_t* Mg; const bf16_t* P;
    __device__ __forceinline__ void operator()(AccRef acc, const Unit& u, int wr, int wc, int fr, int fq) const {
        const int row0 = u.pm * BM + wr * 64 + fr, c = u.pn * HALF + wc * 32 + 8 * fq;
        u32x2 gq[2][4]; u32x4 oq[2][4];
#pragma unroll
        for (int ai = 0; ai < 2; ++ai)
#pragma unroll
            for (int m = 0; m < 4; ++m) { const size_t r = (size_t)(row0 + ai * HALF + m * 16); gq[ai][m] = *(const u32x2*)((const unsigned char*)(P + r * NIN + C_GC) + (C_GS - C_GC) + c); oq[ai][m] = *(const u32x4*)(Mg + r * D + c); }
#pragma unroll
        for (int ai = 0; ai < 2; ++ai)
#pragma unroll
            for (int m = 0; m < 4; ++m) { const size_t r = (size_t)(row0 + ai * HALF + m * 16);
                const f32x4 g0 = gate_u4_(gq[ai][m].x), g1 = gate_u4_(gq[ai][m].y);
                f32x4 o0, o1; unpack8(oq[ai][m], o0, o1);
                f32x4 a0 = acc[ai][0][m][0], a1 = acc[ai][0][m][1]; const f32x4 s0 = acc[ai][1][m][0], s1 = acc[ai][1][m][1];
#pragma unroll
                for (int e = 0; e < 4; ++e) { a0[e] = o0[e] + g0[e] * a0[e] * sigmoidf_(s0[e]); a1[e] = o1[e] + g1[e] * a1[e] * sigmoidf_(s1[e]); }
                *(u32x4*)(Mg + r * D + c) = pack8(a0, a1); }
    }
};
}

namespace attn {
constexpr int DH = 128, NW = 8, QBLK = 32, KVBLK = 64;
constexpr float SCALE = 0.088388347648318440f;
constexpr float THR = 8.f;
constexpr size_t SHM_V = KVBLK * DH * 2, SHM_K = KVBLK * DH * 2, SHM_ATTN = 2 * SHM_V + 2 * SHM_K + NW * 64 * 4;
#define KSWZ(row, colB) ((row) * 256 + ((colB) ^ (((row) & 7) << 4)))
#define SBAR() __builtin_amdgcn_sched_barrier(0)
__device__ __forceinline__ int crow(int r, int hi) { return (r & 3) + 8 * (r >> 2) + 4 * hi; }
__device__ __forceinline__ void partialSM(f32x16& p0, f32x16& p1, float& m_reg, float& mn, float& alpha) {
  constexpr float C = SCALE * 1.4426950408889634f;
  float pmax = p0[0];
#pragma unroll
  for (int r = 1; r < 16; ++r) pmax = fmaxf(pmax, p0[r]);
#pragma unroll
  for (int r = 0; r < 16; ++r) pmax = fmaxf(pmax, p1[r]);
  { auto rr = __builtin_amdgcn_permlane32_swap(__float_as_uint(pmax), __float_as_uint(pmax), false, false);
    pmax = fmaxf(__uint_as_float(rr[0]), __uint_as_float(rr[1])); }
  if (__builtin_expect(__all(pmax - m_reg <= THR / SCALE), 1)) { mn = m_reg; alpha = 1.f; }
  else { mn = fmaxf(m_reg, pmax); alpha = __builtin_amdgcn_exp2f((m_reg - mn) * C); m_reg = mn; }
  float mnC = -mn * C;
#pragma unroll
  for (int r = 0; r < 16; ++r) p0[r] = fmaf(p0[r], C, mnC);
#pragma unroll
  for (int r = 0; r < 16; ++r) p1[r] = fmaf(p1[r], C, mnC);
#pragma unroll
  for (int r = 0; r < 16; ++r) p0[r] = __builtin_amdgcn_exp2f(p0[r]);
}
__device__ __forceinline__ void finishSM(f32x16& p0, f32x16& p1, float alpha, float& l_reg, bf16x8& pa0, bf16x8& pa1, bf16x8& pa2, bf16x8& pa3) {
#pragma unroll
  for (int r = 0; r < 16; ++r) p1[r] = __builtin_amdgcn_exp2f(p1[r]);
  float ps = 0;
#pragma unroll
  for (int r = 0; r < 16; ++r) ps += p0[r];
#pragma unroll
  for (int r = 0; r < 16; ++r) ps += p1[r];
  { auto rr = __builtin_amdgcn_permlane32_swap(__float_as_uint(ps), __float_as_uint(ps), false, false);
    ps = __uint_as_float(rr[0]) + __uint_as_float(rr[1]); }
  l_reg = l_reg * alpha + ps;
#define PK4(P, BASE, OUT) do { unsigned a0 = cvt_pk_bf16(P[BASE + 0], P[BASE + 1]), a1 = cvt_pk_bf16(P[BASE + 2], P[BASE + 3]);   \
    unsigned b0 = cvt_pk_bf16(P[BASE + 4], P[BASE + 5]), b1 = cvt_pk_bf16(P[BASE + 6], P[BASE + 7]);                              \
    auto r0 = __builtin_amdgcn_permlane32_swap(a0, b0, false, false); auto r1 = __builtin_amdgcn_permlane32_swap(a1, b1, false, false); \
    u32x4 w = {r0[0], r1[0], r0[1], r1[1]}; OUT = *reinterpret_cast<bf16x8*>(&w); } while (0)
  PK4(p0, 0, pa0); PK4(p0, 8, pa1); PK4(p1, 0, pa2); PK4(p1, 8, pa3);
#undef PK4
}
__device__ __forceinline__ void qkt(f32x16& p0, f32x16& p1, const char* Ks, const bf16x8* qr, int r32, int hi) {
  p0 = f32x16{}; p1 = f32x16{};
#pragma unroll
  for (int d0 = 0; d0 < 8; ++d0) { int cb = (d0 * 16 + hi * 8) * 2;
    bf16x8 b0 = *reinterpret_cast<const bf16x8*>(Ks + KSWZ(r32, cb));
    bf16x8 b1 = *reinterpret_cast<const bf16x8*>(Ks + KSWZ(32 + r32, cb));
    p0 = __builtin_amdgcn_mfma_f32_32x32x16_bf16(b0, qr[d0], p0, 0, 0, 0);
    p1 = __builtin_amdgcn_mfma_f32_32x32x16_bf16(b1, qr[d0], p1, 0, 0, 0); }
}
__device__ __forceinline__ int v_st(int k, int c) { const int kk = (k & ~0xC) | ((k & 4) << 1) | ((k & 8) >> 1); return ((kk >> 3) * 4 + (c >> 5)) * 512 + ((kk & 7) * 32 + (c & 31)) * 2; }
__device__ __forceinline__ int v_rd_base(int lane) { return ((lane & 3) << 3) | (((lane >> 2) & 3) << 6) | (((lane >> 4) & 1) << 5) | (((lane >> 5) & 1) << 8); }
constexpr int v_rd_off(int d0, int ks, int half) { return d0 * 512 + ks * 4096 + half * 2048; }
template <int OFF> __device__ __forceinline__ s16x4 tr_read(int vb) {
  s16x4 r; asm volatile("ds_read_b64_tr_b16 %0, %1 offset:%2" : "=&v"(r) : "v"(vb), "i"(OFF) : "memory"); return r;
}
template <int D0> __device__ __forceinline__ void pv_one(f32x16& od, int vb, bf16x8 pa0, bf16x8 pa1, bf16x8 pa2, bf16x8 pa3) {
  const s16x4 l0 = tr_read<v_rd_off(D0, 0, 0)>(vb), h0 = tr_read<v_rd_off(D0, 0, 1)>(vb), l1 = tr_read<v_rd_off(D0, 1, 0)>(vb), h1 = tr_read<v_rd_off(D0, 1, 1)>(vb);
  const s16x4 l2 = tr_read<v_rd_off(D0, 2, 0)>(vb), h2 = tr_read<v_rd_off(D0, 2, 1)>(vb), l3 = tr_read<v_rd_off(D0, 3, 0)>(vb), h3 = tr_read<v_rd_off(D0, 3, 1)>(vb);
  asm volatile("s_waitcnt lgkmcnt(0)" ::: "memory"); SBAR();
#define PK(L, H) (bf16x8){L[0], L[1], L[2], L[3], H[0], H[1], H[2], H[3]}
  od = __builtin_amdgcn_mfma_f32_32x32x16_bf16(pa0, PK(l0, h0), od, 0, 0, 0);
  od = __builtin_amdgcn_mfma_f32_32x32x16_bf16(pa1, PK(l1, h1), od, 0, 0, 0);
  od = __builtin_amdgcn_mfma_f32_32x32x16_bf16(pa2, PK(l2, h2), od, 0, 0, 0);
  od = __builtin_amdgcn_mfma_f32_32x32x16_bf16(pa3, PK(l3, h3), od, 0, 0, 0);
#undef PK
}
__device__ __forceinline__ void pv_d0(f32x16* o, int vb, bf16x8 pa0, bf16x8 pa1, bf16x8 pa2, bf16x8 pa3) {
  pv_one<0>(o[0], vb, pa0, pa1, pa2, pa3); pv_one<1>(o[1], vb, pa0, pa1, pa2, pa3); pv_one<2>(o[2], vb, pa0, pa1, pa2, pa3); pv_one<3>(o[3], vb, pa0, pa1, pa2, pa3);
}
__device__ __forceinline__ void attn_unit(const bf16_t* __restrict__ Qb, const bf16_t* __restrict__ Kc, const bf16_t* __restrict__ Kl, bf16_t* __restrict__ Ob, int nkc, int seq, char* lds,
                                          const float* __restrict__ qg, const float* __restrict__ rope, int t0) {
  int tid_ = threadIdx.x; asm volatile("" : "+v"(tid_));
  const int tid = tid_, wid = tid >> 6, lane = tid & 63, r32 = lane & 31, hi = lane >> 5;
  char* V_lds = lds; char* K_lds = lds + 2 * SHM_V;
  float* ws = (float*)(lds + 2 * SHM_V + 2 * SHM_K) + wid * 64; float* li_l = ws; float* al_l = ws + 32;
  float m_reg = -1e30f, l_reg = 0; f32x16 o[4] = {}; bf16x8 qr[8];
  const bf16_t* Qw = Qb + (long)(wid * QBLK + r32) * NIN + hi * 8;
  {
    float qf[8][8]; float ss = 0.f;
#pragma unroll
    for (int d0 = 0; d0 < 8; ++d0) { const u32x4 w = *reinterpret_cast<const u32x4*>(Qw + d0 * 16);
      qf[d0][0] = bf_lo(w.x); qf[d0][1] = bf_hi(w.x); qf[d0][2] = bf_lo(w.y); qf[d0][3] = bf_hi(w.y); qf[d0][4] = bf_lo(w.z); qf[d0][5] = bf_hi(w.z); qf[d0][6] = bf_lo(w.w); qf[d0][7] = bf_hi(w.w);
#pragma unroll
      for (int j = 0; j < 8; ++j) ss += qf[d0][j] * qf[d0][j]; }
    ss += __shfl_xor(ss, 32);
    const float rstd = rsqrtf(ss * (1.f / 128.f) + NORM_EPS);
#pragma unroll
    for (int d0 = 0; d0 < 8; ++d0) { const f32x4 g0 = *reinterpret_cast<const f32x4*>(qg + d0 * 16 + hi * 8), g1 = *reinterpret_cast<const f32x4*>(qg + d0 * 16 + hi * 8 + 4);
#pragma unroll
      for (int j = 0; j < 4; ++j) { qf[d0][j] *= rstd * g0[j]; qf[d0][4 + j] *= rstd * g1[j]; } }
    if (t0 >= 0) {
      const int t = t0 + wid * QBLK + r32;
#pragma unroll
      for (int hf = 0; hf < 2; ++hf) { const int pos = hf == 0 ? (t >> 6) : (t & 63);
#pragma unroll
        for (int q1 = 0; q1 < 2; ++q1) { const float* rp = rope + pos * 32 + 16 * q1 + 8 * hi;
          const f32x4 c0 = *reinterpret_cast<const f32x4*>(rp), c1 = *reinterpret_cast<const f32x4*>(rp + 4), s0 = *reinterpret_cast<const f32x4*>(rp + 4096), s1 = *reinterpret_cast<const f32x4*>(rp + 4100);
          const int da = 4 * hf + q1, db = da + 2;
#pragma unroll
          for (int j = 0; j < 8; ++j) { const float cs = j < 4 ? c0[j] : c1[j - 4], sn = j < 4 ? s0[j] : s1[j - 4]; const float x1 = qf[da][j], x2 = qf[db][j];
            qf[da][j] = x1 * cs - x2 * sn; qf[db][j] = x2 * cs + x1 * sn; } } }
    }
#pragma unroll
    for (int d0 = 0; d0 < 8; ++d0) { u32x4 w; w.x = cvt_pk_bf16(qf[d0][0], qf[d0][1]); w.y = cvt_pk_bf16(qf[d0][2], qf[d0][3]); w.z = cvt_pk_bf16(qf[d0][4], qf[d0][5]); w.w = cvt_pk_bf16(qf[d0][6], qf[d0][7]);
      qr[d0] = *reinterpret_cast<bf16x8*>(&w); }
  }
  const int sr = tid >> 4, sc = (tid & 15) * 8, vst0 = v_st(sr, sc), vst1 = v_st(32 + sr, sc);
  const int vb0 = (int)(uintptr_t)V_lds + v_rd_base(lane);
  struct { bf16x8 vs0, vs1, ks0, ks1; } sr_[2];
#define KROWP(k0) (((k0) < nkc) ? (Kc + (long)(k0) * NIN) : (Kl + (long)((k0) - nkc) * NIN))
#define SLOAD(i, k0) do { const bf16_t* kb_ = KROWP(k0) + (long)sr * NIN + sc; \
    sr_[i].vs0 = *reinterpret_cast<const bf16x8*>(kb_ + 256); sr_[i].vs1 = *reinterpret_cast<const bf16x8*>(kb_ + 32L * NIN + 256); \
    sr_[i].ks0 = *reinterpret_cast<const bf16x8*>(kb_); sr_[i].ks1 = *reinterpret_cast<const bf16x8*>(kb_ + 32L * NIN); } while (0)
#define SWRITE(b, i) do { *(bf16x8*)(V_lds + (b) * SHM_V + vst0) = sr_[i].vs0;          \
    *(bf16x8*)(V_lds + (b) * SHM_V + vst1) = sr_[i].vs1; int kc = sc * 2;               \
    *(bf16x8*)(K_lds + (b) * SHM_K + KSWZ(sr, kc)) = sr_[i].ks0;                       \
    *(bf16x8*)(K_lds + (b) * SHM_K + KSWZ(32 + sr, kc)) = sr_[i].ks1; } while (0)
#define SWAIT() asm volatile("s_waitcnt vmcnt(4)" ::: "memory")
#define RESC(a) do { if (__any((a) < 1.f)) { if (hi == 0) al_l[r32] = (a); asm volatile("s_waitcnt lgkmcnt(0)" ::: "memory"); \
    _Pragma("unroll") for (int d = 0; d < 4; ++d) _Pragma("unroll") for (int r = 0; r < 16; ++r) o[d][r] *= al_l[crow(r, hi)]; } } while (0)
  f32x16 pA0, pA1, pB0, pB1; float mnA, mnB, alA, alB; bf16x8 pa0, pa1, pa2, pa3; const int NT = seq / KVBLK;
  constexpr int SE = 0, SO = 1;
  SLOAD(SE, 0); asm volatile("s_waitcnt vmcnt(0)" ::: "memory"); SWRITE(0, SE); __syncthreads();
  qkt(pA0, pA1, K_lds, qr, r32, hi); partialSM(pA0, pA1, m_reg, mnA, alA);
  SLOAD(SO, KVBLK); if (2 < NT) SLOAD(SE, 2 * KVBLK);
  SWAIT(); SWRITE(1, SO); __syncthreads();
  for (int j = 1; j + 1 < NT; j += 2) {
    SBAR(); qkt(pB0, pB1, K_lds + SHM_K, qr, r32, hi);
    finishSM(pA0, pA1, alA, l_reg, pa0, pa1, pa2, pa3); SBAR();
    SLOAD(SO, (j + 2) * KVBLK); SBAR();
    pv_d0(o, vb0, pa0, pa1, pa2, pa3); partialSM(pB0, pB1, m_reg, mnB, alB);
    __syncthreads(); SWAIT(); SWRITE(0, SE);
    RESC(alB); __syncthreads();
    SBAR(); qkt(pA0, pA1, K_lds, qr, r32, hi);
    finishSM(pB0, pB1, alB, l_reg, pa0, pa1, pa2, pa3); SBAR();
    if (j + 3 < NT) SLOAD(SE, (j + 3) * KVBLK); SBAR();
    pv_d0(o, vb0 + (int)SHM_V, pa0, pa1, pa2, pa3); partialSM(pA0, pA1, m_reg, mnA, alA);
    __syncthreads(); SWAIT(); SWRITE(1, SO);
    RESC(alA); __syncthreads();
  }
  SBAR(); qkt(pB0, pB1, K_lds + SHM_K, qr, r32, hi);
  finishSM(pA0, pA1, alA, l_reg, pa0, pa1, pa2, pa3); SBAR();
  pv_d0(o, vb0, pa0, pa1, pa2, pa3); partialSM(pB0, pB1, m_reg, mnB, alB);
  __syncthreads(); RESC(alB);
  finishSM(pB0, pB1, alB, l_reg, pa0, pa1, pa2, pa3); SBAR();
  pv_d0(o, vb0 + (int)SHM_V, pa0, pa1, pa2, pa3);
  if (hi == 0) li_l[r32] = l_reg; asm volatile("s_waitcnt lgkmcnt(0)" ::: "memory");
  float rli[16];
#pragma unroll
  for (int r = 0; r < 16; ++r) rli[r] = __builtin_amdgcn_rcpf(li_l[crow(r, hi)]);
  bf16_t* Ow = Ob + (long)(wid * QBLK) * NIN;
#pragma unroll
  for (int r = 0; r < 16; ++r) { int orow = crow(r, hi);
#pragma unroll
    for (int d0 = 0; d0 < 4; ++d0) Ow[(long)orow * NIN + d0 * 32 + r32] = (bf16_t)(cvt_pk_bf16(o[d0][r] * rli[r], 0.f) & 0xffffu); }
  __syncthreads();
#undef KROWP
#undef SLOAD
#undef SWRITE
#undef SWAIT
#undef RESC
}

constexpr size_t SHM_K8 = KVBLK * DH;
__device__ __forceinline__ void qkt8(f32x16& p0, f32x16& p1, const char* Ks, const v8i* q8, int r32, int hi) {
  p0 = f32x16{}; p1 = f32x16{};
  const int sw = (r32 >> 1) & 7;
#pragma unroll
  for (int j = 0; j < 2; ++j) { const int c0 = (4 * j + 2 * hi) ^ sw, c1 = (4 * j + 2 * hi + 1) ^ sw;
    const v4i a0 = *reinterpret_cast<const v4i*>(Ks + r32 * 128 + 16 * c0), a1 = *reinterpret_cast<const v4i*>(Ks + r32 * 128 + 16 * c1);
    const v4i b0 = *reinterpret_cast<const v4i*>(Ks + (32 + r32) * 128 + 16 * c0), b1 = *reinterpret_cast<const v4i*>(Ks + (32 + r32) * 128 + 16 * c1);
    const v8i ka = __builtin_shufflevector(a0, a1, 0, 1, 2, 3, 4, 5, 6, 7), kb = __builtin_shufflevector(b0, b1, 0, 1, 2, 3, 4, 5, 6, 7);
    p0 = __builtin_amdgcn_mfma_scale_f32_32x32x64_f8f6f4(ka, q8[j], p0, 0, 0, 0, 0x7f7f7f7f, 0, 0x7f7f7f7f);
    p1 = __builtin_amdgcn_mfma_scale_f32_32x32x64_f8f6f4(kb, q8[j], p1, 0, 0, 0, 0x7f7f7f7f, 0, 0x7f7f7f7f); }
}
__device__ __forceinline__ void attn_unit8(const bf16_t* __restrict__ Qb, const unsigned char* __restrict__ K8b, const bf16_t* __restrict__ Vc, const bf16_t* __restrict__ Vl, bf16_t* __restrict__ Ob,
                                           int nkc, int seq, char* lds, const float* __restrict__ qg, const float* __restrict__ rope, int t0) {
  int tid_ = threadIdx.x; asm volatile("" : "+v"(tid_));
  const int tid = tid_, wid = tid >> 6, lane = tid & 63, r32 = lane & 31, hi = lane >> 5;
  char* V_lds = lds; char* K_lds = lds + 2 * SHM_V;
  float* ws = (float*)(lds + 2 * SHM_V + 2 * SHM_K8) + wid * 64; float* li_l = ws; float* al_l = ws + 32;
  float m_reg = -1e30f, l_reg = 0; f32x16 o[4] = {}; v8i q8[2];
  {
    const bf16_t* Qw = Qb + (long)(wid * QBLK + r32) * NIN + hi * 32;
    float qf[2][4][8]; float ss = 0.f;
#pragma unroll
    for (int j = 0; j < 2; ++j)
#pragma unroll
      for (int i = 0; i < 4; ++i) { const u32x4 w = *reinterpret_cast<const u32x4*>(Qw + 64 * j + 8 * i);
        qf[j][i][0] = bf_lo(w.x); qf[j][i][1] = bf_hi(w.x); qf[j][i][2] = bf_lo(w.y); qf[j][i][3] = bf_hi(w.y); qf[j][i][4] = bf_lo(w.z); qf[j][i][5] = bf_hi(w.z); qf[j][i][6] = bf_lo(w.w); qf[j][i][7] = bf_hi(w.w);
#pragma unroll
        for (int e = 0; e < 8; ++e) ss += qf[j][i][e] * qf[j][i][e]; }
    ss += __shfl_xor(ss, 32);
    const float rstd = rsqrtf(ss * (1.f / 128.f) + NORM_EPS);
#pragma unroll
    for (int j = 0; j < 2; ++j)
#pragma unroll
      for (int i = 0; i < 4; ++i) { const float* gp = qg + 64 * j + 32 * hi + 8 * i; const f32x4 g0 = *reinterpret_cast<const f32x4*>(gp), g1 = *reinterpret_cast<const f32x4*>(gp + 4);
#pragma unroll
        for (int e = 0; e < 4; ++e) { qf[j][i][e] *= rstd * g0[e]; qf[j][i][4 + e] *= rstd * g1[e]; } }
    if (t0 >= 0) {
      const int t = t0 + wid * QBLK + r32;
#pragma unroll
      for (int j = 0; j < 2; ++j) { const int pos = j == 0 ? (t >> 6) : (t & 63);
#pragma unroll
        for (int i = 0; i < 4; ++i) { const float* rp = rope + pos * 32 + 8 * i;
          const f32x4 c0 = *reinterpret_cast<const f32x4*>(rp), c1 = *reinterpret_cast<const f32x4*>(rp + 4), s0 = *reinterpret_cast<const f32x4*>(rp + 4096), s1 = *reinterpret_cast<const f32x4*>(rp + 4100);
#pragma unroll
          for (int e = 0; e < 8; ++e) { const float cs = e < 4 ? c0[e] : c1[e - 4], sn = e < 4 ? s0[e] : s1[e - 4]; const float x = qf[j][i][e], pr = __shfl_xor(x, 32);
            qf[j][i][e] = x * cs + (hi ? pr : -pr) * sn; } } }
    }
#pragma unroll
    for (int j = 0; j < 2; ++j) { int w[8];
#pragma unroll
      for (int i = 0; i < 4; ++i) { unsigned t0_ = 0u, t1_ = 0u;
        t0_ = __builtin_amdgcn_cvt_pk_fp8_f32(qf[j][i][0], qf[j][i][1], t0_, false); t0_ = __builtin_amdgcn_cvt_pk_fp8_f32(qf[j][i][2], qf[j][i][3], t0_, true);
        t1_ = __builtin_amdgcn_cvt_pk_fp8_f32(qf[j][i][4], qf[j][i][5], t1_, false); t1_ = __builtin_amdgcn_cvt_pk_fp8_f32(qf[j][i][6], qf[j][i][7], t1_, true);
        w[2 * i] = (int)t0_; w[2 * i + 1] = (int)t1_; }
      q8[j] = (v8i){w[0], w[1], w[2], w[3], w[4], w[5], w[6], w[7]}; }
  }
  const int sr = tid >> 4, sc = (tid & 15) * 8, vst0 = v_st(sr, sc), vst1 = v_st(32 + sr, sc);
  const int krow = tid >> 3, kch = tid & 7, kst = krow * 128 + 16 * (kch ^ ((krow >> 1) & 7));
  const int vb0 = (int)(uintptr_t)V_lds + v_rd_base(lane);
  struct { bf16x8 vs0, vs1; v4i ks; } sr_[2];
#define VROWP(k0) (((k0) < nkc) ? (Vc + (long)(k0) * NIN) : (Vl + (long)((k0) - nkc) * NIN))
#define SLOAD(i, k0) do { const bf16_t* vb_ = VROWP(k0) + (long)sr * NIN + sc; \
    sr_[i].vs0 = *reinterpret_cast<const bf16x8*>(vb_); sr_[i].vs1 = *reinterpret_cast<const bf16x8*>(vb_ + 32L * NIN); \
    sr_[i].ks = *reinterpret_cast<const v4i*>(K8b + (long)((k0) + krow) * 128 + 16 * kch); } while (0)
#define SWRITE(b, i) do { *(bf16x8*)(V_lds + (b) * SHM_V + vst0) = sr_[i].vs0; *(bf16x8*)(V_lds + (b) * SHM_V + vst1) = sr_[i].vs1; \
    *(v4i*)(K_lds + (b) * SHM_K8 + kst) = sr_[i].ks; } while (0)
#define SWAIT() asm volatile("s_waitcnt vmcnt(3)" ::: "memory")
#define RESC(a) do { if (__any((a) < 1.f)) { if (hi == 0) al_l[r32] = (a); asm volatile("s_waitcnt lgkmcnt(0)" ::: "memory"); \
    _Pragma("unroll") for (int d = 0; d < 4; ++d) _Pragma("unroll") for (int r = 0; r < 16; ++r) o[d][r] *= al_l[crow(r, hi)]; } } while (0)
  f32x16 pA0, pA1, pB0, pB1; float mnA, mnB, alA, alB; bf16x8 pa0, pa1, pa2, pa3; const int NT = seq / KVBLK;
  constexpr int SE = 0, SO = 1;
  SLOAD(SE, 0); asm volatile("s_waitcnt vmcnt(0)" ::: "memory"); SWRITE(0, SE); __syncthreads();
  qkt8(pA0, pA1, K_lds, q8, r32, hi); partialSM(pA0, pA1, m_reg, mnA, alA);
  SLOAD(SO, KVBLK); if (2 < NT) SLOAD(SE, 2 * KVBLK);
  SWAIT(); SWRITE(1, SO); __syncthreads();
  for (int j = 1; j + 1 < NT; j += 2) {
    SBAR(); qkt8(pB0, pB1, K_lds + SHM_K8, q8, r32, hi);
    finishSM(pA0, pA1, alA, l_reg, pa0, pa1, pa2, pa3); SBAR();
    SLOAD(SO, (j + 2) * KVBLK); SBAR();
    pv_d0(o, vb0, pa0, pa1, pa2, pa3); partialSM(pB0, pB1, m_reg, mnB, alB);
    __syncthreads(); SWAIT(); SWRITE(0, SE);
    RESC(alB); __syncthreads();
    SBAR(); qkt8(pA0, pA1, K_lds, q8, r32, hi);
    finishSM(pB0, pB1, alB, l_reg, pa0, pa1, pa2, pa3); SBAR();
    if (j + 3 < NT) SLOAD(SE, (j + 3) * KVBLK); SBAR();
    pv_d0(o, vb0 + (int)SHM_V, pa0, pa1, pa2, pa3); partialSM(pA0, pA1, m_reg, mnA, alA);
    __syncthreads(); SWAIT(); SWRITE(1, SO);
    RESC(alA); __syncthreads();
  }
  SBAR(); qkt8(pB0, pB1, K_lds + SHM_K8, q8, r32, hi);
  finishSM(pA0, pA1, alA, l_reg, pa0, pa1, pa2, pa3); SBAR();
  pv_d0(o, vb0, pa0, pa1, pa2, pa3); partialSM(pB0, pB1, m_reg, mnB, alB);
  __syncthreads(); RESC(alB);
  finishSM(pB0, pB1, alB, l_reg, pa0, pa1, pa2, pa3); SBAR();
  pv_d0(o, vb0 + (int)SHM_V, pa0, pa1, pa2, pa3);
  if (hi == 0) li_l[r32] = l_reg; asm volatile("s_waitcnt lgkmcnt(0)" ::: "memory");
  float rli[16];
#pragma unroll
  for (int r = 0; r < 16; ++r) rli[r] = __builtin_amdgcn_rcpf(li_l[crow(r, hi)]);
  bf16_t* Ow = Ob + (long)(wid * QBLK) * NIN;
#pragma unroll
  for (int r = 0; r < 16; ++r) { int orow = crow(r, hi);
#pragma unroll
    for (int d0 = 0; d0 < 4; ++d0) Ow[(long)orow * NIN + d0 * 32 + r32] = (bf16_t)(cvt_pk_bf16(o[d0][r] * rli[r], 0.f) & 0xffffu); }
  __syncthreads();
#undef VROWP
#undef SLOAD
#undef SWRITE
#undef SWAIT
#undef RESC
}

constexpr float THR8 = 3.f;
constexpr size_t SHM_V8 = KVBLK * DH;
__host__ __device__ __forceinline__ int v_pos(int kk) { return 32 * ((kk >> 2) & 1) + 16 * (kk >> 5) + (kk & 3) + 4 * ((kk & 31) >> 3); }
__device__ __forceinline__ float fma_s(float a, float b, float c) { float r; asm("v_fma_f32 %0, %1, %2, %3" : "=v"(r) : "v"(a), "v"(b), "v"(c)); return r; }
__device__ __forceinline__ void partialSM8(f32x16& p0, f32x16& p1, float& m_reg, float& mn, float& alpha) {
  constexpr float C = SCALE * 1.4426950408889634f;
  float pmax = p0[0];
#pragma unroll
  for (int r = 1; r < 16; ++r) pmax = fmaxf(pmax, p0[r]);
#pragma unroll
  for (int r = 0; r < 16; ++r) pmax = fmaxf(pmax, p1[r]);
  { auto rr = __builtin_amdgcn_permlane32_swap(__float_as_uint(pmax), __float_as_uint(pmax), false, false);
    pmax = fmaxf(__uint_as_float(rr[0]), __uint_as_float(rr[1])); }
  if (__builtin_expect(__all(pmax - m_reg <= THR8 / SCALE), 1)) { mn = m_reg; alpha = 1.f; }
  else { mn = fmaxf(m_reg, pmax); alpha = __builtin_amdgcn_exp2f((m_reg - mn) * C); m_reg = mn; }
  float mnC = 4.0f - mn * C;
#pragma unroll
  for (int r = 0; r < 16; ++r) p0[r] = fma_s(p0[r], C, mnC);
#pragma unroll
  for (int r = 0; r < 16; ++r) p1[r] = fma_s(p1[r], C, mnC);
#pragma unroll
  for (int r = 0; r < 16; ++r) p0[r] = __builtin_amdgcn_exp2f(p0[r]);
}
__device__ __forceinline__ void finishSM8(f32x16& p0, f32x16& p1, float alpha, float& l_reg, v8i& p8) {
#pragma unroll
  for (int r = 0; r < 16; ++r) p1[r] = __builtin_amdgcn_exp2f(p1[r]);
  float ps = 0;
#pragma unroll
  for (int r = 0; r < 16; ++r) ps += p0[r];
#pragma unroll
  for (int r = 0; r < 16; ++r) ps += p1[r];
  { auto rr = __builtin_amdgcn_permlane32_swap(__float_as_uint(ps), __float_as_uint(ps), false, false);
    ps = __uint_as_float(rr[0]) + __uint_as_float(rr[1]); }
  l_reg = l_reg * alpha + ps;
  int w[8];
#pragma unroll
  for (int i = 0; i < 4; ++i) { unsigned a = 0u, b = 0u;
    a = __builtin_amdgcn_cvt_pk_fp8_f32(p0[4 * i], p0[4 * i + 1], a, false); a = __builtin_amdgcn_cvt_pk_fp8_f32(p0[4 * i + 2], p0[4 * i + 3], a, true);
    b = __builtin_amdgcn_cvt_pk_fp8_f32(p1[4 * i], p1[4 * i + 1], b, false); b = __builtin_amdgcn_cvt_pk_fp8_f32(p1[4 * i + 2], p1[4 * i + 3], b, true);
    w[i] = (int)a; w[4 + i] = (int)b; }
  p8 = (v8i){w[0], w[1], w[2], w[3], w[4], w[5], w[6], w[7]};
}
__device__ __forceinline__ void pv8(f32x16* o, const char* Vs, v8i p8, int r32, int hi) {
  const int sw = (r32 >> 2) & 3, c0 = (2 * hi) ^ sw, c1 = (2 * hi + 1) ^ sw;
#pragma unroll
  for (int d0 = 0; d0 < 4; ++d0) { const char* rp = Vs + (32 * d0 + r32) * 64;
    const v4i v0 = *reinterpret_cast<const v4i*>(rp + 16 * c0), v1 = *reinterpret_cast<const v4i*>(rp + 16 * c1);
    const v8i vf = __builtin_shufflevector(v0, v1, 0, 1, 2, 3, 4, 5, 6, 7);
    o[d0] = __builtin_amdgcn_mfma_scale_f32_32x32x64_f8f6f4(p8, vf, o[d0], 0, 0, 0, 0x7b7b7b7b, 0, 0x7f7f7f7f); }
}
__device__ __forceinline__ void attn_unit9(const bf16_t* __restrict__ Qb, const unsigned char* __restrict__ K8b, const unsigned char* __restrict__ VT8b, bf16_t* __restrict__ Ob,
                                           int seq, char* lds, const float* __restrict__ qg, const float* __restrict__ rope, int t0) {
  int tid_ = threadIdx.x; asm volatile("" : "+v"(tid_));
  const int tid = tid_, wid = tid >> 6, lane = tid & 63, r32 = lane & 31, hi = lane >> 5;
  char* V_lds = lds; char* K_lds = lds + 2 * SHM_V8;
  float* ws = (float*)(lds + 2 * SHM_V8 + 2 * SHM_K8) + wid * 64; float* li_l = ws; float* al_l = ws + 32;
  float m_reg = -1e30f, l_reg = 0; f32x16 o[4] = {}; v8i q8[2];
  {
    const bf16_t* Qw = Qb + (long)(wid * QBLK + r32) * NIN + hi * 32;
    float qf[2][4][8]; float ss = 0.f;
#pragma unroll
    for (int j = 0; j < 2; ++j)
#pragma unroll
      for (int i = 0; i < 4; ++i) { const u32x4 w = *reinterpret_cast<const u32x4*>(Qw + 64 * j + 8 * i);
        qf[j][i][0] = bf_lo(w.x); qf[j][i][1] = bf_hi(w.x); qf[j][i][2] = bf_lo(w.y); qf[j][i][3] = bf_hi(w.y); qf[j][i][4] = bf_lo(w.z); qf[j][i][5] = bf_hi(w.z); qf[j][i][6] = bf_lo(w.w); qf[j][i][7] = bf_hi(w.w);
#pragma unroll
        for (int e = 0; e < 8; ++e) ss += qf[j][i][e] * qf[j][i][e]; }
    ss += __shfl_xor(ss, 32);
    const float rstd = rsqrtf(ss * (1.f / 128.f) + NORM_EPS);
#pragma unroll
    for (int j = 0; j < 2; ++j)
#pragma unroll
      for (int i = 0; i < 4; ++i) { const float* gp = qg + 64 * j + 32 * hi + 8 * i; const f32x4 g0 = *reinterpret_cast<const f32x4*>(gp), g1 = *reinterpret_cast<const f32x4*>(gp + 4);
#pragma unroll
        for (int e = 0; e < 4; ++e) { qf[j][i][e] *= rstd * g0[e]; qf[j][i][4 + e] *= rstd * g1[e]; } }
    if (t0 >= 0) {
      const int t = t0 + wid * QBLK + r32;
#pragma unroll
      for (int j = 0; j < 2; ++j) { const int pos = j == 0 ? (t >> 6) : (t & 63);
#pragma unroll
        for (int i = 0; i < 4; ++i) { const float* rp = rope + pos * 32 + 8 * i;
          const f32x4 c0 = *reinterpret_cast<const f32x4*>(rp), c1 = *reinterpret_cast<const f32x4*>(rp + 4), s0 = *reinterpret_cast<const f32x4*>(rp + 4096), s1 = *reinterpret_cast<const f32x4*>(rp + 4100);
#pragma unroll
          for (int e = 0; e < 8; ++e) { const float cs = e < 4 ? c0[e] : c1[e - 4], sn = e < 4 ? s0[e] : s1[e - 4]; const float x = qf[j][i][e], pr = __shfl_xor(x, 32);
            qf[j][i][e] = x * cs + (hi ? pr : -pr) * sn; } } }
    }
#pragma unroll
    for (int j = 0; j < 2; ++j) { int w[8];
#pragma unroll
      for (int i = 0; i < 4; ++i) { unsigned t0_ = 0u, t1_ = 0u;
        t0_ = __builtin_amdgcn_cvt_pk_fp8_f32(qf[j][i][0], qf[j][i][1], t0_, false); t0_ = __builtin_amdgcn_cvt_pk_fp8_f32(qf[j][i][2], qf[j][i][3], t0_, true);
        t1_ = __builtin_amdgcn_cvt_pk_fp8_f32(qf[j][i][4], qf[j][i][5], t1_, false); t1_ = __builtin_amdgcn_cvt_pk_fp8_f32(qf[j][i][6], qf[j][i][7], t1_, true);
        w[2 * i] = (int)t0_; w[2 * i + 1] = (int)t1_; }
      q8[j] = (v8i){w[0], w[1], w[2], w[3], w[4], w[5], w[6], w[7]}; }
  }
  const int krow = tid >> 3, kch = tid & 7, kst = krow * 128 + 16 * (kch ^ ((krow >> 1) & 7));
  const int vrow = tid >> 2, vch = tid & 3, vst = vrow * 64 + 16 * (vch ^ ((vrow >> 2) & 3));
  struct { v4i vs, ks; } sr_[2];
#define SLOAD(i, k0) do { sr_[i].vs = *reinterpret_cast<const v4i*>(VT8b + (long)(k0) * 128 + 16 * tid); \
    sr_[i].ks = *reinterpret_cast<const v4i*>(K8b + (long)((k0) + krow) * 128 + 16 * kch); } while (0)
#define SWRITE(b, i) do { *(v4i*)(V_lds + (b) * SHM_V8 + vst) = sr_[i].vs; *(v4i*)(K_lds + (b) * SHM_K8 + kst) = sr_[i].ks; } while (0)
#define SWAIT() asm volatile("s_waitcnt vmcnt(2)" ::: "memory")
#define RESC(a) do { if (__any((a) < 1.f)) { if (hi == 0) al_l[r32] = (a); asm volatile("s_waitcnt lgkmcnt(0)" ::: "memory"); \
    _Pragma("unroll") for (int d = 0; d < 4; ++d) _Pragma("unroll") for (int r = 0; r < 16; ++r) o[d][r] *= al_l[crow(r, hi)]; } } while (0)
  f32x16 pA0, pA1, pB0, pB1; float mnA, mnB, alA, alB; v8i p8; const int NT = seq / KVBLK;
  constexpr int SE = 0, SO = 1;
  SLOAD(SE, 0); asm volatile("s_waitcnt vmcnt(0)" ::: "memory"); SWRITE(0, SE); __syncthreads();
  qkt8(pA0, pA1, K_lds, q8, r32, hi); partialSM8(pA0, pA1, m_reg, mnA, alA);
  SLOAD(SO, KVBLK); if (2 < NT) SLOAD(SE, 2 * KVBLK);
  SWAIT(); SWRITE(1, SO); __syncthreads();
  for (int j = 1; j + 1 < NT; j += 2) {
    SBAR(); qkt8(pB0, pB1, K_lds + SHM_K8, q8, r32, hi);
    finishSM8(pA0, pA1, alA, l_reg, p8); SBAR();
    SLOAD(SO, (j + 2) * KVBLK); SBAR();
    pv8(o, V_lds, p8, r32, hi); partialSM8(pB0, pB1, m_reg, mnB, alB);
    __syncthreads(); SWAIT(); SWRITE(0, SE);
    RESC(alB); __syncthreads();
    SBAR(); qkt8(pA0, pA1, K_lds, q8, r32, hi);
    finishSM8(pB0, pB1, alB, l_reg, p8); SBAR();
    if (j + 3 < NT) SLOAD(SE, (j + 3) * KVBLK); SBAR();
    pv8(o, V_lds + SHM_V8, p8, r32, hi); partialSM8(pA0, pA1, m_reg, mnA, alA);
    __syncthreads(); SWAIT(); SWRITE(1, SO);
    RESC(alA); __syncthreads();
  }
  SBAR(); qkt8(pB0, pB1, K_lds + SHM_K8, q8, r32, hi);
  finishSM8(pA0, pA1, alA, l_reg, p8); SBAR();
  pv8(o, V_lds, p8, r32, hi); partialSM8(pB0, pB1, m_reg, mnB, alB);
  __syncthreads(); RESC(alB);
  finishSM8(pB0, pB1, alB, l_reg, p8); SBAR();
  pv8(o, V_lds + SHM_V8, p8, r32, hi);
  if (hi == 0) li_l[r32] = l_reg; asm volatile("s_waitcnt lgkmcnt(0)" ::: "memory");
  float rli[16];
#pragma unroll
  for (int r = 0; r < 16; ++r) rli[r] = 16.0f * __builtin_amdgcn_rcpf(li_l[crow(r, hi)]);
  bf16_t* Ow = Ob + (long)(wid * QBLK) * NIN;
#pragma unroll
  for (int r = 0; r < 16; ++r) { int orow = crow(r, hi);
#pragma unroll
    for (int d0 = 0; d0 < 4; ++d0) Ow[(long)orow * NIN + d0 * 32 + r32] = (bf16_t)(cvt_pk_bf16(o[d0][r] * rli[r], 0.f) & 0xffffu); }
  __syncthreads();
#undef SLOAD
#undef SWRITE
#undef SWAIT
#undef RESC
}

__device__ __forceinline__ void qkt9(f32x16& p0, f32x16& p1, const char* Ks, const v8i* q8, const f32x16& negm, int r32, int hi) {
  const int sw = (r32 >> 1) & 7;
  { const int c0 = (2 * hi) ^ sw, c1 = (2 * hi + 1) ^ sw;
    const v4i a0 = *reinterpret_cast<const v4i*>(Ks + r32 * 128 + 16 * c0), a1 = *reinterpret_cast<const v4i*>(Ks + r32 * 128 + 16 * c1);
    const v4i b0 = *reinterpret_cast<const v4i*>(Ks + (32 + r32) * 128 + 16 * c0), b1 = *reinterpret_cast<const v4i*>(Ks + (32 + r32) * 128 + 16 * c1);
    const v8i ka = __builtin_shufflevector(a0, a1, 0, 1, 2, 3, 4, 5, 6, 7), kb = __builtin_shufflevector(b0, b1, 0, 1, 2, 3, 4, 5, 6, 7);
    p0 = __builtin_amdgcn_mfma_scale_f32_32x32x64_f8f6f4(ka, q8[0], negm, 0, 0, 0, 0x7f7f7f7f, 0, 0x7f7f7f7f);
    p1 = __builtin_amdgcn_mfma_scale_f32_32x32x64_f8f6f4(kb, q8[0], negm, 0, 0, 0, 0x7f7f7f7f, 0, 0x7f7f7f7f); }
  { const int c0 = (4 + 2 * hi) ^ sw, c1 = (4 + 2 * hi + 1) ^ sw;
    const v4i a0 = *reinterpret_cast<const v4i*>(Ks + r32 * 128 + 16 * c0), a1 = *reinterpret_cast<const v4i*>(Ks + r32 * 128 + 16 * c1);
    const v4i b0 = *reinterpret_cast<const v4i*>(Ks + (32 + r32) * 128 + 16 * c0), b1 = *reinterpret_cast<const v4i*>(Ks + (32 + r32) * 128 + 16 * c1);
    const v8i ka = __builtin_shufflevector(a0, a1, 0, 1, 2, 3, 4, 5, 6, 7), kb = __builtin_shufflevector(b0, b1, 0, 1, 2, 3, 4, 5, 6, 7);
    p0 = __builtin_amdgcn_mfma_scale_f32_32x32x64_f8f6f4(ka, q8[1], p0, 0, 0, 0, 0x7f7f7f7f, 0, 0x7f7f7f7f);
    p1 = __builtin_amdgcn_mfma_scale_f32_32x32x64_f8f6f4(kb, q8[1], p1, 0, 0, 0, 0x7f7f7f7f, 0, 0x7f7f7f7f); }
}
template <bool FIRST>
__device__ __forceinline__ void partialSM9(f32x16& p0, f32x16& p1, float& m_reg, f32x16& negm, float& alpha) {
  constexpr float THRL = THR8 * 1.4426950408889634f;
  float pmax = p0[0];
#pragma unroll
  for (int r = 1; r < 16; ++r) pmax = fmaxf(pmax, p0[r]);
#pragma unroll
  for (int r = 0; r < 16; ++r) pmax = fmaxf(pmax, p1[r]);
  { auto rr = __builtin_amdgcn_permlane32_swap(__float_as_uint(pmax), __float_as_uint(pmax), false, false);
    pmax = fmaxf(__uint_as_float(rr[0]), __uint_as_float(rr[1])); }
  if (!FIRST && __builtin_expect(__all(pmax - 4.0f <= THRL), 1)) { alpha = 1.f; }
  else {
    const float d = FIRST ? (pmax - 4.0f) : fmaxf(pmax - 4.0f, 0.f);
    alpha = FIRST ? 1.f : __builtin_amdgcn_exp2f(-d); m_reg += d;
#pragma unroll
    for (int r = 0; r < 16; ++r) { p0[r] -= d; p1[r] -= d; negm[r] -= d; }
    if (FIRST) {
#pragma unroll
      for (int r = 0; r < 16; ++r) negm[r] = 4.0f - m_reg; }
  }
#pragma unroll
  for (int r = 0; r < 16; ++r) p0[r] = __builtin_amdgcn_exp2f(p0[r]);
}
__device__ __forceinline__ void attn_unit11(const bf16_t* __restrict__ Qb, const unsigned char* __restrict__ K8b, const unsigned char* __restrict__ VT8b, bf16_t* __restrict__ Ob,
                                           int seq, char* lds, const float* __restrict__ qg, const float* __restrict__ rope, int t0) {
  int tid_ = threadIdx.x; asm volatile("" : "+v"(tid_));
  const int tid = tid_, wid = tid >> 6, lane = tid & 63, r32 = lane & 31, hi = lane >> 5;
  char* V_lds = lds; char* K_lds = lds + 2 * SHM_V8;
  float* ws = (float*)(lds + 2 * SHM_V8 + 2 * SHM_K8) + wid * 64; float* li_l = ws; float* al_l = ws + 32;
  float m_reg = 4.0f, l_reg = 0; f32x16 o[4] = {}; v8i q8[2]; f32x16 negm = {};
  {
    const bf16_t* Qw = Qb + (long)(wid * QBLK + r32) * NIN + hi * 32;
    float qf[2][4][8]; float ss = 0.f;
#pragma unroll
    for (int j = 0; j < 2; ++j)
#pragma unroll
      for (int i = 0; i < 4; ++i) { const u32x4 w = *reinterpret_cast<const u32x4*>(Qw + 64 * j + 8 * i);
        qf[j][i][0] = bf_lo(w.x); qf[j][i][1] = bf_hi(w.x); qf[j][i][2] = bf_lo(w.y); qf[j][i][3] = bf_hi(w.y); qf[j][i][4] = bf_lo(w.z); qf[j][i][5] = bf_hi(w.z); qf[j][i][6] = bf_lo(w.w); qf[j][i][7] = bf_hi(w.w);
#pragma unroll
        for (int e = 0; e < 8; ++e) ss += qf[j][i][e] * qf[j][i][e]; }
    ss += __shfl_xor(ss, 32);
    const float rstd = rsqrtf(ss * (1.f / 128.f) + NORM_EPS);
#pragma unroll
    for (int j = 0; j < 2; ++j)
#pragma unroll
      for (int i = 0; i < 4; ++i) { const float* gp = qg + 64 * j + 32 * hi + 8 * i; const f32x4 g0 = *reinterpret_cast<const f32x4*>(gp), g1 = *reinterpret_cast<const f32x4*>(gp + 4);
#pragma unroll
        for (int e = 0; e < 4; ++e) { qf[j][i][e] *= (rstd * (SCALE * 1.4426950408889634f)) * g0[e]; qf[j][i][4 + e] *= (rstd * (SCALE * 1.4426950408889634f)) * g1[e]; } }
    if (t0 >= 0) {
      const int t = t0 + wid * QBLK + r32;
#pragma unroll
      for (int j = 0; j < 2; ++j) { const int pos = j == 0 ? (t >> 6) : (t & 63);
#pragma unroll
        for (int i = 0; i < 4; ++i) { const float* rp = rope + pos * 32 + 8 * i;
          const f32x4 c0 = *reinterpret_cast<const f32x4*>(rp), c1 = *reinterpret_cast<const f32x4*>(rp + 4), s0 = *reinterpret_cast<const f32x4*>(rp + 4096), s1 = *reinterpret_cast<const f32x4*>(rp + 4100);
#pragma unroll
          for (int e = 0; e < 8; ++e) { const float cs = e < 4 ? c0[e] : c1[e - 4], sn = e < 4 ? s0[e] : s1[e - 4]; const float x = qf[j][i][e], pr = __shfl_xor(x, 32);
            qf[j][i][e] = x * cs + (hi ? pr : -pr) * sn; } } }
    }
#pragma unroll
    for (int j = 0; j < 2; ++j) { int w[8];
#pragma unroll
      for (int i = 0; i < 4; ++i) { unsigned t0_ = 0u, t1_ = 0u;
        t0_ = __builtin_amdgcn_cvt_pk_fp8_f32(qf[j][i][0], qf[j][i][1], t0_, false); t0_ = __builtin_amdgcn_cvt_pk_fp8_f32(qf[j][i][2], qf[j][i][3], t0_, true);
        t1_ = __builtin_amdgcn_cvt_pk_fp8_f32(qf[j][i][4], qf[j][i][5], t1_, false); t1_ = __builtin_amdgcn_cvt_pk_fp8_f32(qf[j][i][6], qf[j][i][7], t1_, true);
        w[2 * i] = (int)t0_; w[2 * i + 1] = (int)t1_; }
      q8[j] = (v8i){w[0], w[1], w[2], w[3], w[4], w[5], w[6], w[7]}; }
  }
  const int krow = tid >> 3, kch = tid & 7, kst = krow * 128 + 16 * (kch ^ ((krow >> 1) & 7));
  const int vrow = tid >> 2, vch = tid & 3, vst = vrow * 64 + 16 * (vch ^ ((vrow >> 2) & 3));
  struct { v4i vs, ks; } sr_[2];
#define SLOAD(i, k0) do { sr_[i].vs = *reinterpret_cast<const v4i*>(VT8b + (long)(k0) * 128 + 16 * tid); \
    sr_[i].ks = *reinterpret_cast<const v4i*>(K8b + (long)((k0) + krow) * 128 + 16 * kch); } while (0)
#define SWRITE(b, i) do { *(v4i*)(V_lds + (b) * SHM_V8 + vst) = sr_[i].vs; *(v4i*)(K_lds + (b) * SHM_K8 + kst) = sr_[i].ks; } while (0)
#define SWAIT() asm volatile("s_waitcnt vmcnt(2)" ::: "memory")
#define RESC(a) do { if (__any((a) < 1.f)) { if (hi == 0) al_l[r32] = (a); asm volatile("s_waitcnt lgkmcnt(0)" ::: "memory"); \
    _Pragma("unroll") for (int d = 0; d < 4; ++d) _Pragma("unroll") for (int r = 0; r < 16; ++r) o[d][r] *= al_l[crow(r, hi)]; } } while (0)
  f32x16 pA0, pA1, pB0, pB1; float mnA, mnB, alA, alB; v8i p8; const int NT = seq / KVBLK;
  constexpr int SE = 0, SO = 1;
  SLOAD(SE, 0); asm volatile("s_waitcnt vmcnt(0)" ::: "memory"); SWRITE(0, SE); __syncthreads();
  qkt9(pA0, pA1, K_lds, q8, negm, r32, hi); partialSM9<true>(pA0, pA1, m_reg, negm, alA);
  SLOAD(SO, KVBLK); if (2 < NT) SLOAD(SE, 2 * KVBLK);
  SWAIT(); SWRITE(1, SO); __syncthreads();
  for (int j = 1; j + 1 < NT; j += 2) {
    SBAR(); qkt9(pB0, pB1, K_lds + SHM_K8, q8, negm, r32, hi);
    finishSM8(pA0, pA1, alA, l_reg, p8); SBAR();
    SLOAD(SO, (j + 2) * KVBLK); SBAR();
    pv8(o, V_lds, p8, r32, hi); partialSM9<false>(pB0, pB1, m_reg, negm, alB);
    __syncthreads(); SWAIT(); SWRITE(0, SE);
    RESC(alB); __syncthreads();
    SBAR(); qkt9(pA0, pA1, K_lds, q8, negm, r32, hi);
    finishSM8(pB0, pB1, alB, l_reg, p8); SBAR();
    if (j + 3 < NT) SLOAD(SE, (j + 3) * KVBLK); SBAR();
    pv8(o, V_lds + SHM_V8, p8, r32, hi); partialSM9<false>(pA0, pA1, m_reg, negm, alA);
    __syncthreads(); SWAIT(); SWRITE(1, SO);
    RESC(alA); __syncthreads();
  }
  SBAR(); qkt9(pB0, pB1, K_lds + SHM_K8, q8, negm, r32, hi);
  finishSM8(pA0, pA1, alA, l_reg, p8); SBAR();
  pv8(o, V_lds, p8, r32, hi); partialSM9<false>(pB0, pB1, m_reg, negm, alB);
  __syncthreads(); RESC(alB);
  finishSM8(pB0, pB1, alB, l_reg, p8); SBAR();
  pv8(o, V_lds + SHM_V8, p8, r32, hi);
  if (hi == 0) li_l[r32] = l_reg; asm volatile("s_waitcnt lgkmcnt(0)" ::: "memory");
  float rli[16];
#pragma unroll
  for (int r = 0; r < 16; ++r) rli[r] = 16.0f * __builtin_amdgcn_rcpf(li_l[crow(r, hi)]);
  bf16_t* Ow = Ob + (long)(wid * QBLK) * NIN;
#pragma unroll
  for (int r = 0; r < 16; ++r) { int orow = crow(r, hi);
#pragma unroll
    for (int d0 = 0; d0 < 4; ++d0) Ow[(long)orow * NIN + d0 * 32 + r32] = (bf16_t)(cvt_pk_bf16(o[d0][r] * rli[r], 0.f) & 0xffffu); }
  __syncthreads();
#undef SLOAD
#undef SWRITE
#undef SWAIT
#undef RESC
}
template <bool FIRST, bool NOSUM = false>
__device__ __forceinline__ void softmax14(f32x16& p0, f32x16& p1, float& m_reg, f32x16& negm, float& l_reg, v8i& p8, float& alpha) {
  constexpr float THRL = THR8 * 1.4426950408889634f;
  float ma = fmaxf(fmaxf(p0[0], p0[1]), p0[2]), mb = fmaxf(fmaxf(p0[3], p0[4]), p0[5]), mc = fmaxf(fmaxf(p0[6], p0[7]), p0[8]), md = fmaxf(fmaxf(p0[9], p0[10]), p0[11]);
  ma = fmaxf(fmaxf(ma, p0[12]), p0[13]); mb = fmaxf(fmaxf(mb, p0[14]), p0[15]); mc = fmaxf(fmaxf(mc, p1[0]), p1[1]); md = fmaxf(fmaxf(md, p1[2]), p1[3]);
  ma = fmaxf(fmaxf(ma, p1[4]), p1[5]); mb = fmaxf(fmaxf(mb, p1[6]), p1[7]); mc = fmaxf(fmaxf(mc, p1[8]), p1[9]); md = fmaxf(fmaxf(md, p1[10]), p1[11]);
  ma = fmaxf(fmaxf(ma, p1[12]), p1[13]); mb = fmaxf(fmaxf(mb, p1[14]), p1[15]);
  float pmax = fmaxf(fmaxf(fmaxf(ma, mb), mc), md);
  { auto rr = __builtin_amdgcn_permlane32_swap(__float_as_uint(pmax), __float_as_uint(pmax), false, false);
    pmax = fmaxf(__uint_as_float(rr[0]), __uint_as_float(rr[1])); }
  if (!FIRST && __builtin_expect(__all(pmax - 4.0f <= THRL), 1)) { alpha = 1.f; }
  else {
    const float d = FIRST ? (pmax - 4.0f) : fmaxf(pmax - 4.0f, 0.f);
    alpha = FIRST ? 1.f : __builtin_amdgcn_exp2f(-d); m_reg += d;
#pragma unroll
    for (int r = 0; r < 16; ++r) { p0[r] -= d; p1[r] -= d; negm[r] -= d; }
    if (FIRST) {
#pragma unroll
      for (int r = 0; r < 16; ++r) negm[r] = 4.0f - m_reg; }
  }
#pragma unroll
  for (int r = 0; r < 16; ++r) p0[r] = __builtin_amdgcn_exp2f(p0[r]);
#pragma unroll
  for (int r = 0; r < 16; ++r) p1[r] = __builtin_amdgcn_exp2f(p1[r]);
  if (!NOSUM) {
  float sa = p0[0] + p0[4], sb = p0[1] + p0[5], sc = p0[2] + p0[6], sd = p0[3] + p0[7];
  sa += p0[8]; sb += p0[9]; sc += p0[10]; sd += p0[11]; sa += p0[12]; sb += p0[13]; sc += p0[14]; sd += p0[15];
#pragma unroll
  for (int r = 0; r < 16; r += 4) { sa += p1[r]; sb += p1[r + 1]; sc += p1[r + 2]; sd += p1[r + 3]; }
  float ps = (sa + sb) + (sc + sd);
  { auto rr = __builtin_amdgcn_permlane32_swap(__float_as_uint(ps), __float_as_uint(ps), false, false);
    ps = __uint_as_float(rr[0]) + __uint_as_float(rr[1]); }
  l_reg = l_reg * alpha + ps;
  }
  int w[8];
#pragma unroll
  for (int i = 0; i < 4; ++i) { unsigned a = __float_as_uint(p0[4 * i]), b = __float_as_uint(p1[4 * i]);
    a = __builtin_amdgcn_cvt_pk_fp8_f32(p0[4 * i], p0[4 * i + 1], a, false); a = __builtin_amdgcn_cvt_pk_fp8_f32(p0[4 * i + 2], p0[4 * i + 3], a, true);
    b = __builtin_amdgcn_cvt_pk_fp8_f32(p1[4 * i], p1[4 * i + 1], b, false); b = __builtin_amdgcn_cvt_pk_fp8_f32(p1[4 * i + 2], p1[4 * i + 3], b, true);
    w[i] = (int)a; w[4 + i] = (int)b; }
  p8 = (v8i){w[0], w[1], w[2], w[3], w[4], w[5], w[6], w[7]};
}
constexpr int RING = 6;
template <int MODE = 0>
__device__ __forceinline__ void attn_unit14(const bf16_t* __restrict__ Qb, const unsigned char* __restrict__ K8b, const unsigned char* __restrict__ VT8b, bf16_t* __restrict__ Ob,
                                           int seq, char* lds, LAS unsigned char* ldsl, const float* __restrict__ qg, const float* __restrict__ rope, int t0, int ostr = NIN) {
  int tid_ = threadIdx.x; asm volatile("" : "+v"(tid_));
  const int tid = tid_, wid = tid >> 6, lane = tid & 63, r32 = lane & 31, hi = lane >> 5;
  char* K_lds = lds; char* V_lds = lds + RING * SHM_K8;
  float* ws = (float*)(lds + RING * SHM_K8 + RING * SHM_V8) + wid * 64; float* li_l = ws; float* al_l = ws + 32;
  float m_reg = 4.0f, l_reg = 0; f32x16 o[5] = {}; v8i q8[2]; f32x16 negm = {};
  const int one8 = r32 == 0 ? 0x38383838 : 0; const v8i vones = (v8i){one8, one8, one8, one8, one8, one8, one8, one8};
  {
    const bf16_t* Qw = Qb + (long)(wid * QBLK + r32) * NIN + hi * 32;
    float qf[2][4][8]; float ss = 0.f;
#pragma unroll
    for (int j = 0; j < 2; ++j)
#pragma unroll
      for (int i = 0; i < 4; ++i) { const u32x4 w = *reinterpret_cast<const u32x4*>(Qw + 64 * j + 8 * i);
        qf[j][i][0] = bf_lo(w.x); qf[j][i][1] = bf_hi(w.x); qf[j][i][2] = bf_lo(w.y); qf[j][i][3] = bf_hi(w.y); qf[j][i][4] = bf_lo(w.z); qf[j][i][5] = bf_hi(w.z); qf[j][i][6] = bf_lo(w.w); qf[j][i][7] = bf_hi(w.w);
#pragma unroll
        for (int e = 0; e < 8; ++e) ss += qf[j][i][e] * qf[j][i][e]; }
    ss += __shfl_xor(ss, 32);
    const float rstd = rsqrtf(ss * (1.f / 128.f) + NORM_EPS);
#pragma unroll
    for (int j = 0; j < 2; ++j)
#pragma unroll
      for (int i = 0; i < 4; ++i) { const float* gp = qg + 64 * j + 32 * hi + 8 * i; const f32x4 g0 = *reinterpret_cast<const f32x4*>(gp), g1 = *reinterpret_cast<const f32x4*>(gp + 4);
#pragma unroll
        for (int e = 0; e < 4; ++e) { qf[j][i][e] *= (rstd * (SCALE * 1.4426950408889634f)) * g0[e]; qf[j][i][4 + e] *= (rstd * (SCALE * 1.4426950408889634f)) * g1[e]; } }
    if (t0 >= 0) {
      const int t = t0 + wid * QBLK + r32;
#pragma unroll
      for (int j = 0; j < 2; ++j) { const int pos = j == 0 ? (t >> 6) : (t & 63);
#pragma unroll
        for (int i = 0; i < 4; ++i) { const float* rp = rope + pos * 32 + 8 * i;
          const f32x4 c0 = *reinterpret_cast<const f32x4*>(rp), c1 = *reinterpret_cast<const f32x4*>(rp + 4), s0 = *reinterpret_cast<const f32x4*>(rp + 4096), s1 = *reinterpret_cast<const f32x4*>(rp + 4100);
#pragma unroll
          for (int e = 0; e < 8; ++e) { const float cs = e < 4 ? c0[e] : c1[e - 4], sn = e < 4 ? s0[e] : s1[e - 4]; const float x = qf[j][i][e], pr = __shfl_xor(x, 32);
            qf[j][i][e] = x * cs + (hi ? pr : -pr) * sn; } } }
    }
#pragma unroll
    for (int j = 0; j < 2; ++j) { int w[8];
#pragma unroll
      for (int i = 0; i < 4; ++i) { unsigned t0_ = 0u, t1_ = 0u;
        t0_ = __builtin_amdgcn_cvt_pk_fp8_f32(qf[j][i][0], qf[j][i][1], t0_, false); t0_ = __builtin_amdgcn_cvt_pk_fp8_f32(qf[j][i][2], qf[j][i][3], t0_, true);
        t1_ = __builtin_amdgcn_cvt_pk_fp8_f32(qf[j][i][4], qf[j][i][5], t1_, false); t1_ = __builtin_amdgcn_cvt_pk_fp8_f32(qf[j][i][6], qf[j][i][7], t1_, true);
        w[2 * i] = (int)t0_; w[2 * i + 1] = (int)t1_; }
      q8[j] = (v8i){w[0], w[1], w[2], w[3], w[4], w[5], w[6], w[7]}; }
  }
  const int widu = __builtin_amdgcn_readfirstlane(wid);
  const bool grpB = widu >= 4;
  const int krow = 8 * wid + (lane >> 3), koff = krow * 128 + 16 * ((lane & 7) ^ ((krow >> 1) & 7));
  const int vrow = 16 * wid + (lane >> 2), voff = vrow * 64 + 16 * ((lane & 3) ^ ((vrow >> 2) & 3));
  const int NT = seq / KVBLK;
#define DMA(t, s) do { const long to_ = (long)((t) < NT ? (t) : NT - 1) * 8192; \
    __builtin_amdgcn_global_load_lds((const unsigned*)(K8b + to_ + koff), (LAS unsigned*)(ldsl + (s) * SHM_K8 + 1024 * widu), 16, 0, 0); \
    __builtin_amdgcn_global_load_lds((const unsigned*)(VT8b + to_ + voff), (LAS unsigned*)(ldsl + RING * SHM_K8 + (s) * SHM_V8 + 1024 * widu), 16, 0, 0); } while (0)
#define BAR() do { SBAR(); __builtin_amdgcn_s_barrier(); asm volatile("" ::: "memory"); SBAR(); } while (0)
#define BAR_V() do { SBAR(); asm volatile("s_barrier" : "+v"(p8) :: "memory"); SBAR(); } while (0)
#define WAIT_BAR() do { SBAR(); asm volatile("s_waitcnt vmcnt(4)\n\ts_barrier" : "+v"(o[0]), "+v"(o[1]), "+v"(o[2]), "+v"(o[3]), "+v"(o[4]), "+v"(s0), "+v"(s1) :: "memory"); SBAR(); } while (0)
#define RESC(a) do { if (__any((a) < 1.f)) { if (hi == 0) al_l[r32] = (a); asm volatile("s_waitcnt lgkmcnt(0)" ::: "memory"); \
    _Pragma("unroll") for (int d = 0; d < 5; ++d) _Pragma("unroll") for (int r = 0; r < 16; ++r) o[d][r] *= al_l[crow(r, hi)]; } } while (0)
#define PVS() (o[4] = __builtin_amdgcn_mfma_scale_f32_32x32x64_f8f6f4(p8, vones, o[4], 0, 0, 0, 0x7b7b7b7b, 0, 0x7f7f7f7f))
#define LDK(Ks) do { const char* ks_ = (Ks); const int sw_ = (r32 >> 1) & 7; \
    { const int c0 = (2 * hi) ^ sw_, c1 = (2 * hi + 1) ^ sw_; \
      const v4i a0 = *reinterpret_cast<const v4i*>(ks_ + r32 * 128 + 16 * c0), a1 = *reinterpret_cast<const v4i*>(ks_ + r32 * 128 + 16 * c1); \
      const v4i b0 = *reinterpret_cast<const v4i*>(ks_ + (32 + r32) * 128 + 16 * c0), b1 = *reinterpret_cast<const v4i*>(ks_ + (32 + r32) * 128 + 16 * c1); \
      kf0 = __builtin_shufflevector(a0, a1, 0, 1, 2, 3, 4, 5, 6, 7); kf1 = __builtin_shufflevector(b0, b1, 0, 1, 2, 3, 4, 5, 6, 7); } \
    { const int c0 = (4 + 2 * hi) ^ sw_, c1 = (4 + 2 * hi + 1) ^ sw_; \
      const v4i a0 = *reinterpret_cast<const v4i*>(ks_ + r32 * 128 + 16 * c0), a1 = *reinterpret_cast<const v4i*>(ks_ + r32 * 128 + 16 * c1); \
      const v4i b0 = *reinterpret_cast<const v4i*>(ks_ + (32 + r32) * 128 + 16 * c0), b1 = *reinterpret_cast<const v4i*>(ks_ + (32 + r32) * 128 + 16 * c1); \
      kf2 = __builtin_shufflevector(a0, a1, 0, 1, 2, 3, 4, 5, 6, 7); kf3 = __builtin_shufflevector(b0, b1, 0, 1, 2, 3, 4, 5, 6, 7); } } while (0)
#define QK() do { \
    s0 = __builtin_amdgcn_mfma_scale_f32_32x32x64_f8f6f4(kf0, q8[0], negm, 0, 0, 0, 0x7f7f7f7f, 0, 0x7f7f7f7f); \
    s1 = __builtin_amdgcn_mfma_scale_f32_32x32x64_f8f6f4(kf1, q8[0], negm, 0, 0, 0, 0x7f7f7f7f, 0, 0x7f7f7f7f); \
    s0 = __builtin_amdgcn_mfma_scale_f32_32x32x64_f8f6f4(kf2, q8[1], s0, 0, 0, 0, 0x7f7f7f7f, 0, 0x7f7f7f7f); \
    s1 = __builtin_amdgcn_mfma_scale_f32_32x32x64_f8f6f4(kf3, q8[1], s1, 0, 0, 0, 0x7f7f7f7f, 0, 0x7f7f7f7f); } while (0)
  f32x16 s0, s1; float al; v8i p8, kf0, kf1, kf2, kf3;
#pragma unroll
  for (int t = 0; t < RING - 1; ++t) DMA(t, t);
  asm volatile("s_waitcnt vmcnt(4)" ::: "memory"); BAR();
  if (grpB) BAR();
  LDK(K_lds); QK();
  WAIT_BAR();
  softmax14<true, true>(s0, s1, m_reg, negm, l_reg, p8, al);
  LDK(K_lds + SHM_K8);
  BAR_V();
  int sv = 0;
  for (int j = 0; j + 1 < NT; ++j) {
    const int sd = sv == 0 ? RING - 1 : sv - 1, sk2 = sv + 2 >= RING ? sv + 2 - RING : sv + 2;
    if (MODE != 2) DMA(j + RING - 1, sd);
    SBAR(); if (MODE != 3) { QK();
    pv8(o, V_lds + sv * SHM_V8, p8, r32, hi); PVS(); }
    WAIT_BAR();
    if (MODE != 1) { softmax14<false, true>(s0, s1, m_reg, negm, l_reg, p8, al);
    RESC(al); } else { p8 = (v8i){(int)__float_as_uint(s0[0]), (int)__float_as_uint(s0[1]), (int)__float_as_uint(s0[2]), (int)__float_as_uint(s0[3]), (int)__float_as_uint(s1[0]), (int)__float_as_uint(s1[1]), (int)__float_as_uint(s1[2]), (int)__float_as_uint(s1[3])}; l_reg += s0[5]; }
    LDK(K_lds + sk2 * SHM_K8);
    BAR_V();
    sv = sv + 1 == RING ? 0 : sv + 1;
  }
  pv8(o, V_lds + sv * SHM_V8, p8, r32, hi); PVS();
  if (!grpB) BAR();
  asm volatile("s_waitcnt vmcnt(0)" ::: "memory");
  if (r32 == 0) {
#pragma unroll
    for (int r = 0; r < 16; ++r) li_l[crow(r, hi)] = o[4][r]; }
  asm volatile("s_waitcnt lgkmcnt(0)" ::: "memory");
  float rli[16];
#pragma unroll
  for (int r = 0; r < 16; ++r) rli[r] = __builtin_amdgcn_rcpf(li_l[crow(r, hi)]);
  bf16_t* Ow = Ob + (long)(wid * QBLK) * ostr;
#pragma unroll
  for (int r = 0; r < 16; ++r) { int orow = crow(r, hi);
#pragma unroll
    for (int d0 = 0; d0 < 4; ++d0) Ow[(long)orow * ostr + d0 * 32 + r32] = (bf16_t)(cvt_pk_bf16(o[d0][r] * rli[r], 0.f) & 0xffffu); }
  __syncthreads();
#undef DMA
#undef BAR
#undef BAR_V
#undef WAIT_BAR
#undef RESC
#undef LDK
#undef PVS
#undef QK
}
}

struct Args { const float* in[28]; float* out; unsigned char* ws; int lo, hi; };
enum { I_X = 0, I_C, I_CTX, I_CCTX, I_WMOD, I_BMOD, I_GPREMIX, I_GPOSTMIX, I_GPREMLP, I_GPOSTMLP, I_WIN, I_CONVW, I_WCO, I_LRE, I_LIM, I_LDT, I_BRE, I_BIM, I_CRE, I_CIM, I_SD, I_WGLU, I_QG, I_KG, I_WAO, I_WOUT, I_WUP, I_WDN };

__device__ __forceinline__ void transpose_block(const float* W, int K, int N, int k0, int n0, bf16_t* dst, LAS float* scr, int lane) {
    f32x4 v[8];
    const int lr = lane >> 3, lc = (lane & 7) * 4;
#pragma unroll
    for (int i = 0; i < 8; ++i) v[i] = *(const f32x4*)(W + (size_t)(k0 + 8 * i + lr) * N + n0 + lc);
#pragma unroll
    for (int i = 0; i < 8; ++i) { LAS float* s = scr + (8 * i + lr) * 33 + lc; s[0] = v[i].x; s[1] = v[i].y; s[2] = v[i].z; s[3] = v[i].w; }
    LDS_WAIT(); asm volatile("" ::: "memory");
    const int c = lane & 7;
#pragma unroll
    for (int j = 0; j < 4; ++j) { const int n = (lane >> 3) + 8 * j; const LAS float* s = scr + (8 * c) * 33 + n;
        u32x4 o; o.x = cvt_pk_bf16(s[0 * 33], s[1 * 33]); o.y = cvt_pk_bf16(s[2 * 33], s[3 * 33]); o.z = cvt_pk_bf16(s[4 * 33], s[5 * 33]); o.w = cvt_pk_bf16(s[6 * 33], s[7 * 33]);
        *(u32x4*)(dst + (size_t)n * K + k0 + 8 * c) = o; }
    LDS_WAIT(); asm volatile("" ::: "memory");
}
__device__ __forceinline__ void transpose_block_f8(const float* W, int K, int N, int k0, int n0, unsigned char* dst, float sc, LAS float* scr, int lane) {
    f32x4 v[8];
    const int lr = lane >> 3, lc = (lane & 7) * 4;
#pragma unroll
    for (int i = 0; i < 8; ++i) v[i] = *(const f32x4*)(W + (size_t)(k0 + 8 * i + lr) * N + n0 + lc);
#pragma unroll
    for (int i = 0; i < 8; ++i) { LAS float* s = scr + (8 * i + lr) * 33 + lc; s[0] = v[i].x * sc; s[1] = v[i].y * sc; s[2] = v[i].z * sc; s[3] = v[i].w * sc; }
    LDS_WAIT(); asm volatile("" ::: "memory");
    const int c = lane & 3;
#pragma unroll
    for (int j = 0; j < 2; ++j) { const int n = (lane >> 2) + 16 * j; const LAS float* s = scr + (16 * c) * 33 + n;
        unsigned w[4];
#pragma unroll
        for (int q = 0; q < 4; ++q) { unsigned t = 0u; t = __builtin_amdgcn_cvt_pk_fp8_f32(s[(4 * q) * 33], s[(4 * q + 1) * 33], t, false); t = __builtin_amdgcn_cvt_pk_fp8_f32(s[(4 * q + 2) * 33], s[(4 * q + 3) * 33], t, true); w[q] = t; }
        *(u32x4*)(dst + (size_t)n * K + k0 + 16 * c) = (u32x4){w[0], w[1], w[2], w[3]}; }
    LDS_WAIT(); asm volatile("" ::: "memory");
}
__device__ __forceinline__ void convert_weights(const Args& a, int l, LAS unsigned char* lds, int gw, int NGW, int wave, int lane) {
    LAS float* scr = (LAS float*)(lds + wave * 16384);
    unsigned char* ws = a.ws;
    constexpr int I_IN = (D / 64) * (NIN / 32), I_CO = (1024 / 64) * (D / 32), I_GLU = (768 / 64) * (4096 / 32), I_AO = I_CO, I_OUT = (D / 64) * (D / 32), I_UP = (D / 64) * (FF / 32), I_DN = (FF / 64) * (D / 32);
    constexpr int NITEMS = I_IN + I_CO + I_GLU + I_AO + I_OUT + I_UP + I_DN;
    for (int it = gw; it < NITEMS; it += NGW) {
        int r = it;
        if (r < I_IN) { const int nb = r % (NIN / 32), kb = r / (NIN / 32);
            if (32 * nb < C_F8) { int dcol = 32 * nb;
                if (dcol >= C_AC && dcol < C_SU) { const bool isv = dcol >= C_AV; const int jn = dcol - (isv ? C_AV : C_AC); dcol = C_AC + 256 * (jn >> 7) + (isv ? 128 : 0) + (jn & 127); }
                transpose_block(a.in[I_WIN] + (size_t)l * D * NIN, D, NIN, 64 * kb, 32 * nb, (bf16_t*)(ws + WS_WIN) + (size_t)dcol * D, scr, lane); }
            else transpose_block_f8(a.in[I_WIN] + (size_t)l * D * NIN, D, NIN, 64 * kb, 32 * nb, (unsigned char*)(ws + WS_WG8) + (size_t)(32 * nb - C_F8) * D, WG8_SCALE, scr, lane);
            continue; } r -= I_IN;
        if (r < I_CO) { const int nb = r % (D / 32), kb = r / (D / 32); transpose_block(a.in[I_WCO] + (size_t)l * 1024 * D, 1024, D, 64 * kb, 32 * nb, (bf16_t*)(ws + WS_WCO) + (size_t)(32 * nb) * 1024, scr, lane); continue; } r -= I_CO;
        if (r < I_GLU) { const int nb = r % 128, kb = r / 128; const int nq = nb & 63, drow = 256 * (nq >> 2) + 32 * (nq & 3) + (nb >= 64 ? 128 : 0);
            transpose_block(a.in[I_WGLU] + (size_t)l * 768 * 4096, 768, 4096, 64 * kb, 32 * nb, (bf16_t*)(ws + WS_WGLU) + (size_t)drow * 768, scr, lane); continue; } r -= I_GLU;
        if (r < I_AO) { const int nb = r % (D / 32), kb = r / (D / 32); transpose_block(a.in[I_WAO] + (size_t)l * 1024 * D, 1024, D, 64 * kb, 32 * nb, (bf16_t*)(ws + WS_WAO) + (size_t)(32 * nb) * 1024, scr, lane); continue; } r -= I_AO;
        if (r < I_OUT) { const int nb = r % (D / 32), kb = r / (D / 32); transpose_block(a.in[I_WOUT] + (size_t)l * D * D, D, D, 64 * kb, 32 * nb, (bf16_t*)(ws + WS_WOUT) + (size_t)(32 * nb) * D, scr, lane); continue; } r -= I_OUT;
        if (r < I_UP) { const int nb = r % (FF / 32), kb = r / (FF / 32); transpose_block(a.in[I_WUP] + (size_t)l * D * FF, D, FF, 64 * kb, 32 * nb, (bf16_t*)(ws + WS_WUP) + (size_t)(32 * nb) * D, scr, lane); continue; } r -= I_UP;
        { const int nb = r % (D / 32), kb = r / (D / 32); transpose_block(a.in[I_WDN] + (size_t)l * FF * D, FF, D, 64 * kb, 32 * nb, (bf16_t*)(ws + WS_WDN) + (size_t)(32 * nb) * FF, scr, lane); }
    }
}

__device__ __forceinline__ void mod_gemv(const Args& a, LAS unsigned char* lds, int bid, int G, int tid, int wave, int lane) {
    LAS float* SV = (LAS float*)lds;
    LAS float* RED = (LAS float*)(lds + 40960);
    float* MOD = (float*)(a.ws + WS_MOD);
    if (bid >= 384) return;
    for (int i = tid; i < 5 * D; i += 512) { const int j = i / D, k = i % D; const float v = j < 4 ? a.in[I_C][j * D + k] : a.in[I_CCTX][k]; SV[i] = v * sigmoidf_(v); }
    __syncthreads();
    for (int it = bid; it < 384; it += G) {
        const int l = it / 96, n0 = (it % 96) * 128;
        const float* W = a.in[I_WMOD] + (size_t)l * D * NMOD + n0 + 2 * lane;
        float acc[5][2];
#pragma unroll
        for (int j = 0; j < 5; ++j) { acc[j][0] = 0.f; acc[j][1] = 0.f; }
        const int kb = wave * 256;
#pragma unroll 16
        for (int k = 0; k < 256; ++k) { const f32x2 w = *(const f32x2*)(W + (size_t)(kb + k) * NMOD);
#pragma unroll
            for (int j = 0; j < 5; ++j) { const float s = SV[j * D + kb + k]; acc[j][0] += s * w.x; acc[j][1] += s * w.y; } }
#pragma unroll
        for (int j = 0; j < 5; ++j) { RED[(wave * 5 + j) * 128 + 2 * lane] = acc[j][0]; RED[(wave * 5 + j) * 128 + 2 * lane + 1] = acc[j][1]; }
        __syncthreads();
        for (int i = tid; i < 640; i += 512) { const int j = i >> 7, cn = i & 127; float s = 0.f;
#pragma unroll
            for (int w = 0; w < 8; ++w) s += RED[(w * 5 + j) * 128 + cn];
            MOD[((size_t)l * 5 + j) * NMOD + n0 + cn] = s + a.in[I_BMOD][l * NMOD + n0 + cn]; }
        __syncthreads();
    }
}

__device__ __forceinline__ void ssm_tables_t1(const Args& a, int gtid, int NT) {
    float* ETAB = (float*)(a.ws + WS_ETAB); float* BBT = (float*)(a.ws + WS_BB);
    for (int idx = gtid; idx < DEPTH * 2 * SG * 64; idx += NT) {
        const int n = idx & 63, gq = (idx >> 6) % SG, dir = (idx / (64 * SG)) & 1, l = idx / (64 * SG * 2);
        const double lr = fmin((double)a.in[I_LRE][idx], -1e-4), li = (double)a.in[I_LIM][idx], dt = exp((double)a.in[I_LDT][(l * 2 + dir) * SG + gq]);
        const double mag = exp(lr * dt), th = li * dt; double sn, cs; sincos(th, &sn, &cs);
        const double ab_re = mag * cs, ab_im = mag * sn, nr = ab_re - 1.0, den = lr * lr + li * li;
        const double f_re = (nr * lr + ab_im * li) / den, f_im = (ab_im * lr - nr * li) / den;
        const size_t o = (((size_t)(l * SG + gq) * 2 + dir) * 64 + n);
        float* e = ETAB + o * 66;
        double pr = 1.0, pi = 0.0;
        for (int k = 0; k <= 32; ++k) { e[2 * k] = (float)pr; e[2 * k + 1] = (float)pi; const double nr2 = pr * ab_re - pi * ab_im, ni2 = pr * ab_im + pi * ab_re; pr = nr2; pi = ni2; }
        float* bb = BBT + o * 32;
        for (int q = 0; q < 16; ++q) { const double br = (double)a.in[I_BRE][(size_t)idx * 16 + q], bi = (double)a.in[I_BIM][(size_t)idx * 16 + q];
            bb[2 * q] = (float)(f_re * br - f_im * bi); bb[2 * q + 1] = (float)(f_re * bi + f_im * br); }
    }
}
__device__ __forceinline__ void ssm_tables_t2(const Args& a, LAS unsigned char* lds, int bid, int G, int tid) {
    LAS float* Cs = (LAS float*)lds;
    LAS float* Es = (LAS float*)(lds + 16 * 65 * 8);
    LAS float* Bs = Es + 64 * 32 * 2;
    const float* ETAB = (const float*)(a.ws + WS_ETAB); const float* BBT = (const float*)(a.ws + WS_BB); float* MT = (float*)(a.ws + WS_MT);
    for (int it = bid; it < DEPTH * SG * 2; it += G) {
        const int dir = it & 1, gq = (it >> 1) % SG, l = it / (2 * SG);
        const size_t o = ((size_t)(l * SG + gq) * 2 + dir);
        const size_t ci = ((size_t)(l * 2 + dir) * SG + gq) * 1024;
        for (int i = tid; i < 1024; i += 512) { const int p = i >> 6, n = i & 63; Cs[(p * 65 + n) * 2] = a.in[I_CRE][ci + i]; Cs[(p * 65 + n) * 2 + 1] = a.in[I_CIM][ci + i]; }
        for (int i = tid; i < 64 * 32; i += 512) { const int n = i >> 5, lag = i & 31; Es[i * 2] = ETAB[(o * 64 + n) * 66 + 2 * lag]; Es[i * 2 + 1] = ETAB[(o * 64 + n) * 66 + 2 * lag + 1]; }
        for (int i = tid; i < 64 * 32; i += 512) Bs[i] = BBT[o * 64 * 32 + i];
        __syncthreads();
        const int lag = tid >> 4, p = tid & 15;
        float acc[16];
#pragma unroll
        for (int q = 0; q < 16; ++q) acc[q] = 0.f;
        for (int n = 0; n < 64; ++n) {
            const float cr = Cs[(p * 65 + n) * 2], cim = Cs[(p * 65 + n) * 2 + 1], er = Es[(n * 32 + lag) * 2], ei = Es[(n * 32 + lag) * 2 + 1];
            const float gr = cr * er - cim * ei, gi = cr * ei + cim * er;
#pragma unroll
            for (int q = 0; q < 16; ++q) acc[q] += gr * Bs[(n * 16 + q) * 2] - gi * Bs[(n * 16 + q) * 2 + 1];
        }
        float* dst = MT + (o * 32 + lag) * 256 + p * 16;
#pragma unroll
        for (int q = 0; q < 16; q += 4) *(f32x4*)(dst + q) = (f32x4){acc[q], acc[q + 1], acc[q + 2], acc[q + 3]};
        __syncthreads();
    }
}
__device__ __forceinline__ void ssm_fill(const Args& a, int l, LAS unsigned char* lds, int bid, int G, int tid) {
    LAS float* MTs = (LAS float*)lds;
    LAS float* Es = (LAS float*)(lds + 65536);
    LAS float* Cs = (LAS float*)(lds + 65536 + 33792);
    LAS float* Bs = (LAS float*)(lds + 65536 + 33792 + 16384);
    LAS float* Ds = (LAS float*)(lds + 65536 + 33792 + 32768);
    const float* ETAB = (const float*)(a.ws + WS_ETAB); const float* BBT = (const float*)(a.ws + WS_BB); const float* MT = (const float*)(a.ws + WS_MT);
    bf16_t* W1 = (bf16_t*)(a.ws + WS_W1); bf16_t* W3 = (bf16_t*)(a.ws + WS_W3);
    for (int it = bid; it < SG * 4; it += G) {
        const int gq = it >> 2, part = it & 3;
        const size_t o = (size_t)(l * SG + gq) * 2;
        for (int i = tid; i < 2 * 32 * 256; i += 512) MTs[i] = MT[o * 32 * 256 + i];
        for (int i = tid; i < 2 * 64 * 66; i += 512) Es[i] = ETAB[o * 64 * 66 + i];
        for (int i = tid; i < 2 * 64 * 32; i += 512) Bs[i] = BBT[o * 64 * 32 + i];
        for (int i = tid; i < 2 * 1024; i += 512) { const int dir = i >> 10, pn = i & 1023; const size_t ci = ((size_t)(l * 2 + dir) * SG + gq) * 1024 + pn;
            Cs[i * 2] = a.in[I_CRE][ci]; Cs[i * 2 + 1] = a.in[I_CIM][ci]; }
        if (tid < 16) Ds[tid] = a.in[I_SD][l * 768 + gq * 16 + tid];
        __syncthreads();
        for (int ch = tid; ch < 128 * 96; ch += 512) {
            const int ncol = part * 128 + ch / 96, kc = ch % 96, t = ncol >> 4, p = ncol & 15;
            float v[8];
            if (kc < 64) { const int s = kc >> 1, q0 = (kc & 1) * 8;
#pragma unroll
                for (int i = 0; i < 8; ++i) { const int q = q0 + i; float x = 0.f;
                    if (s <= t) x += MTs[((t - s) * 16 + p) * 16 + q];
                    if (s >= t) x += MTs[8192 + ((s - t) * 16 + p) * 16 + q];
                    if (s == t && p == q) x += Ds[p];
                    v[i] = x; }
            } else { const int dir = (kc - 64) >> 4, kk0 = ((kc - 64) & 15) * 8, e = dir == 0 ? t + 1 : 32 - t;
#pragma unroll
                for (int i = 0; i < 8; ++i) { const int kk = kk0 + i, prt = kk >> 6, n = kk & 63;
                    const float cr = Cs[((dir * 16 + p) * 64 + n) * 2], cim = Cs[((dir * 16 + p) * 64 + n) * 2 + 1], er = Es[((dir * 64 + n) * 33 + e) * 2], ei = Es[((dir * 64 + n) * 33 + e) * 2 + 1];
                    v[i] = prt == 0 ? (cr * er - cim * ei) : -(cr * ei + cim * er); }
            }
            u32x4 w; w.x = cvt_pk_bf16(v[0], v[1]); w.y = cvt_pk_bf16(v[2], v[3]); w.z = cvt_pk_bf16(v[4], v[5]); w.w = cvt_pk_bf16(v[6], v[7]);
            *(u32x4*)(W3 + ((size_t)(gq * 512 + ncol) * 768 + kc * 8)) = w;
        }
        for (int ch = tid; ch < 64 * 64; ch += 512) {
            const int ncol = part * 64 + (ch >> 6), kc = ch & 63, dir = ncol >> 7, prt = (ncol >> 6) & 1, n = ncol & 63, s = kc >> 1, q0 = (kc & 1) * 8, e = dir == 0 ? 31 - s : s;
            const float er = Es[((dir * 64 + n) * 33 + e) * 2], ei = Es[((dir * 64 + n) * 33 + e) * 2 + 1];
            float v[8];
#pragma unroll
            for (int i = 0; i < 8; ++i) { const float br = Bs[((dir * 64 + n) * 16 + q0 + i) * 2], bi = Bs[((dir * 64 + n) * 16 + q0 + i) * 2 + 1];
                v[i] = prt == 0 ? (er * br - ei * bi) : (er * bi + ei * br); }
            u32x4 w; w.x = cvt_pk_bf16(v[0], v[1]); w.y = cvt_pk_bf16(v[2], v[3]); w.z = cvt_pk_bf16(v[4], v[5]); w.w = cvt_pk_bf16(v[6], v[7]);
            *(u32x4*)(W1 + ((size_t)(gq * 256 + ncol) * 512 + kc * 8)) = w;
        }
        __syncthreads();
    }
}

template <int MODE>
__device__ __forceinline__ void row_pass(LAS unsigned char* lds, int bid, int G, int tid, int wave, int lane,
                                         const float* xin, float* xout, const float* cin, float* cout, const bf16_t* Y, const float* YP  , int nrows, bf16_t* XN, unsigned char* XN8, bool w8,
                                         const float* gpost, const float* gpre, const float* modg  , int gate_off,
                                         const float* modn  , int shift_off, int scale_off) {
    LAS float* V = (LAS float*)lds;
    int cur = -1;
    const int nblk = nrows / 16;
    for (int blk = bid; blk < nblk; blk += G) {
        const int row0 = blk * 16, jb = row0 < ML ? row0 / SEQ : 4;
        if (jb != cur) {
            __syncthreads();
            for (int i = tid; i < D; i += 512) {
                if (cur < 0) { if (MODE != 0) V[i] = gpost[i]; if (MODE != 2) V[D + i] = gpre[i]; }
                if (MODE != 0) V[2 * D + i] = modg[(size_t)jb * NMOD + gate_off + i];
                if (MODE != 2) { V[3 * D + i] = modn[(size_t)jb * NMOD + shift_off + i]; V[4 * D + i] = 1.0f + modn[(size_t)jb * NMOD + scale_off + i]; }
            }
            cur = jb;
            __syncthreads();
        }
        f32x4 x2[2][8]; u32x2 yw[2][8];
#pragma unroll
        for (int rr = 0; rr < 2; ++rr) {
            const int row = row0 + wave * 2 + rr;
            const float* xs = row < ML ? xin + (size_t)row * D : cin + (size_t)(row - ML) * D;
#pragma unroll
            for (int j = 0; j < 8; ++j) x2[rr][j] = __builtin_nontemporal_load((const f32x4*)(xs + 4 * lane + 256 * j));
            if (MODE != 0 && row < ML) {
#pragma unroll
                for (int j = 0; j < 8; ++j) yw[rr][j] = __builtin_nontemporal_load((const u32x2*)(Y + (size_t)row * D + 4 * lane + 256 * j)); }
        }
#pragma unroll
        for (int rr = 0; rr < 2; ++rr) {
            const int row = row0 + wave * 2 + rr;
            float* xd = row < ML ? xout + (size_t)row * D : cout + (size_t)(row - ML) * D;
            f32x4 x[8];
#pragma unroll
            for (int j = 0; j < 8; ++j) x[j] = x2[rr][j];
            if (MODE != 0) {
                f32x4 y[8]; float ss = 0.f;
#pragma unroll
                for (int j = 0; j < 8; ++j) {
                    if (row < ML) { const u32x2 w = yw[rr][j]; y[j] = (f32x4){bf_lo(w.x), bf_hi(w.x), bf_lo(w.y), bf_hi(w.y)}; }
                    else { const float* yp = YP + (size_t)(row - ML) * D + 4 * lane + 256 * j; f32x4 s = *(const f32x4*)yp;
#pragma unroll
                        for (int ks = 1; ks < 8; ++ks) s += *(const f32x4*)(yp + (size_t)ks * MC * D);
                        y[j] = s; }
                    ss += (y[j].x * y[j].x + y[j].y * y[j].y) + (y[j].z * y[j].z + y[j].w * y[j].w); }
                const float rstd = rsqrtf(wave_sum(ss) * (1.f / D) + NORM_EPS);
#pragma unroll
                for (int j = 0; j < 8; ++j) { const f32x4 gp = *(const LAS f32x4*)(V + 4 * lane + 256 * j), gt = *(const LAS f32x4*)(V + 2 * D + 4 * lane + 256 * j);
                    x[j] = x[j] + gt * (y[j] * rstd * gp);
                    if (MODE != 3) __builtin_nontemporal_store(x[j], (f32x4*)(xd + 4 * lane + 256 * j)); }
            }
            if (MODE != 2) {
                float ss = 0.f;
#pragma unroll
                for (int j = 0; j < 8; ++j) ss += (x[j].x * x[j].x + x[j].y * x[j].y) + (x[j].z * x[j].z + x[j].w * x[j].w);
                const float rstd = rsqrtf(wave_sum(ss) * (1.f / D) + NORM_EPS);
#pragma unroll
                for (int j = 0; j < 8; ++j) { const f32x4 gp = *(const LAS f32x4*)(V + D + 4 * lane + 256 * j), sh = *(const LAS f32x4*)(V + 3 * D + 4 * lane + 256 * j), sc = *(const LAS f32x4*)(V + 4 * D + 4 * lane + 256 * j);
                    const f32x4 h = sh + sc * (x[j] * rstd * gp);
                    u32x2 w; w.x = cvt_pk_bf16(h.x, h.y); w.y = cvt_pk_bf16(h.z, h.w);
                    *(u32x2*)(XN + (size_t)row * D + 4 * lane + 256 * j) = w;
                    if (w8) { unsigned t = 0u; t = __builtin_amdgcn_cvt_pk_fp8_f32(h.x, h.y, t, false); t = __builtin_amdgcn_cvt_pk_fp8_f32(h.z, h.w, t, true); *(unsigned*)(XN8 + (size_t)row * D + 4 * lane + 256 * j) = t; } }
            }
        }
    }
    __syncthreads();
}

__device__ __forceinline__ void conv_pass(const Args& a, int l, int wk, int nwk, int lane) {
    bf16_t* P = (bf16_t*)(a.ws + WS_P);
    const int c = (wk & 1) * 512 + 8 * lane;
    const float* cw = a.in[I_CONVW] + (size_t)l * 3 * 1024 + c;
    float w0[8], w1[8], w2[8];
#pragma unroll
    for (int i = 0; i < 8; ++i) { w0[i] = cw[i]; w1[i] = cw[1024 + i]; w2[i] = cw[2048 + i]; }
    for (int it = wk; it < (M / 16) * 8; it += nwk) {
        const int r0 = (it >> 3) * 16 + ((it >> 1) & 3) * 4;
        const int s0 = r0 < ML ? (r0 / SEQ) * SEQ : ML + ((r0 - ML) / CTXL) * CTXL, s1 = s0 + (r0 < ML ? SEQ : CTXL);
        float u[6][8];
#pragma unroll
        for (int k = 0; k < 6; ++k) { const int r = r0 - 1 + k;
            if (r >= s0 && r < s1) { f32x4 c0, c1; pg8::unpack8(*(const u32x4*)(P + (size_t)r * NIN + C_AC + c), c0, c1);
#pragma unroll
                for (int i = 0; i < 4; ++i) { u[k][i] = c0[i]; u[k][4 + i] = c1[i]; } }
            else {
#pragma unroll
                for (int i = 0; i < 8; ++i) u[k][i] = 0.f; } }
#pragma unroll
        for (int k = 0; k < 4; ++k) { bf16_t* pb = P + (size_t)(r0 + k) * NIN + C_AB + c; f32x4 b0, b1; pg8::unpack8(*(const u32x4*)pb, b0, b1);
#pragma unroll
            for (int i = 0; i < 4; ++i) { b0[i] *= w0[i] * u[k][i] + w1[i] * u[k + 1][i] + w2[i] * u[k + 2][i]; b1[i] *= w0[4 + i] * u[k][4 + i] + w1[4 + i] * u[k + 1][4 + i] + w2[4 + i] * u[k + 2][4 + i]; }
            *(u32x4*)pb = pg8::pack8(b0, b1); }
    }
}
__device__ __forceinline__ void qk_pass(const Args& a, int l, int gw, int NGW, int lane) {
    bf16_t* P = (bf16_t*)(a.ws + WS_P); unsigned char* K8 = (unsigned char*)(a.ws + WS_K8);
    const float* ROPE = (const float*)(a.ws + WS_ROPE);
    const int j = lane & 15, hd = (lane >> 4) & 1, rp2 = lane >> 5;
    float gk_[8];
#pragma unroll
    for (int i = 0; i < 8; ++i) gk_[i] = a.in[I_KG][l * 128 + 8 * j + i];
    for (int r0 = 8 * gw; r0 < M; r0 += 8 * NGW) {
        const bool lat = r0 < ML;
        u32x4 raw[4]; f32x4 cs[4][2], sn[4][2];
#pragma unroll
        for (int rr = 0; rr < 4; ++rr) { const int row = r0 + 2 * rr + rp2;
            raw[rr] = *(const u32x4*)(P + (size_t)row * NIN + C_K + hd * 128 + 8 * j);
            if (lat) { const int t = row % SEQ, pos = (j < 8) ? (t >> 6) : (t & 63); const float* rp = ROPE + pos * 32 + 8 * (j & 3);
                cs[rr][0] = *(const f32x4*)rp; cs[rr][1] = *(const f32x4*)(rp + 4); sn[rr][0] = *(const f32x4*)(rp + 4096); sn[rr][1] = *(const f32x4*)(rp + 4100); } }
#pragma unroll
        for (int rr = 0; rr < 4; ++rr) { const int row = r0 + 2 * rr + rp2;
            f32x4 v0, v1; pg8::unpack8(raw[rr], v0, v1);
            float x[8] = {v0[0], v0[1], v0[2], v0[3], v1[0], v1[1], v1[2], v1[3]};
            float ss = 0.f;
#pragma unroll
            for (int i = 0; i < 8; ++i) ss += x[i] * x[i];
            ss += __shfl_xor(ss, 1); ss += __shfl_xor(ss, 2); ss += __shfl_xor(ss, 4); ss += __shfl_xor(ss, 8);
            const float rstd = rsqrtf(ss * (1.f / 128.f) + NORM_EPS);
#pragma unroll
            for (int i = 0; i < 8; ++i) x[i] = x[i] * rstd * gk_[i];
            if (lat) {
#pragma unroll
                for (int i = 0; i < 8; ++i) { const float pr = __shfl_xor(x[i], 4); x[i] = x[i] * cs[rr][i >> 2][i & 3] + ((j & 4) ? pr : -pr) * sn[rr][i >> 2][i & 3]; } }
            {
                const int bq = lat ? row / SEQ : (row - ML) / CTXL, key = lat ? CTXL + row % SEQ : (row - ML) % CTXL;
                unsigned t0_ = 0u, t1_ = 0u;
                t0_ = __builtin_amdgcn_cvt_pk_fp8_f32(x[0], x[1], t0_, false); t0_ = __builtin_amdgcn_cvt_pk_fp8_f32(x[2], x[3], t0_, true);
                t1_ = __builtin_amdgcn_cvt_pk_fp8_f32(x[4], x[5], t1_, false); t1_ = __builtin_amdgcn_cvt_pk_fp8_f32(x[6], x[7], t1_, true);
                *(u32x2*)(K8 + ((size_t)(bq * 2 + hd) * (CTXL + SEQ) + key) * 128 + 8 * j) = (u32x2){t0_, t1_}; }
        }
    }
}
__device__ __forceinline__ void vt_pass(const Args& a, LAS unsigned char* scr, int wk, int nwk, int lane) {
    const bf16_t* P = (const bf16_t*)(a.ws + WS_P); unsigned char* VT8 = (unsigned char*)(a.ws + WS_VT8);
    const int j = lane & 15, kq = lane >> 4;
    for (int it = wk; it < NBATCH * 2 * 132; it += nwk) {
        const int b = it / 264, kvh = (it / 132) & 1, tau = it % 132;
        const size_t row0 = tau < 4 ? (size_t)(ML + b * CTXL + tau * 64) : (size_t)b * SEQ + (size_t)(tau - 4) * 64;
        u32x4 raw[16];
#pragma unroll
        for (int i = 0; i < 16; ++i) raw[i] = *(const u32x4*)(P + (row0 + 4 * i + kq) * NIN + C_V + kvh * 128 + 8 * j);
#pragma unroll
        for (int i = 0; i < 16; ++i) { const int pos = attn::v_pos(4 * i + kq); f32x4 v0, v1; pg8::unpack8(raw[i], v0, v1);
            unsigned w0 = 0u, w1 = 0u;
            w0 = __builtin_amdgcn_cvt_pk_fp8_f32(v0[0], v0[1], w0, false); w0 = __builtin_amdgcn_cvt_pk_fp8_f32(v0[2], v0[3], w0, true);
            w1 = __builtin_amdgcn_cvt_pk_fp8_f32(v1[0], v1[1], w1, false); w1 = __builtin_amdgcn_cvt_pk_fp8_f32(v1[2], v1[3], w1, true);
#pragma unroll
            for (int e = 0; e < 4; ++e) { scr[(8 * j + e) * 64 + pos] = (unsigned char)(w0 >> (8 * e)); scr[(8 * j + 4 + e) * 64 + pos] = (unsigned char)(w1 >> (8 * e)); } }
        LDS_WAIT(); asm volatile("" ::: "memory");
        unsigned char* dst = VT8 + ((size_t)(b * 2 + kvh) * 132 + tau) * 8192;
#pragma unroll
        for (int i = 0; i < 8; ++i) *(u32x4*)(dst + 16 * (lane + 64 * i)) = *(const LAS u32x4*)(scr + 16 * (lane + 64 * i));
        LDS_WAIT(); asm volatile("" ::: "memory");
    }
}
__device__ __forceinline__ void ssm_scan(const Args& a, int l, int bid, int G, int wave, int lane) {
    const bf16_t* S = (const bf16_t*)(a.ws + WS_S); bf16_t* As = (bf16_t*)(a.ws + WS_ASSM); const float* ETAB = (const float*)(a.ws + WS_ETAB);
    for (int ch = bid + G * wave; ch < NBATCH * SG * 2; ch += G * 8) {
        const int dir = ch & 1, gq = (ch >> 1) % SG, b = ch / (2 * SG);
        const float* e = ETAB + ((((size_t)(l * SG + gq) * 2 + dir) * 64 + lane) * 66 + 64);
        const float ar = e[0], ai = e[1];
        float hr = 0.f, hi = 0.f;
        for (int s0 = 0; s0 < 264; s0 += 12) {
            float sr[12], si[12]; int rows[12];
#pragma unroll
            for (int k = 0; k < 12; ++k) { const int s = s0 + k; int row;
                if (s < 8) row = 1024 + 8 * b + (dir == 0 ? s : 7 - s); else row = 256 * b + (dir == 0 ? s - 8 : 263 - s);
                rows[k] = row; const bf16_t* sp = S + ((size_t)(gq * SGR + row) * 256 + dir * 128 + lane); sr[k] = __uint_as_float((unsigned)sp[0] << 16); si[k] = __uint_as_float((unsigned)sp[64] << 16); }
#pragma unroll
            for (int k = 0; k < 12; ++k) { bf16_t* hp = As + ((size_t)(gq * SGR + rows[k]) * 768 + 512 + dir * 128 + lane);
                hp[0] = (bf16_t)(cvt_pk_bf16(hr, 0.f) & 0xffffu); hp[64] = (bf16_t)(cvt_pk_bf16(hi, 0.f) & 0xffffu);
                const float nr = ar * hr - ai * hi + sr[k], ni = ar * hi + ai * hr + si[k]; hr = nr; hi = ni; }
        }
    }
}

typedef const __attribute__((address_space(4))) unsigned long long* KArgP;
__device__ __forceinline__ Args load_args() {
    KArgP p = (KArgP)__builtin_amdgcn_kernarg_segment_ptr(); asm volatile("" : "+s"(p));
    Args r;
#pragma unroll
    for (int i = 0; i < 28; ++i) r.in[i] = (const float*)(const GAS float*)p[i];
    r.out = (float*)(GAS float*)p[28]; r.ws = (unsigned char*)(GAS unsigned char*)p[29]; const unsigned long long lh = p[30]; r.lo = (int)(unsigned)lh; r.hi = (int)(unsigned)(lh >> 32);
    return r;
}
__global__ void __launch_bounds__(512, 2) hybrid_fwd(Args ka) {
    extern __shared__ __attribute__((aligned(16))) unsigned char lds_raw[];
    LAS unsigned char* lds = (LAS unsigned char*)lds_raw;
    volatile LAS unsigned* MISC = (volatile LAS unsigned*)(lds + MISC_OFF);
    const int G = gridDim.x, bid = blockIdx.x;
    if (threadIdx.x < 64) MISC[threadIdx.x] = 0u;
    __syncthreads();
    XcdBarrier bar; bar.bar = (unsigned*)(ka.ws + WS_CTL) + CW_BAR; bar.x = 0; bar.st = nullptr;
    if (ka.hi - ka.lo > 1) bar = xcd_barrier_post((unsigned*)(ka.ws + WS_CTL) + CW_BAR, MISC + 8);
#define PH(k) (ka.lo <= (k) && (k) < ka.hi)
#define SEAM(k) do { if ((k) + 1 < ka.hi) xcd_barrier(bar); } while (0)
#define PHASE_ARGS const Args a = load_args(); unsigned char* const ws = a.ws; (void)ws; \
    int tid_ = threadIdx.x; asm volatile("" : "+v"(tid_)); const int tid = tid_, lane = tid & 63, wave = __builtin_amdgcn_readfirstlane(tid >> 6); \
    const int gw = bid * 8 + wave, NGW = G * 8, gtid = bid * 512 + tid, NTHR = G * 512; (void)lane; (void)gw; (void)NGW; (void)gtid; (void)NTHR; \
    bf16_t* const P = (bf16_t*)(ws + WS_P); bf16_t* const XN = (bf16_t*)(ws + WS_XN); bf16_t* const MX = (bf16_t*)(ws + WS_MX); bf16_t* const UP = (bf16_t*)(ws + WS_UP); \
    bf16_t* const ASSM = (bf16_t*)(ws + WS_ASSM); bf16_t* const SST = (bf16_t*)(ws + WS_S); float* const CTXR = (float*)(ws + WS_CTXR); float* const MOD = (float*)(ws + WS_MOD); \
    (void)P; (void)XN; (void)MX; (void)UP; (void)ASSM; (void)SST; (void)CTXR; (void)MOD;

    if (PH(0)) { PHASE_ARGS
        float* ROPE = (float*)(ws + WS_ROPE);
        for (int idx = gtid; idx < 4096; idx += NTHR) { const int pos = idx >> 5, i = idx & 31; const double inv = exp(-(double)i * (9.210340371976184 / 32.0)); double s, c; sincos((double)pos * inv, &s, &c); ROPE[idx] = (float)c; ROPE[4096 + idx] = (float)s; }
        for (int rep = 0; rep < REP_CV; ++rep) { ssm_tables_t1(a, gtid, NTHR);
        mod_gemv(a, lds, bid, G, tid, wave, lane); __syncthreads(); }
        __syncthreads();
        for (int rep = 0; rep < REP_CV; ++rep) convert_weights(a, 0, lds, gw, NGW, wave, lane);
        SEAM(0);
    }
    if (PH(1)) { PHASE_ARGS
        for (int rep = 0; rep < REP_CV; ++rep) ssm_tables_t2(a, lds, bid, G, tid);
        if (REP_RP > 1) row_pass<0>(lds, bid, G, tid, wave, lane, a.in[I_X], (float*)P, a.in[I_CTX], (float*)(ws + WS_P + 500 * MiB), MX, (const float*)(ws + WS_PART), M, (bf16_t*)(ws + WS_P + 300 * MiB), (unsigned char*)(ws + WS_XN8), false, a.in[I_GPREMIX], a.in[I_GPREMIX], MOD, 0, MOD, 0, D);
        row_pass<0>(lds, bid, G, tid, wave, lane, a.in[I_X], a.out, a.in[I_CTX], CTXR, MX, (const float*)(ws + WS_PART), M, XN, (unsigned char*)(ws + WS_XN8), true, a.in[I_GPREMIX], a.in[I_GPREMIX], MOD, 0, MOD, 0, D);
        SEAM(1);
    }
    for (int l = 0; l < DEPTH; ++l) {
        const int pb = 2 + 12 * l;
        const int Meff = l + 1 < DEPTH ? M : ML;
        if (PH(pb + 0)) { PHASE_ARGS
            if (l == 0) for (int rep = 0; rep < REP_CV; ++rep) ssm_fill(a, l, lds, bid, G, tid);
            { pg8::Gemm g{XN, (const bf16_t*)(ws + WS_WIN), D, D, D}; pg8::StaticOrder S; S.init(M, C_F8, D, G, bid);
              pg8::EpiProj E{P, ASSM};
              for (int rep = 0; rep < REP_BIG * REP_PROJ; ++rep) pg8::gemm_phase(lds, g, S, E); }
            SEAM(pb + 0);
        }
        if (PH(pb + 1)) { PHASE_ARGS
            if (bid & 1) conv_pass(a, l, gw, NGW, lane);
            {
              pg8::Gemm g{(const bf16_t*)(ws + WS_XN8), (const bf16_t*)(ws + WS_WG8), D / 2, D / 2, D / 2}; pg8::StaticOrder S; S.init(M, NIN - C_F8, D / 2, G, bid);
              pg8::EpiGate E{P};
              for (int rep = 0; rep < REP_BIG * REP_PROJ; ++rep) pg8::gemm_phase<pg8::EpiGate, pg8::StaticOrder, true>(lds, g, S, E); }
            { pg8::Gemm g{ASSM, (const bf16_t*)(ws + WS_W1), 768, 512, 512}; pg8::GroupOrder S; S.init(1, 512, G, bid); pg8::EpiState E{SST}; for (int rep = 0; rep < REP_RG; ++rep) pg8::gemm_phase(lds, g, S, E); }
            if (!(bid & 1)) conv_pass(a, l, gw, NGW, lane);
            SEAM(pb + 1);
        }
        if (PH(pb + 2)) { PHASE_ARGS
            if (wave < 2) { for (int rep = 0; rep < REP_SCAN; ++rep) ssm_scan(a, l, bid, G, wave, lane); }
            else { const int wk = bid * 6 + (wave - 2), nwk = G * 6; qk_pass(a, l, wk, nwk, lane); vt_pass(a, lds + wave * 8192, wk, nwk, lane); }
            SEAM(pb + 2);
        }
        if (PH(pb + 3)) { PHASE_ARGS
            { pg8::Gemm g{ASSM, (const bf16_t*)(ws + WS_W3), 768, 768, 768}; pg8::GroupOrder S; S.init(2, 768, G, bid); pg8::EpiSsmY E{P}; for (int rep = 0; rep < REP_RG; ++rep) pg8::gemm_phase(lds, g, S, E); }
            for (int rep = 0; rep < REP_ATT; ++rep)
            for (int u = bid; u < (l + 1 < DEPTH ? 1056 : 1024); u += G) {
                const bool lat = u < 1024; int b, hq, qb;
                if (lat) { const int xcd = u & 7, idx = (u >> 3) & 31, rnd = u >> 8; b = xcd >> 1; hq = (xcd & 1) * 4 + (idx >> 3); qb = (idx & 7) + 8 * rnd; }
                else { const int c = u - 1024; b = c >> 3; hq = c & 7; qb = 0; }
                const int kvh = hq >> 2;
                const size_t r0 = lat ? (size_t)b * SEQ + (size_t)qb * 256 : (size_t)(ML + b * CTXL);
                const size_t kvo = (size_t)(b * 2 + kvh) * (CTXL + SEQ) * 128;
#ifdef ATT_PROBE
                attn::attn_unit14<ATT_PROBE - 1>(P + r0 * NIN + C_Q + hq * 128, (const unsigned char*)(ws + WS_K8) + kvo, (const unsigned char*)(ws + WS_VT8) + kvo, XN + (size_t)bid * 256 * 128, lat ? CTXL + SEQ : CTXL,
                                  (char*)lds_raw, lds, a.in[I_QG] + l * 128, (const float*)(ws + WS_ROPE), lat ? qb * 256 : -1, 128);
#endif
                attn::attn_unit14(P + r0 * NIN + C_Q + hq * 128, (const unsigned char*)(ws + WS_K8) + kvo, (const unsigned char*)(ws + WS_VT8) + kvo, P + r0 * NIN + C_O + hq * 128, lat ? CTXL + SEQ : CTXL,
                                  (char*)lds_raw, lds, a.in[I_QG] + l * 128, (const float*)(ws + WS_ROPE), lat ? qb * 256 : -1);
            }
            SEAM(pb + 3);
        }
        if (PH(pb + 4)) { PHASE_ARGS pg8::Gemm g{P + C_AB, (const bf16_t*)(ws + WS_WCO), NIN, 1024, 1024}; pg8::StaticOrder S; S.init(Meff, D, 1024, G, bid); pg8::EpiMerge<false> E{XN, P, C_GC}; for (int rep = 0; rep < REP_RG; ++rep) pg8::gemm_phase(lds, g, S, E, S.stagger()); SEAM(pb + 4); }
        if (PH(pb + 5)) { PHASE_ARGS pg8::Gemm g{P + C_Y, (const bf16_t*)(ws + WS_WGLU), NIN, 768, 768}; pg8::StaticOrder S; S.init(Meff, 4096, 768, G, bid); pg8::EpiGlu E{XN, P}; if (REP_RG > 1) { pg8::EpiGlu Ed{MX, P}; pg8::gemm_phase(lds, g, S, Ed); } pg8::gemm_phase(lds, g, S, E, S.stagger()); SEAM(pb + 5); }
        if (PH(pb + 6)) { PHASE_ARGS pg8::Gemm g{P + C_O, (const bf16_t*)(ws + WS_WAO), NIN, 1024, 1024}; pg8::StaticOrder S; S.init(Meff, D, 1024, G, bid); pg8::EpiMerge<true> E{XN, P, C_GA}; if (REP_RG > 1) { pg8::EpiMerge<true> Ed{MX, P, C_GA}; pg8::gemm_phase(lds, g, S, Ed); } pg8::gemm_phase(lds, g, S, E, S.stagger()); SEAM(pb + 6); }
        if (PH(pb + 7)) { PHASE_ARGS pg8::Gemm g{XN, (const bf16_t*)(ws + WS_WOUT), D, D, D}; pg8::SplitCtxOrder S; S.init(D, D, G, bid, l + 1 < DEPTH); pg8::EpiBf16Part E{MX, (float*)(ws + WS_PART)}; for (int rep = 0; rep < REP_RG; ++rep) pg8::gemm_phase(lds, g, S, E); SEAM(pb + 7); }
        if (PH(pb + 8)) { PHASE_ARGS
            const float* modl = MOD + (size_t)l * 5 * NMOD;
            if (REP_RP > 1) row_pass<1>(lds, bid, G, tid, wave, lane, l == 0 ? a.in[I_X] : a.out, (float*)P, l == 0 ? a.in[I_CTX] : CTXR, (float*)(ws + WS_P + 500 * MiB), MX, (const float*)(ws + WS_PART), Meff, (bf16_t*)(ws + WS_P + 300 * MiB), (unsigned char*)(ws + WS_XN8), false, a.in[I_GPOSTMIX] + l * D, a.in[I_GPREMLP] + l * D, modl, 2 * D, modl, 3 * D, 4 * D);
            row_pass<1>(lds, bid, G, tid, wave, lane, l == 0 ? a.in[I_X] : a.out, a.out, l == 0 ? a.in[I_CTX] : CTXR, CTXR, MX, (const float*)(ws + WS_PART), Meff, XN, (unsigned char*)(ws + WS_XN8), false, a.in[I_GPOSTMIX] + l * D, a.in[I_GPREMLP] + l * D, modl, 2 * D, modl, 3 * D, 4 * D);
            SEAM(pb + 8);
        }
        if (PH(pb + 9)) { PHASE_ARGS pg8::Gemm g{XN, (const bf16_t*)(ws + WS_WUP), D, D, D}; pg8::StaticOrder S; S.init(Meff, FF, D, G, bid); pg8::EpiBf16<1> E{UP, FF, 0};
#if OVL_EXP
            { const float* modl = MOD + (size_t)l * 5 * NMOD; const int kq = OVL_EXP == 2 ? (bid & 15) : 0;
              if (kq > 0) { pg8::StaticOrder S1 = S; S1.iend = kq; pg8::gemm_phase(lds, g, S1, E); }
              row_pass<3>(lds, bid, G, tid, wave, lane, a.out, a.out, CTXR, CTXR, MX, (const float*)(ws + WS_PART), ML, ASSM, (unsigned char*)(ws + WS_XN8), false, a.in[I_GPOSTMIX] + l * D, a.in[I_GPREMLP] + l * D, modl, 2 * D, modl, 3 * D, 4 * D);
              S.ibeg = kq; }
#endif
            if (REP_UP) { pg8::EpiBf16<1> Ed{UP, FF, REP_UP == 2 ? (G + 1000) : 0}; pg8::gemm_phase(lds, g, S, Ed); } for (int rep = 0; rep < REP_BIG; ++rep) pg8::gemm_phase(lds, g, S, E, S.stagger()); SEAM(pb + 9); }
        if (PH(pb + 10)) { PHASE_ARGS pg8::Gemm g{UP, (const bf16_t*)(ws + WS_WDN), FF, FF, FF}; pg8::SplitCtxOrder S; S.init(D, FF, G, bid, l + 1 < DEPTH); S.so.wgm = 4; pg8::EpiBf16Part E{MX, (float*)(ws + WS_PART)}; for (int rep = 0; rep < REP_BIG * REP_DOWN; ++rep) pg8::gemm_phase(lds, g, S, E); SEAM(pb + 10); }
        if (PH(pb + 11)) { PHASE_ARGS
            const float* modl = MOD + (size_t)l * 5 * NMOD;
            if (l + 1 < DEPTH) {
                if (REP_RP > 1) row_pass<1>(lds, bid, G, tid, wave, lane, a.out, (float*)P, CTXR, (float*)(ws + WS_P + 500 * MiB), MX, (const float*)(ws + WS_PART), M, (bf16_t*)(ws + WS_P + 300 * MiB), (unsigned char*)(ws + WS_XN8), false, a.in[I_GPOSTMLP] + l * D, a.in[I_GPREMIX] + (l + 1) * D, modl, 5 * D, modl + 5 * NMOD, 0, D);
                row_pass<1>(lds, bid, G, tid, wave, lane, a.out, a.out, CTXR, CTXR, MX, (const float*)(ws + WS_PART), M, XN, (unsigned char*)(ws + WS_XN8), true, a.in[I_GPOSTMLP] + l * D, a.in[I_GPREMIX] + (l + 1) * D, modl, 5 * D, modl + 5 * NMOD, 0, D);
                for (int rep = 0; rep < REP_CV; ++rep) convert_weights(a, l + 1, lds, gw, NGW, wave, lane);
                __syncthreads();
                ssm_fill(a, l + 1, lds, (bid + 64) % G, G, tid);
                SEAM(pb + 11);
            } else {
                if (REP_RP > 1) row_pass<2>(lds, bid, G, tid, wave, lane, a.out, (float*)P, CTXR, CTXR, MX, (const float*)(ws + WS_PART), ML, XN, (unsigned char*)(ws + WS_XN8), false, a.in[I_GPOSTMLP] + l * D, a.in[I_GPOSTMLP] + l * D, modl, 5 * D, modl, 0, 0);
                row_pass<2>(lds, bid, G, tid, wave, lane, a.out, a.out, CTXR, CTXR, MX, (const float*)(ws + WS_PART), ML, XN, (unsigned char*)(ws + WS_XN8), false, a.in[I_GPOSTMLP] + l * D, a.in[I_GPOSTMLP] + l * D, modl, 5 * D, modl, 0, 0);
            }
        }
    }
#undef PH
#undef PHASE_ARGS
#undef SEAM
}

constexpr int N_PHASES = 2 + 12 * DEPTH;
extern "C" void kernel_launch(void* const* d_in, const int* in_sizes, int n_in, void* d_out, int out_size, void* d_ws, size_t ws_size, hipStream_t stream) {
    static int grid = 0;
    if (grid == 0) {
        if (n_in != 28 || in_sizes[0] != ML * D || out_size != ML * D || ws_size < WS_END) { fprintf(stderr, "kernel_launch: shape/workspace mismatch (n_in %d, ws %zu < %zu?)\n", n_in, ws_size, (size_t)WS_END); grid = -1; return; }
        int dev = 0, cus = 0, per_cu = 0;
        if (hipGetDevice(&dev) != hipSuccess || hipDeviceGetAttribute(&cus, hipDeviceAttributeMultiprocessorCount, dev) != hipSuccess) { grid = -1; return; }
        if (hipFuncSetAttribute((const void*)hybrid_fwd, hipFuncAttributeMaxDynamicSharedMemorySize, LDS_BYTES) != hipSuccess) { fprintf(stderr, "kernel_launch: hipFuncSetAttribute failed\n"); grid = -1; return; }
        if (hipOccupancyMaxActiveBlocksPerMultiprocessor(&per_cu, (const void*)hybrid_fwd, 512, LDS_BYTES) != hipSuccess || per_cu < 1) { fprintf(stderr, "kernel_launch: occupancy query says %d blocks per CU\n", per_cu); (void)hipGetLastError(); if (per_cu < 1) { grid = -1; return; } }
        grid = cus;
    }
    if (grid < 0) return;
    if (hipMemsetAsync((char*)d_ws + WS_CTL, 0, CTL_ZERO_BYTES, stream) != hipSuccess) return;
    Args a{};
    for (int i = 0; i < 28; ++i) a.in[i] = (const float*)d_in[i];
    a.out = (float*)d_out; a.ws = (unsigned char*)d_ws;
#if MK_PER_PHASE
    for (int p = 0; p < N_PHASES; ++p) { a.lo = p; a.hi = p + 1; hipLaunchKernelGGL(hybrid_fwd, dim3(grid), dim3(512), LDS_BYTES, stream, a); }
#else
    a.lo = 0; a.hi = N_PHASES;
    hipLaunchKernelGGL(hybrid_fwd, dim3(grid), dim3(512), LDS_BYTES, stream, a);
#endif
    const hipError_t le = hipPeekAtLastError();
    if (le != hipSuccess) fprintf(stderr, "kernel_launch: launch failed: %s\n", hipGetErrorName(le));
}
```

```cpp
#include <hip/hip_runtime.h>
#include <cstdio>
#include <cstdint>
#include <cmath>

#ifndef MK_PER_PHASE
#define MK_PER_PHASE 0
#endif
#ifndef REP_BIG
#define REP_BIG 1
#endif
#ifndef STAGGER
#define STAGGER 0
#endif
#ifndef REP_UP
#define REP_UP 0
#endif
#ifndef OVL_EXP
#define OVL_EXP 0
#endif
#ifndef REP_SCAN
#define REP_SCAN 1
#endif
#ifndef REP_PROJ
#define REP_PROJ 1
#endif
#ifndef REP_DOWN
#define REP_DOWN 1
#endif
#ifndef REP_RG
#define REP_RG 1
#endif
#ifndef REP_RP
#define REP_RP 1
#endif
#ifndef REP_CV
#define REP_CV 1
#endif
#ifndef REP_ATT
#define REP_ATT 1
#endif

#define LAS __attribute__((address_space(3)))
#define GAS __attribute__((address_space(1)))
typedef unsigned short bf16_t;
typedef short bf16x8 __attribute__((ext_vector_type(8)));
typedef short s16x4 __attribute__((ext_vector_type(4)));
typedef float f32x2 __attribute__((ext_vector_type(2)));
typedef float f32x4 __attribute__((ext_vector_type(4)));
typedef float f32x16 __attribute__((ext_vector_type(16)));
typedef unsigned u32x2 __attribute__((ext_vector_type(2)));
typedef unsigned u32x4 __attribute__((ext_vector_type(4)));
typedef GAS unsigned gu32;
typedef int v4i __attribute__((ext_vector_type(4)));
typedef int v8i __attribute__((ext_vector_type(8)));
constexpr float WG8_SCALE = 64.0f;

constexpr int D = 2048, NBATCH = 4, SEQ = 8192, CTXL = 256, DEPTH = 4;
constexpr int ML = NBATCH * SEQ, MC = NBATCH * CTXL, M = ML + MC;
constexpr int NIN = 11520, FF = 8192, NMOD = 6 * D;
constexpr int C_AB = 0, C_AC = 1024, C_AV = 2048, C_SU = 3072, C_Q = 3840, C_K = 4864, C_V = 5120, C_GC = 5376, C_GS = 7424, C_GA = 9472;
constexpr int C_O = C_AC, C_Y = C_SU;
constexpr int C_F8 = C_Q;
constexpr int SG = 48, SGR = 1280, SGV = 1056;
constexpr float NORM_EPS = 1e-6f;

constexpr size_t MiB = 1u << 20;
constexpr size_t WS_CTL = 0, CTL_ZERO_BYTES = 1 * MiB;
constexpr size_t WS_MOD = 1 * MiB;
constexpr size_t WS_ROPE = 2 * MiB;
constexpr size_t WS_ETAB = 3 * MiB;
constexpr size_t WS_BB = 10 * MiB;
constexpr size_t WS_MT = 13 * MiB;
constexpr size_t WS_CTXR = 25 * MiB;
constexpr size_t WS_WIN = 33 * MiB, WS_WCO = 78 * MiB, WS_WGLU = 82 * MiB, WS_WAO = 88 * MiB, WS_WOUT = 92 * MiB, WS_WUP = 100 * MiB, WS_WDN = 132 * MiB;
constexpr size_t WS_W1 = 164 * MiB, WS_W3 = 176 * MiB;
constexpr size_t WS_XN = 212 * MiB, WS_MX = 344 * MiB, WS_ASSM = 476 * MiB, WS_S = 566 * MiB, WS_P = 626 * MiB;
constexpr size_t WS_PART = WS_P + (size_t)M * NIN * 2 + MiB;
constexpr size_t WS_XN8 = WS_PART + (size_t)8 * MC * D * 4;
constexpr size_t WS_WG8 = WS_XN8 + (size_t)M * D;
constexpr size_t WS_K8 = WS_WG8 + (size_t)(NIN - C_Q) * D;
constexpr size_t WS_VT8 = WS_K8 + (size_t)NBATCH * 2 * (CTXL + SEQ) * 128;
constexpr size_t WS_END = WS_VT8 + (size_t)NBATCH * 2 * (CTXL + SEQ) * 128;
constexpr size_t WS_UP = WS_P;
static_assert((size_t)M * FF * 2 <= (size_t)M * NIN * 2, "UP overlay");
constexpr int CW_BAR = 4096;

constexpr int LDS_BYTES = 147456, MISC_OFF = LDS_BYTES - 256;

#define RLX_AGENT __ATOMIC_RELAXED, __HIP_MEMORY_SCOPE_AGENT
#define LDS_WAIT() asm volatile("s_waitcnt lgkmcnt(0)" ::: "memory")
__device__ __forceinline__ unsigned cvt_pk_bf16(float lo, float hi) { unsigned r; asm volatile("v_cvt_pk_bf16_f32 %0, %1, %2" : "=v"(r) : "v"(lo), "v"(hi)); return r; }
__device__ __forceinline__ float bf_lo(unsigned w) { return __uint_as_float(w << 16); }
__device__ __forceinline__ float bf_hi(unsigned w) { return __uint_as_float(w & 0xffff0000u); }
__device__ __forceinline__ float wave_sum(float v) {
#pragma unroll
    for (int o = 1; o < 64; o <<= 1) v += __shfl_xor(v, o);
    return v;
}
__device__ __forceinline__ float sigmoidf_(float x) { return __builtin_amdgcn_rcpf(1.0f + __builtin_amdgcn_exp2f(-1.4426950408889634f * x)); }
__device__ __forceinline__ unsigned gate_q4_(const f32x4 s) { unsigned w = (unsigned)(s[0] * 255.f + 0.5f); w |= (unsigned)(s[1] * 255.f + 0.5f) << 8; w |= (unsigned)(s[2] * 255.f + 0.5f) << 16; w |= (unsigned)(s[3] * 255.f + 0.5f) << 24; return w; }
__device__ __forceinline__ f32x4 gate_u4_(unsigned w) { return (f32x4){(float)(w & 255u), (float)((w >> 8) & 255u), (float)((w >> 16) & 255u), (float)(w >> 24)} * (1.0f / 255.f); }
__device__ __forceinline__ float sigmoid_pre_(float z) { return __builtin_amdgcn_rcpf(1.0f + __builtin_amdgcn_exp2f(z)); }
__device__ __forceinline__ float gelu_tanh(float x) { const float u = 0.7978845608028654f * (x + 0.044715f * x * x * x); return x * sigmoidf_(2.0f * u); }

#define XB_TMO      128
#define XB_XCNT(j)  (256  + 64 * (j))
#define XB_XSUB(j)  (1280 + 64 * (j))
#define XB_XGEN(j)  (2304 + 64 * (j))
#define XB_TOP      3328
#define XB_TOPGEN   3392
#define XCD_BAR_WORDS 3456
#define XB_SPIN_CAP (1u << 22)
__device__ __forceinline__ unsigned xb_ld(unsigned* p)              { return __hip_atomic_load(p, __ATOMIC_RELAXED, __HIP_MEMORY_SCOPE_AGENT); }
__device__ __forceinline__ unsigned xb_add(unsigned* p, unsigned v) { return __hip_atomic_fetch_add(p, v, __ATOMIC_RELAXED, __HIP_MEMORY_SCOPE_AGENT); }
__device__ __forceinline__ unsigned xb_xcc_id() { return (unsigned)__builtin_amdgcn_s_getreg((3 << 11) | 20) & 0xFu; }
#define XB_SPIN(cond, bar) do { unsigned _sp = 0; while (cond) { __builtin_amdgcn_s_sleep(1); \
    if ((++_sp & 255u) == 0u) { if (xb_ld(&(bar)[XB_TMO])) break; if (_sp > XB_SPIN_CAP) { atomicAdd(&(bar)[XB_TMO], 1u); break; } } } } while (0)
struct XcdBarrier { unsigned* bar; unsigned x; volatile LAS unsigned* st; };
__device__ __forceinline__ XcdBarrier xcd_barrier_post(unsigned* bar, volatile LAS unsigned* st) {
    XcdBarrier b; b.bar = bar; b.x = xb_xcc_id(); b.st = st;
    if (threadIdx.x == 0) (void)xb_add(&bar[XB_XCNT(b.x)], 1u);
    return b;
}
__device__ __forceinline__ void xcd_barrier_complete(unsigned* bar, unsigned x, unsigned& nloc, unsigned& nx) {
    const unsigned G = gridDim.x * gridDim.y * gridDim.z;
    unsigned sum, cnt, mine, sp = 0u;
    for (;;) {
        sum = 0u; cnt = 0u; mine = 0u;
#pragma unroll
        for (unsigned j = 0; j < 16; ++j) { const unsigned c = xb_ld(&bar[XB_XCNT(j)]); sum += c; cnt += (c > 0u) ? 1u : 0u; mine = (j == x) ? c : mine; }
        if (sum == G) break;
        __builtin_amdgcn_s_sleep(1);
        if ((++sp & 255u) == 0u) { if (xb_ld(&bar[XB_TMO])) break; if (sp > XB_SPIN_CAP) { atomicAdd(&bar[XB_TMO], 1u); break; } }
    }
    nloc = mine > 0u ? mine : 1u; nx = cnt > 0u ? cnt : 1u;
}
__device__ __forceinline__ void xcd_barrier(const XcdBarrier& b) {
    asm volatile("s_waitcnt vmcnt(0)" ::: "memory");
    __syncthreads();
    if (threadIdx.x == 0) {
        unsigned* bar = b.bar;
        __builtin_amdgcn_s_waitcnt(0);
        unsigned nloc = b.st[0], nx = b.st[1];
        if (nloc == 0u) { xcd_barrier_complete(bar, b.x, nloc, nx); b.st[0] = nloc; b.st[1] = nx; }
        const unsigned old = xb_add(&bar[XB_XSUB(b.x)], 1u);
        const unsigned gen = old / nloc;
        if (old + 1u == (gen + 1u) * nloc) {
            __builtin_amdgcn_fence(__ATOMIC_RELEASE, "agent");
            asm volatile("s_waitcnt vmcnt(0)" ::: "memory");
            const unsigned og = xb_add(&bar[XB_TOP], 1u);
            const unsigned tg = og / nx;
            if (og + 1u == (tg + 1u) * nx) xb_add(&bar[XB_TOPGEN], 1u);
            else XB_SPIN(xb_ld(&bar[XB_TOPGEN]) == tg, bar);
            __builtin_amdgcn_fence(__ATOMIC_ACQUIRE, "agent");
            xb_add(&bar[XB_XGEN(b.x)], 1u);
            asm volatile("s_waitcnt vmcnt(0)" ::: "memory");
        } else {
            XB_SPIN(xb_ld(&bar[XB_XGEN(b.x)]) == gen, bar);
            __builtin_amdgcn_fence(__ATOMIC_ACQUIRE, "agent");
            asm volatile("s_waitcnt vmcnt(0)" ::: "memory");
        }
    }
    __syncthreads();
}

namespace pg8 {
constexpr int BM = 256, BK = 64, HALF = 128, HTB = HALF * BK * 2, STAGE_BYTES = 8 * HTB, NXCD = 8, WGM = 8;
__host__ __device__ __forceinline__ int lds_byte(int r, int c) { const int st = (r >> 4) * 2 + (c >> 5), rr = r & 15, cc = c & 31, ob = rr * 64 + cc * 2; return st * 1024 + (ob ^ (((ob >> 9) & 1) << 5)); }
__host__ __device__ __forceinline__ void stage_rc(int b, int& R, int& C) { const int st = b / 1024, sb = b % 1024, swz = sb ^ (((sb >> 9) & 1) << 5); R = (st >> 1) * 16 + swz / 64; C = (st & 1) * 32 + (swz % 64) / 2; }
__host__ __device__ __forceinline__ int perm32(int rho) { const int n = rho >> 4, i = rho & 15; return 8 * (i >> 2) + 4 * n + (i & 3); }
struct Unit { int pm, pn, koff, nt, kind; };
struct Gemm { const bf16_t* A; const bf16_t* Bt; int lda, ldb, K; };
struct StaticOrder {
    int nM, nN, nwg, G, c, ntk, ibeg, iend, wgm;
    __device__ __forceinline__ void init(int M_, int N_, int K_, int G_, int c_) { nM = M_ / BM; nN = N_ / BM; nwg = nM * nN; G = G_; c = c_; ntk = K_ / BK; ibeg = 0; iend = 1 << 30; wgm = WGM; }
    __device__ __forceinline__ int stagger() const { const int rem = nwg % G; return (STAGGER && rem != 0 && c >= rem) ? ((c >> 3) & 3) * ntk * 36 : 0; }
    __device__ __forceinline__ bool next(int i, Unit& u) const {
        if (i + ibeg >= iend) return false;
        const long L = (long)(i + ibeg) * G + c; if (L >= nwg) return false;
        u.koff = 0; u.nt = ntk; u.kind = 0;
        int wgid = (int)L; { const int q = nwg / NXCD, r = nwg % NXCD, xcd = wgid % NXCD, off = wgid / NXCD; wgid = (xcd < r ? xcd * (q + 1) : r * (q + 1) + (xcd - r) * q) + off; }
        const int nig = wgm * nN, gid = wgid / nig, fm = gid * wgm, gsz = (nM - fm) < wgm ? (nM - fm) : wgm;
        u.pm = fm + ((wgid % nig) % gsz); u.pn = (wgid % nig) / gsz; return true;
    }
};
struct GroupOrder {
    int nj, nunits, G, c, ntk;
    __device__ __forceinline__ void init(int nj_, int K_, int G_, int c_) { nj = nj_; nunits = SG * 5 * nj_; G = G_; c = c_; ntk = K_ / BK; }
    __device__ __forceinline__ bool next(int i, Unit& u) const {
        const int L = i * G + c; if (L >= nunits) return false;
        u.pm = L / nj; u.pn = (u.pm / 5) * nj + (L % nj); u.koff = 0; u.nt = ntk; u.kind = 0; return true;
    }
};
struct SplitCtxOrder {
    StaticOrder so; int nlat, nN, ntk8, kq, G, c; bool ctx;
    __device__ __forceinline__ void init(int N_, int K_, int G_, int c_, bool ctx_) { so.init(ML, N_, K_, G_, c_); nN = N_ / BM; G = G_; c = c_; ctx = ctx_; kq = K_ / 8; ntk8 = K_ / (8 * BK);
        nlat = c_ < so.nwg ? (so.nwg - c_ + G_ - 1) / G_ : 0; }
    __device__ __forceinline__ bool next(int i, Unit& u) const {
        Unit a; a.pm = 0; a.pn = 0; a.koff = 0; a.nt = 0; a.kind = 0;
        const bool la = so.next(i, a);
        const int L = (i - nlat) * G + c; const bool lc = ctx && !la && L >= 0 && L < 32 * nN;
        const int ks = L & 7;
        u.pm = la ? a.pm : ML / BM + (L >> 3) / nN; u.pn = la ? a.pn : (L >> 3) % nN; u.koff = la ? 0 : ks * kq; u.nt = la ? a.nt : ntk8; u.kind = la ? 0 : 1 + ks;
        return la || lc;
    }
};

template <class Epi, class Sched, bool F8 = false>
__device__ __forceinline__ void gemm_phase(LAS unsigned char* lds, const Gemm g, const Sched& S, const Epi& E, int stag_ticks = 0) {
    int tid_ = threadIdx.x; asm volatile("" : "+v"(tid_));
    const int tid = tid_, wid = __builtin_amdgcn_readfirstlane(tid >> 6), lane = tid & 63, wr = wid >> 2, wc = wid & 3, fr = lane & 15, fq = lane >> 4;
    unsigned voffA[2], voffB[2];
#pragma unroll
    for (int i = 0; i < 2; ++i) { int R, C; stage_rc(tid * 16 + i * 8192, R, C); const int Rb = Epi::PERM ? ((R & ~31) + perm32(R & 31)) : R;
        voffA[i] = (unsigned)(R * g.lda + C) * 2u; voffB[i] = (unsigned)(Rb * g.ldb + C) * 2u; }
    const size_t kstep = (size_t)(BK * 2);
    const size_t hA = (size_t)HALF * g.lda * 2, hB = (size_t)HALF * g.ldb * 2, tA = 2 * hA, tB = 2 * hB;
    const unsigned ldsw = (unsigned)wid * 1024u;
    const int aoff = lds_byte(wr * 64 + fr, fq * 8), boff = lds_byte(wc * 32 + fr, fq * 8);
#define PG8_SA(b, h) (((b) * 2 + (h)) * HTB)
#define PG8_SB(b, h) ((4 + (b) * 2 + (h)) * HTB)
#define PG8_STAGE(bufoff, gbase, voff) do { _Pragma("unroll") for (int _i = 0; _i < 2; ++_i) \
        __builtin_amdgcn_global_load_lds((const unsigned*)((const char*)(gbase) + (voff)[_i]), (LAS unsigned*)(lds + (bufoff) + ldsw + _i * 8192), 16, 0, 0); } while (0)
#define PG8_LDA(dst, b, h) do { _Pragma("unroll") for (int m = 0; m < 4; ++m) _Pragma("unroll") for (int k = 0; k < 2; ++k) dst[m][k] = *(const LAS bf16x8*)(lds + PG8_SA(b, h) + aoff + m * 2048 + k * 1024); } while (0)
#define PG8_LDB(dst, b, h) do { _Pragma("unroll") for (int n = 0; n < 2; ++n) _Pragma("unroll") for (int k = 0; k < 2; ++k) dst[n][k] = *(const LAS bf16x8*)(lds + PG8_SB(b, h) + boff + n * 2048 + k * 1024); } while (0)
#define PG8_MMA(ai, bj, At, Bt) do { __builtin_amdgcn_s_setprio(1); _Pragma("unroll") for (int m = 0; m < 4; ++m) _Pragma("unroll") for (int n = 0; n < 2; ++n) { \
        if constexpr (F8) { const v8i a8_ = __builtin_shufflevector(__builtin_bit_cast(v4i, At[m][0]), __builtin_bit_cast(v4i, At[m][1]), 0, 1, 2, 3, 4, 5, 6, 7); \
                            const v8i b8_ = __builtin_shufflevector(__builtin_bit_cast(v4i, Bt[n][0]), __builtin_bit_cast(v4i, Bt[n][1]), 0, 1, 2, 3, 4, 5, 6, 7); \
                            asm("s_nop 1\n\tv_mfma_scale_f32_16x16x128_f8f6f4 %0, %1, %2, %0, %3, %3 op_sel_hi:[0,0,0]" : "+v"(acc[ai][bj][m][n]) : "v"(b8_), "v"(a8_), "v"(f8_scale_)); } \
        else { _Pragma("unroll") for (int k = 0; k < 2; ++k) acc[ai][bj][m][n] = __builtin_amdgcn_mfma_f32_16x16x32_bf16(Bt[n][k], At[m][k], acc[ai][bj][m][n], 0, 0, 0); } } \
        __builtin_amdgcn_s_setprio(0); } while (0)
#define PG8_WAIT_V(n) asm volatile("s_waitcnt vmcnt(" #n ")" ::: "memory")
#define PG8_WAIT_L(n) asm volatile("s_waitcnt lgkmcnt(" #n ")" ::: "memory")
#define PG8_BAR __builtin_amdgcn_s_barrier()
#define PG8_SCHED __builtin_amdgcn_sched_barrier(0)
    const int f8_scale_ = 0x7f7f7f7f; (void)f8_scale_;
    Unit cur, nxt; int ui = 0;
    if (!S.next(0, cur)) return;
    if (stag_ticks > 0) {
        const unsigned long long t0 = __builtin_amdgcn_s_memrealtime(); while (__builtin_amdgcn_s_memrealtime() - t0 < (unsigned long long)stag_ticks) __builtin_amdgcn_s_sleep(16); }
    f32x4 acc[2][2][4][2];
#pragma unroll
    for (int a = 0; a < 2; ++a)
#pragma unroll
        for (int b = 0; b < 2; ++b)
#pragma unroll
            for (int m = 0; m < 4; ++m)
#pragma unroll
                for (int n = 0; n < 2; ++n) acc[a][b][m][n] = (f32x4){0.f, 0.f, 0.f, 0.f};
    bf16x8 At[4][2], B0[2][2], B1[2][2];
    const char* cA = (const char*)g.A + (size_t)cur.pm * tA + (size_t)cur.koff * 2; const char* cB = (const char*)g.Bt + (size_t)cur.pn * tB + (size_t)cur.koff * 2;
    PG8_STAGE(PG8_SB(0, 0), cB, voffB); PG8_STAGE(PG8_SB(0, 1), cB + hB, voffB); PG8_STAGE(PG8_SA(0, 0), cA, voffA); PG8_STAGE(PG8_SA(0, 1), cA + hA, voffA);
    if (wr == 1) PG8_BAR;
    PG8_WAIT_V(2); PG8_BAR;
    PG8_STAGE(PG8_SB(1, 0), cB + kstep, voffB); PG8_STAGE(PG8_SA(1, 0), cA + kstep, voffA); PG8_STAGE(PG8_SB(1, 1), cB + hB + kstep, voffB);
    PG8_WAIT_V(6); PG8_BAR;
    for (;;) {
        const bool has_next = S.next(ui + 1, nxt);
        const char* nA = has_next ? (const char*)g.A + (size_t)nxt.pm * tA + (size_t)nxt.koff * 2 : cA; const char* nB = has_next ? (const char*)g.Bt + (size_t)nxt.pn * tB + (size_t)nxt.koff * 2 : cB;
        const int nt = cur.nt;
        for (int t = 0; t < nt; t += 2) {
            const bool last = (t == nt - 2);
            const char* a1 = cA + (size_t)(t + 1) * kstep;
            const char* a2 = last ? nA : cA + (size_t)(t + 2) * kstep; const char* b2 = last ? nB : cB + (size_t)(t + 2) * kstep;
            const char* a3 = a2 + kstep; const char* b3 = b2 + kstep;
            PG8_LDB(B0, 0, 0); PG8_LDB(B1, 0, 1); PG8_SCHED; PG8_LDA(At, 0, 0); PG8_STAGE(PG8_SA(1, 1), a1 + hA, voffA);
            PG8_WAIT_V(8); PG8_WAIT_L(0); PG8_BAR; PG8_MMA(0, 0, At, B0); PG8_MMA(0, 1, At, B1); PG8_BAR; PG8_SCHED;
            PG8_LDA(At, 0, 1); PG8_STAGE(PG8_SB(0, 0), b2, voffB); PG8_STAGE(PG8_SB(0, 1), b2 + hB, voffB); PG8_STAGE(PG8_SA(0, 0), a2, voffA);
            PG8_WAIT_V(8); PG8_WAIT_L(0); PG8_BAR; PG8_MMA(1, 0, At, B0); PG8_MMA(1, 1, At, B1); PG8_BAR; PG8_SCHED;
            PG8_LDB(B0, 1, 0); PG8_LDB(B1, 1, 1); PG8_SCHED; PG8_LDA(At, 1, 0); PG8_STAGE(PG8_SA(0, 1), a2 + hA, voffA);
            PG8_WAIT_V(8); PG8_WAIT_L(0); PG8_BAR; PG8_MMA(0, 0, At, B0); PG8_MMA(0, 1, At, B1); PG8_BAR; PG8_SCHED;
            PG8_LDA(At, 1, 1); PG8_STAGE(PG8_SB(1, 0), b3, voffB); PG8_STAGE(PG8_SB(1, 1), b3 + hB, voffB); PG8_STAGE(PG8_SA(1, 0), a3, voffA);
            PG8_WAIT_V(8); PG8_WAIT_L(0); PG8_BAR; PG8_MMA(1, 0, At, B0); PG8_MMA(1, 1, At, B1); PG8_BAR; PG8_SCHED;
        }
        if (wr == 0) PG8_BAR;
        if constexpr (F8) asm volatile("s_nop 15\n\ts_nop 15" : "+v"(acc[1][1][3][1]), "+v"(acc[1][0][3][1]));
        E(acc, cur, wr, wc, fr, fq);
        if (!has_next) break;
#pragma unroll
        for (int a = 0; a < 2; ++a)
#pragma unroll
            for (int b = 0; b < 2; ++b)
#pragma unroll
                for (int m = 0; m < 4; ++m)
#pragma unroll
                    for (int n = 0; n < 2; ++n) acc[a][b][m][n] = (f32x4){0.f, 0.f, 0.f, 0.f};
        cur = nxt; cA = nA; cB = nB; ++ui;
        if (wr == 1) PG8_BAR;
    }
    PG8_WAIT_V(0);
    PG8_BAR;
#undef PG8_SA
#undef PG8_SB
#undef PG8_STAGE
#undef PG8_LDA
#undef PG8_LDB
#undef PG8_MMA
#undef PG8_WAIT_V
#undef PG8_WAIT_L
#undef PG8_BAR
#undef PG8_SCHED
}

typedef const f32x4 (&AccRef)[2][2][4][2];
__device__ __forceinline__ u32x4 pack8(const f32x4 v0, const f32x4 v1) { u32x4 w; w.x = cvt_pk_bf16(v0[0], v0[1]); w.y = cvt_pk_bf16(v0[2], v0[3]); w.z = cvt_pk_bf16(v1[0], v1[1]); w.w = cvt_pk_bf16(v1[2], v1[3]); return w; }
__device__ __forceinline__ void unpack8(const u32x4 w, f32x4& v0, f32x4& v1) { v0 = (f32x4){bf_lo(w.x), bf_hi(w.x), bf_lo(w.y), bf_hi(w.y)}; v1 = (f32x4){bf_lo(w.z), bf_hi(w.z), bf_lo(w.w), bf_hi(w.w)}; }

template <int ACT> struct EpiBf16 {
    static constexpr bool PERM = true;
    bf16_t* O; int ldc; int skip_below;
    __device__ __forceinline__ void operator()(AccRef acc, const Unit& u, int wr, int wc, int fr, int fq) const {
        const int row0 = u.pm * BM + wr * 64 + fr, col0 = u.pn * BM + wc * 32 + 8 * fq;
        if (u.pm < skip_below) return;
#pragma unroll
        for (int ai = 0; ai < 2; ++ai)
#pragma unroll
            for (int m = 0; m < 4; ++m) { bf16_t* rowp = O + (size_t)(row0 + ai * HALF + m * 16) * ldc + col0;
#pragma unroll
                for (int bj = 0; bj < 2; ++bj) { f32x4 v0 = acc[ai][bj][m][0], v1 = acc[ai][bj][m][1];
                    if (ACT == 1) {
#pragma unroll
                        for (int e = 0; e < 4; ++e) { const float a = fmaxf(v0[e], 0.f), b = fmaxf(v1[e], 0.f); v0[e] = a * a; v1[e] = b * b; } }
                    *(u32x4*)(rowp + bj * HALF) = pack8(v0, v1); } }
    }
};
struct EpiBf16Part {
    static constexpr bool PERM = true;
    bf16_t* O; float* PART;
    __device__ __forceinline__ void operator()(AccRef acc, const Unit& u, int wr, int wc, int fr, int fq) const {
        const int row0 = u.pm * BM + wr * 64 + fr, col0 = u.pn * BM + wc * 32 + 8 * fq;
        if (u.kind == 0) {
#pragma unroll
            for (int ai = 0; ai < 2; ++ai)
#pragma unroll
                for (int m = 0; m < 4; ++m) { bf16_t* rowp = O + (size_t)(row0 + ai * HALF + m * 16) * D + col0;
#pragma unroll
                    for (int bj = 0; bj < 2; ++bj) *(u32x4*)(rowp + bj * HALF) = pack8(acc[ai][bj][m][0], acc[ai][bj][m][1]); }
        } else {
            float* pb = PART + (size_t)(u.kind - 1) * MC * D;
#pragma unroll
            for (int ai = 0; ai < 2; ++ai)
#pragma unroll
                for (int m = 0; m < 4; ++m) { float* rowp = pb + (size_t)(row0 - ML + ai * HALF + m * 16) * D + col0;
#pragma unroll
                    for (int bj = 0; bj < 2; ++bj) { *(f32x4*)(rowp + bj * HALF) = acc[ai][bj][m][0]; *(f32x4*)(rowp + bj * HALF + 4) = acc[ai][bj][m][1]; } }
        }
    }
};
struct EpiProj {
    static constexpr bool PERM = true;
    bf16_t* P; bf16_t* Assm;
    __device__ __forceinline__ void operator()(AccRef acc, const Unit& u, int wr, int wc, int fr, int fq) const {
        const int row0 = u.pm * BM + wr * 64 + fr, col0 = u.pn * BM + wc * 32 + 8 * fq;
        if (u.pn >= 4 && u.pn < 12) {
            const int c = C_AC + (u.pn - 4) * HALF + wc * 32 + 8 * fq;
#pragma unroll
            for (int ai = 0; ai < 2; ++ai)
#pragma unroll
                for (int m = 0; m < 4; ++m) *(u32x4*)(P + (size_t)(row0 + ai * HALF + m * 16) * NIN + c) = pack8(acc[ai][0][m][0] * acc[ai][1][m][0], acc[ai][0][m][1] * acc[ai][1][m][1]);
        } else if (u.pn >= 12 && u.pn < 15) {
#pragma unroll
            for (int ai = 0; ai < 2; ++ai)
#pragma unroll
                for (int m = 0; m < 4; ++m) { const int r = row0 + ai * HALF + m * 16;
#pragma unroll
                    for (int bj = 0; bj < 2; ++bj) { const int c = col0 + bj * HALF - C_SU, gq = c >> 4, p0 = c & 15;
                        bf16_t* dst = Assm + ((size_t)(gq * SGR + (r >> 5)) * 768 + (r & 31) * 16 + p0);
                        *(u32x4*)dst = pack8(acc[ai][bj][m][0], acc[ai][bj][m][1]); } }
        } else {
#pragma unroll
            for (int ai = 0; ai < 2; ++ai)
#pragma unroll
                for (int m = 0; m < 4; ++m) { bf16_t* rowp = P + (size_t)(row0 + ai * HALF + m * 16) * NIN + col0;
#pragma unroll
                    for (int bj = 0; bj < 2; ++bj) *(u32x4*)(rowp + bj * HALF) = pack8(acc[ai][bj][m][0], acc[ai][bj][m][1]); }
        }
    }
};
struct EpiGate {
    static constexpr bool PERM = true;
    bf16_t* P;
    __device__ __forceinline__ void operator()(AccRef acc, const Unit& u, int wr, int wc, int fr, int fq) const {
        const int row0 = u.pm * BM + wr * 64 + fr, col0 = C_F8 + u.pn * BM + wc * 32 + 8 * fq;
        const bool isgate = col0 >= C_GC; const float sc = isgate ? -1.4426950408889634f / WG8_SCALE : 1.0f / WG8_SCALE;
#pragma unroll
        for (int ai = 0; ai < 2; ++ai)
#pragma unroll
            for (int m = 0; m < 4; ++m) { bf16_t* rowp = P + (size_t)(row0 + ai * HALF + m * 16) * NIN + col0;
#pragma unroll
                for (int bj = 0; bj < 2; ++bj) { f32x4 v0 = acc[ai][bj][m][0] * sc, v1 = acc[ai][bj][m][1] * sc;
                    if (isgate) {
#pragma unroll
                        for (int e = 0; e < 4; ++e) { v0[e] = sigmoid_pre_(v0[e]); v1[e] = sigmoid_pre_(v1[e]); }
                        *(u32x2*)((unsigned char*)(P + (size_t)(row0 + ai * HALF + m * 16) * NIN + C_GC) + (col0 + bj * HALF - C_GC)) = (u32x2){gate_q4_(v0), gate_q4_(v1)}; }
                    else *(u32x4*)(rowp + bj * HALF) = pack8(v0, v1); } }
    }
};
struct EpiState {
    static constexpr bool PERM = false;
    float* S;
    __device__ __forceinline__ void operator()(AccRef acc, const Unit& u, int wr, int wc, int fr, int fq) const {
        const int row0 = u.pm * BM + wr * 64 + fr, col0 = wc * 32 + 4 * fq;
#pragma unroll
        for (int ai = 0; ai < 2; ++ai)
#pragma unroll
            for (int m = 0; m < 4; ++m) { float* rowp = S + (size_t)(row0 + ai * HALF + m * 16) * 256 + col0;
#pragma unroll
                for (int bj = 0; bj < 2; ++bj)
#pragma unroll
                    for (int n = 0; n < 2; ++n) *(f32x4*)(rowp + bj * HALF + n * 16) = acc[ai][bj][m][n]; }
    }
};
struct EpiSsmY {
    static constexpr bool PERM = true;
    bf16_t* P;
    __device__ __forceinline__ void operator()(AccRef acc, const Unit& u, int wr, int wc, int fr, int fq) const {
        const int gq = u.pm / 5, rl0 = (u.pm % 5) * BM + wr * 64 + fr, cl0 = (u.pn & 1) * BM + wc * 32 + 8 * fq;
#pragma unroll
        for (int ai = 0; ai < 2; ++ai)
#pragma unroll
            for (int m = 0; m < 4; ++m) { const int rl = rl0 + ai * HALF + m * 16;
                if (rl < SGV) {
#pragma unroll
                    for (int bj = 0; bj < 2; ++bj) { const int cl = cl0 + bj * HALF, t = cl >> 4, p0 = cl & 15;
                        f32x4 v0 = acc[ai][bj][m][0], v1 = acc[ai][bj][m][1];
#pragma unroll
                        for (int e = 0; e < 4; ++e) { v0[e] = gelu_tanh(v0[e]); v1[e] = gelu_tanh(v1[e]); }
                        *(u32x4*)(P + (size_t)(rl * 32 + t) * NIN + C_Y + gq * 16 + p0) = pack8(v0, v1); } } }
    }
};
template <bool ACCUM> struct EpiMerge {
    static constexpr bool PERM = true;
    bf16_t* Mg; const bf16_t* P; int gcol;
    __device__ __forceinline__ void operator()(AccRef acc, const Unit& u, int wr, int wc, int fr, int fq) const {
        const int row0 = u.pm * BM + wr * 64 + fr, col0 = u.pn * BM + wc * 32 + 8 * fq;
#pragma unroll
        for (int ai = 0; ai < 2; ++ai) {
            u32x2 gq[4][2]; u32x4 oq[4][2];
#pragma unroll
            for (int m = 0; m < 4; ++m) { const size_t r = (size_t)(row0 + ai * HALF + m * 16);
#pragma unroll
                for (int bj = 0; bj < 2; ++bj) { const int c = col0 + bj * HALF;
                    gq[m][bj] = *(const u32x2*)((const unsigned char*)(P + r * NIN + C_GC) + (gcol - C_GC) + c);
                    if (ACCUM) oq[m][bj] = *(const u32x4*)(Mg + r * D + c); } }
#pragma unroll
            for (int m = 0; m < 4; ++m) { const size_t r = (size_t)(row0 + ai * HALF + m * 16);
#pragma unroll
                for (int bj = 0; bj < 2; ++bj) { const int c = col0 + bj * HALF;
                    const f32x4 g0 = gate_u4_(gq[m][bj].x), g1 = gate_u4_(gq[m][bj].y);
                    f32x4 v0 = acc[ai][bj][m][0] * g0, v1 = acc[ai][bj][m][1] * g1;
                    if (ACCUM) { f32x4 o0, o1; unpack8(oq[m][bj], o0, o1); v0 += o0; v1 += o1; }
                    *(u32x4*)(Mg + r * D + c) = pack8(v0, v1); } }
        }
    }
};
struct EpiGlu {
    static constexpr bool PERM = true;
    bf16_t* Mg; const bf16_t* P;
    __device__ __forceinline__ void operator()(AccRef acc, const Unit& u, int wr, int wc, int fr, int fq) const {
        const int row0 = u.pm * BM + wr * 64 + fr, c = u.pn * HALF + wc * 32 + 8 * fq;
        u32x2 gq[2][4]; u32x4 oq[2][4];
#pragma unroll
        for (int ai = 0; ai < 2; ++ai)
#pragma unroll
            for (int m = 0; m < 4; ++m) { const size_t r = (size_t)(row0 + ai * HALF + m * 16); gq[ai][m] = *(const u32x2*)((const unsigned char*)(P + r * NIN + C_GC) + (C_GS - C_GC) + c); oq[ai][m] = *(const u32x4*)(Mg + r * D + c); }
#pragma unroll
        for (int ai = 0; ai < 2; ++ai)
#pragma unroll
            for (int m = 0; m < 4; ++m) { const size_t r = (size_t)(row0 + ai * HALF + m * 16);
                const f32x4 g0 = gate_u4_(gq[ai][m].x), g1 = gate_u4_(gq[ai][m].y);
                f32x4 o0, o1; unpack8(oq[ai][m], o0, o1);
                f32x4 a0 = acc[ai][0][m][0], a1 = acc[ai][0][m][1]; const f32x4 s0 = acc[ai][1][m][0], s1 = acc[ai][1][m][1];
#pragma unroll
                for (int e = 0; e < 4; ++e) { a0[e] = o0[e] + g0[e] * a0[e] * sigmoidf_(s0[e]); a1[e] = o1[e] + g1[e] * a1[e] * sigmoidf_(s1[e]); }
                *(u32x4*)(Mg + r * D + c) = pack8(a0, a1); }
    }
};
}

namespace attn {
constexpr int DH = 128, NW = 8, QBLK = 32, KVBLK = 64;
constexpr float SCALE = 0.088388347648318440f;
constexpr float THR = 8.f;
constexpr size_t SHM_V = KVBLK * DH * 2, SHM_K = KVBLK * DH * 2, SHM_ATTN = 2 * SHM_V + 2 * SHM_K + NW * 64 * 4;
#define KSWZ(row, colB) ((row) * 256 + ((colB) ^ (((row) & 7) << 4)))
#define SBAR() __builtin_amdgcn_sched_barrier(0)
__device__ __forceinline__ int crow(int r, int hi) { return (r & 3) + 8 * (r >> 2) + 4 * hi; }
__device__ __forceinline__ void partialSM(f32x16& p0, f32x16& p1, float& m_reg, float& mn, float& alpha) {
  constexpr float C = SCALE * 1.4426950408889634f;
  float pmax = p0[0];
#pragma unroll
  for (int r = 1; r < 16; ++r) pmax = fmaxf(pmax, p0[r]);
#pragma unroll
  for (int r = 0; r < 16; ++r) pmax = fmaxf(pmax, p1[r]);
  { auto rr = __builtin_amdgcn_permlane32_swap(__float_as_uint(pmax), __float_as_uint(pmax), false, false);
    pmax = fmaxf(__uint_as_float(rr[0]), __uint_as_float(rr[1])); }
  if (__builtin_expect(__all(pmax - m_reg <= THR / SCALE), 1)) { mn = m_reg; alpha = 1.f; }
  else { mn = fmaxf(m_reg, pmax); alpha = __builtin_amdgcn_exp2f((m_reg - mn) * C); m_reg = mn; }
  float mnC = -mn * C;
#pragma unroll
  for (int r = 0; r < 16; ++r) p0[r] = fmaf(p0[r], C, mnC);
#pragma unroll
  for (int r = 0; r < 16; ++r) p1[r] = fmaf(p1[r], C, mnC);
#pragma unroll
  for (int r = 0; r < 16; ++r) p0[r] = __builtin_amdgcn_exp2f(p0[r]);
}
__device__ __forceinline__ void finishSM(f32x16& p0, f32x16& p1, float alpha, float& l_reg, bf16x8& pa0, bf16x8& pa1, bf16x8& pa2, bf16x8& pa3) {
#pragma unroll
  for (int r = 0; r < 16; ++r) p1[r] = __builtin_amdgcn_exp2f(p1[r]);
  float ps = 0;
#pragma unroll
  for (int r = 0; r < 16; ++r) ps += p0[r];
#pragma unroll
  for (int r = 0; r < 16; ++r) ps += p1[r];
  { auto rr = __builtin_amdgcn_permlane32_swap(__float_as_uint(ps), __float_as_uint(ps), false, false);
    ps = __uint_as_float(rr[0]) + __uint_as_float(rr[1]); }
  l_reg = l_reg * alpha + ps;
#define PK4(P, BASE, OUT) do { unsigned a0 = cvt_pk_bf16(P[BASE + 0], P[BASE + 1]), a1 = cvt_pk_bf16(P[BASE + 2], P[BASE + 3]);   \
    unsigned b0 = cvt_pk_bf16(P[BASE + 4], P[BASE + 5]), b1 = cvt_pk_bf16(P[BASE + 6], P[BASE + 7]);                              \
    auto r0 = __builtin_amdgcn_permlane32_swap(a0, b0, false, false); auto r1 = __builtin_amdgcn_permlane32_swap(a1, b1, false, false); \
    u32x4 w = {r0[0], r1[0], r0[1], r1[1]}; OUT = *reinterpret_cast<bf16x8*>(&w); } while (0)
  PK4(p0, 0, pa0); PK4(p0, 8, pa1); PK4(p1, 0, pa2); PK4(p1, 8, pa3);
#undef PK4
}
__device__ __forceinline__ void qkt(f32x16& p0, f32x16& p1, const char* Ks, const bf16x8* qr, int r32, int hi) {
  p0 = f32x16{}; p1 = f32x16{};
#pragma unroll
  for (int d0 = 0; d0 < 8; ++d0) { int cb = (d0 * 16 + hi * 8) * 2;
    bf16x8 b0 = *reinterpret_cast<const bf16x8*>(Ks + KSWZ(r32, cb));
    bf16x8 b1 = *reinterpret_cast<const bf16x8*>(Ks + KSWZ(32 + r32, cb));
    p0 = __builtin_amdgcn_mfma_f32_32x32x16_bf16(b0, qr[d0], p0, 0, 0, 0);
    p1 = __builtin_amdgcn_mfma_f32_32x32x16_bf16(b1, qr[d0], p1, 0, 0, 0); }
}
__device__ __forceinline__ int v_st(int k, int c) { const int kk = (k & ~0xC) | ((k & 4) << 1) | ((k & 8) >> 1); return ((kk >> 3) * 4 + (c >> 5)) * 512 + ((kk & 7) * 32 + (c & 31)) * 2; }
__device__ __forceinline__ int v_rd_base(int lane) { return ((lane & 3) << 3) | (((lane >> 2) & 3) << 6) | (((lane >> 4) & 1) << 5) | (((lane >> 5) & 1) << 8); }
constexpr int v_rd_off(int d0, int ks, int half) { return d0 * 512 + ks * 4096 + half * 2048; }
template <int OFF> __device__ __forceinline__ s16x4 tr_read(int vb) {
  s16x4 r; asm volatile("ds_read_b64_tr_b16 %0, %1 offset:%2" : "=&v"(r) : "v"(vb), "i"(OFF) : "memory"); return r;
}
template <int D0> __device__ __forceinline__ void pv_one(f32x16& od, int vb, bf16x8 pa0, bf16x8 pa1, bf16x8 pa2, bf16x8 pa3) {
  const s16x4 l0 = tr_read<v_rd_off(D0, 0, 0)>(vb), h0 = tr_read<v_rd_off(D0, 0, 1)>(vb), l1 = tr_read<v_rd_off(D0, 1, 0)>(vb), h1 = tr_read<v_rd_off(D0, 1, 1)>(vb);
  const s16x4 l2 = tr_read<v_rd_off(D0, 2, 0)>(vb), h2 = tr_read<v_rd_off(D0, 2, 1)>(vb), l3 = tr_read<v_rd_off(D0, 3, 0)>(vb), h3 = tr_read<v_rd_off(D0, 3, 1)>(vb);
  asm volatile("s_waitcnt lgkmcnt(0)" ::: "memory"); SBAR();
#define PK(L, H) (bf16x8){L[0], L[1], L[2], L[3], H[0], H[1], H[2], H[3]}
  od = __builtin_amdgcn_mfma_f32_32x32x16_bf16(pa0, PK(l0, h0), od, 0, 0, 0);
  od = __builtin_amdgcn_mfma_f32_32x32x16_bf16(pa1, PK(l1, h1), od, 0, 0, 0);
  od = __builtin_amdgcn_mfma_f32_32x32x16_bf16(pa2, PK(l2, h2), od, 0, 0, 0);
  od = __builtin_amdgcn_mfma_f32_32x32x16_bf16(pa3, PK(l3, h3), od, 0, 0, 0);
#undef PK
}
__device__ __forceinline__ void pv_d0(f32x16* o, int vb, bf16x8 pa0, bf16x8 pa1, bf16x8 pa2, bf16x8 pa3) {
  pv_one<0>(o[0], vb, pa0, pa1, pa2, pa3); pv_one<1>(o[1], vb, pa0, pa1, pa2, pa3); pv_one<2>(o[2], vb, pa0, pa1, pa2, pa3); pv_one<3>(o[3], vb, pa0, pa1, pa2, pa3);
}
__device__ __forceinline__ void attn_unit(const bf16_t* __restrict__ Qb, const bf16_t* __restrict__ Kc, const bf16_t* __restrict__ Kl, bf16_t* __restrict__ Ob, int nkc, int seq, char* lds,
                                          const float* __restrict__ qg, const float* __restrict__ rope, int t0) {
  int tid_ = threadIdx.x; asm volatile("" : "+v"(tid_));
  const int tid = tid_, wid = tid >> 6, lane = tid & 63, r32 = lane & 31, hi = lane >> 5;
  char* V_lds = lds; char* K_lds = lds + 2 * SHM_V;
  float* ws = (float*)(lds + 2 * SHM_V + 2 * SHM_K) + wid * 64; float* li_l = ws; float* al_l = ws + 32;
  float m_reg = -1e30f, l_reg = 0; f32x16 o[4] = {}; bf16x8 qr[8];
  const bf16_t* Qw = Qb + (long)(wid * QBLK + r32) * NIN + hi * 8;
  {
    float qf[8][8]; float ss = 0.f;
#pragma unroll
    for (int d0 = 0; d0 < 8; ++d0) { const u32x4 w = *reinterpret_cast<const u32x4*>(Qw + d0 * 16);
      qf[d0][0] = bf_lo(w.x); qf[d0][1] = bf_hi(w.x); qf[d0][2] = bf_lo(w.y); qf[d0][3] = bf_hi(w.y); qf[d0][4] = bf_lo(w.z); qf[d0][5] = bf_hi(w.z); qf[d0][6] = bf_lo(w.w); qf[d0][7] = bf_hi(w.w);
#pragma unroll
      for (int j = 0; j < 8; ++j) ss += qf[d0][j] * qf[d0][j]; }
    ss += __shfl_xor(ss, 32);
    const float rstd = rsqrtf(ss * (1.f / 128.f) + NORM_EPS);
#pragma unroll
    for (int d0 = 0; d0 < 8; ++d0) { const f32x4 g0 = *reinterpret_cast<const f32x4*>(qg + d0 * 16 + hi * 8), g1 = *reinterpret_cast<const f32x4*>(qg + d0 * 16 + hi * 8 + 4);
#pragma unroll
      for (int j = 0; j < 4; ++j) { qf[d0][j] *= rstd * g0[j]; qf[d0][4 + j] *= rstd * g1[j]; } }
    if (t0 >= 0) {
      const int t = t0 + wid * QBLK + r32;
#pragma unroll
      for (int hf = 0; hf < 2; ++hf) { const int pos = hf == 0 ? (t >> 6) : (t & 63);
#pragma unroll
        for (int q1 = 0; q1 < 2; ++q1) { const float* rp = rope + pos * 32 + 16 * q1 + 8 * hi;
          const f32x4 c0 = *reinterpret_cast<const f32x4*>(rp), c1 = *reinterpret_cast<const f32x4*>(rp + 4), s0 = *reinterpret_cast<const f32x4*>(rp + 4096), s1 = *reinterpret_cast<const f32x4*>(rp + 4100);
          const int da = 4 * hf + q1, db = da + 2;
#pragma unroll
          for (int j = 0; j < 8; ++j) { const float cs = j < 4 ? c0[j] : c1[j - 4], sn = j < 4 ? s0[j] : s1[j - 4]; const float x1 = qf[da][j], x2 = qf[db][j];
            qf[da][j] = x1 * cs - x2 * sn; qf[db][j] = x2 * cs + x1 * sn; } } }
    }
#pragma unroll
    for (int d0 = 0; d0 < 8; ++d0) { u32x4 w; w.x = cvt_pk_bf16(qf[d0][0], qf[d0][1]); w.y = cvt_pk_bf16(qf[d0][2], qf[d0][3]); w.z = cvt_pk_bf16(qf[d0][4], qf[d0][5]); w.w = cvt_pk_bf16(qf[d0][6], qf[d0][7]);
      qr[d0] = *reinterpret_cast<bf16x8*>(&w); }
  }
  const int sr = tid >> 4, sc = (tid & 15) * 8, vst0 = v_st(sr, sc), vst1 = v_st(32 + sr, sc);
  const int vb0 = (int)(uintptr_t)V_lds + v_rd_base(lane);
  struct { bf16x8 vs0, vs1, ks0, ks1; } sr_[2];
#define KROWP(k0) (((k0) < nkc) ? (Kc + (long)(k0) * NIN) : (Kl + (long)((k0) - nkc) * NIN))
#define SLOAD(i, k0) do { const bf16_t* kb_ = KROWP(k0) + (long)sr * NIN + sc; \
    sr_[i].vs0 = *reinterpret_cast<const bf16x8*>(kb_ + 256); sr_[i].vs1 = *reinterpret_cast<const bf16x8*>(kb_ + 32L * NIN + 256); \
    sr_[i].ks0 = *reinterpret_cast<const bf16x8*>(kb_); sr_[i].ks1 = *reinterpret_cast<const bf16x8*>(kb_ + 32L * NIN); } while (0)
#define SWRITE(b, i) do { *(bf16x8*)(V_lds + (b) * SHM_V + vst0) = sr_[i].vs0;          \
    *(bf16x8*)(V_lds + (b) * SHM_V + vst1) = sr_[i].vs1; int kc = sc * 2;               \
    *(bf16x8*)(K_lds + (b) * SHM_K + KSWZ(sr, kc)) = sr_[i].ks0;                       \
    *(bf16x8*)(K_lds + (b) * SHM_K + KSWZ(32 + sr, kc)) = sr_[i].ks1; } while (0)
#define SWAIT() asm volatile("s_waitcnt vmcnt(4)" ::: "memory")
#define RESC(a) do { if (__any((a) < 1.f)) { if (hi == 0) al_l[r32] = (a); asm volatile("s_waitcnt lgkmcnt(0)" ::: "memory"); \
    _Pragma("unroll") for (int d = 0; d < 4; ++d) _Pragma("unroll") for (int r = 0; r < 16; ++r) o[d][r] *= al_l[crow(r, hi)]; } } while (0)
  f32x16 pA0, pA1, pB0, pB1; float mnA, mnB, alA, alB; bf16x8 pa0, pa1, pa2, pa3; const int NT = seq / KVBLK;
  constexpr int SE = 0, SO = 1;
  SLOAD(SE, 0); asm volatile("s_waitcnt vmcnt(0)" ::: "memory"); SWRITE(0, SE); __syncthreads();
  qkt(pA0, pA1, K_lds, qr, r32, hi); partialSM(pA0, pA1, m_reg, mnA, alA);
  SLOAD(SO, KVBLK); if (2 < NT) SLOAD(SE, 2 * KVBLK);
  SWAIT(); SWRITE(1, SO); __syncthreads();
  for (int j = 1; j + 1 < NT; j += 2) {
    SBAR(); qkt(pB0, pB1, K_lds + SHM_K, qr, r32, hi);
    finishSM(pA0, pA1, alA, l_reg, pa0, pa1, pa2, pa3); SBAR();
    SLOAD(SO, (j + 2) * KVBLK); SBAR();
    pv_d0(o, vb0, pa0, pa1, pa2, pa3); partialSM(pB0, pB1, m_reg, mnB, alB);
    __syncthreads(); SWAIT(); SWRITE(0, SE);
    RESC(alB); __syncthreads();
    SBAR(); qkt(pA0, pA1, K_lds, qr, r32, hi);
    finishSM(pB0, pB1, alB, l_reg, pa0, pa1, pa2, pa3); SBAR();
    if (j + 3 < NT) SLOAD(SE, (j + 3) * KVBLK); SBAR();
    pv_d0(o, vb0 + (int)SHM_V, pa0, pa1, pa2, pa3); partialSM(pA0, pA1, m_reg, mnA, alA);
    __syncthreads(); SWAIT(); SWRITE(1, SO);
    RESC(alA); __syncthreads();
  }
  SBAR(); qkt(pB0, pB1, K_lds + SHM_K, qr, r32, hi);
  finishSM(pA0, pA1, alA, l_reg, pa0, pa1, pa2, pa3); SBAR();
  pv_d0(o, vb0, pa0, pa1, pa2, pa3); partialSM(pB0, pB1, m_reg, mnB, alB);
  __syncthreads(); RESC(alB);
  finishSM(pB0, pB1, alB, l_reg, pa0, pa1, pa2, pa3); SBAR();
  pv_d0(o, vb0 + (int)SHM_V, pa0, pa1, pa2, pa3);
  if (hi == 0) li_l[r32] = l_reg; asm volatile("s_waitcnt lgkmcnt(0)" ::: "memory");
  float rli[16];
#pragma unroll
  for (int r = 0; r < 16; ++r) rli[r] = __builtin_amdgcn_rcpf(li_l[crow(r, hi)]);
  bf16_t* Ow = Ob + (long)(wid * QBLK) * NIN;
#pragma unroll
  for (int r = 0; r < 16; ++r) { int orow = crow(r, hi);
#pragma unroll
    for (int d0 = 0; d0 < 4; ++d0) Ow[(long)orow * NIN + d0 * 32 + r32] = (bf16_t)(cvt_pk_bf16(o[d0][r] * rli[r], 0.f) & 0xffffu); }
  __syncthreads();
#undef KROWP
#undef SLOAD
#undef SWRITE
#undef SWAIT
#undef RESC
}

constexpr size_t SHM_K8 = KVBLK * DH;
__device__ __forceinline__ void qkt8(f32x16& p0, f32x16& p1, const char* Ks, const v8i* q8, int r32, int hi) {
  p0 = f32x16{}; p1 = f32x16{};
  const int sw = (r32 >> 1) & 7;
#pragma unroll
  for (int j = 0; j < 2; ++j) { const int c0 = (4 * j + 2 * hi) ^ sw, c1 = (4 * j + 2 * hi + 1) ^ sw;
    const v4i a0 = *reinterpret_cast<const v4i*>(Ks + r32 * 128 + 16 * c0), a1 = *reinterpret_cast<const v4i*>(Ks + r32 * 128 + 16 * c1);
    const v4i b0 = *reinterpret_cast<const v4i*>(Ks + (32 + r32) * 128 + 16 * c0), b1 = *reinterpret_cast<const v4i*>(Ks + (32 + r32) * 128 + 16 * c1);
    const v8i ka = __builtin_shufflevector(a0, a1, 0, 1, 2, 3, 4, 5, 6, 7), kb = __builtin_shufflevector(b0, b1, 0, 1, 2, 3, 4, 5, 6, 7);
    p0 = __builtin_amdgcn_mfma_scale_f32_32x32x64_f8f6f4(ka, q8[j], p0, 0, 0, 0, 0x7f7f7f7f, 0, 0x7f7f7f7f);
    p1 = __builtin_amdgcn_mfma_scale_f32_32x32x64_f8f6f4(kb, q8[j], p1, 0, 0, 0, 0x7f7f7f7f, 0, 0x7f7f7f7f); }
}
__device__ __forceinline__ void attn_unit8(const bf16_t* __restrict__ Qb, const unsigned char* __restrict__ K8b, const bf16_t* __restrict__ Vc, const bf16_t* __restrict__ Vl, bf16_t* __restrict__ Ob,
                                           int nkc, int seq, char* lds, const float* __restrict__ qg, const float* __restrict__ rope, int t0) {
  int tid_ = threadIdx.x; asm volatile("" : "+v"(tid_));
  const int tid = tid_, wid = tid >> 6, lane = tid & 63, r32 = lane & 31, hi = lane >> 5;
  char* V_lds = lds; char* K_lds = lds + 2 * SHM_V;
  float* ws = (float*)(lds + 2 * SHM_V + 2 * SHM_K8) + wid * 64; float* li_l = ws; float* al_l = ws + 32;
  float m_reg = -1e30f, l_reg = 0; f32x16 o[4] = {}; v8i q8[2];
  {
    const bf16_t* Qw = Qb + (long)(wid * QBLK + r32) * NIN + hi * 32;
    float qf[2][4][8]; float ss = 0.f;
#pragma unroll
    for (int j = 0; j < 2; ++j)
#pragma unroll
      for (int i = 0; i < 4; ++i) { const u32x4 w = *reinterpret_cast<const u32x4*>(Qw + 64 * j + 8 * i);
        qf[j][i][0] = bf_lo(w.x); qf[j][i][1] = bf_hi(w.x); qf[j][i][2] = bf_lo(w.y); qf[j][i][3] = bf_hi(w.y); qf[j][i][4] = bf_lo(w.z); qf[j][i][5] = bf_hi(w.z); qf[j][i][6] = bf_lo(w.w); qf[j][i][7] = bf_hi(w.w);
#pragma unroll
        for (int e = 0; e < 8; ++e) ss += qf[j][i][e] * qf[j][i][e]; }
    ss += __shfl_xor(ss, 32);
    const float rstd = rsqrtf(ss * (1.f / 128.f) + NORM_EPS);
#pragma unroll
    for (int j = 0; j < 2; ++j)
#pragma unroll
      for (int i = 0; i < 4; ++i) { const float* gp = qg + 64 * j + 32 * hi + 8 * i; const f32x4 g0 = *reinterpret_cast<const f32x4*>(gp), g1 = *reinterpret_cast<const f32x4*>(gp + 4);
#pragma unroll
        for (int e = 0; e < 4; ++e) { qf[j][i][e] *= rstd * g0[e]; qf[j][i][4 + e] *= rstd * g1[e]; } }
    if (t0 >= 0) {
      const int t = t0 + wid * QBLK + r32;
#pragma unroll
      for (int j = 0; j < 2; ++j) { const int pos = j == 0 ? (t >> 6) : (t & 63);
#pragma unroll
        for (int i = 0; i < 4; ++i) { const float* rp = rope + pos * 32 + 8 * i;
          const f32x4 c0 = *reinterpret_cast<const f32x4*>(rp), c1 = *reinterpret_cast<const f32x4*>(rp + 4), s0 = *reinterpret_cast<const f32x4*>(rp + 4096), s1 = *reinterpret_cast<const f32x4*>(rp + 4100);
#pragma unroll
          for (int e = 0; e < 8; ++e) { const float cs = e < 4 ? c0[e] : c1[e - 4], sn = e < 4 ? s0[e] : s1[e - 4]; const float x = qf[j][i][e], pr = __shfl_xor(x, 32);
            qf[j][i][e] = x * cs + (hi ? pr : -pr) * sn; } } }
    }
#pragma unroll
    for (int j = 0; j < 2; ++j) { int w[8];
#pragma unroll
      for (int i = 0; i < 4; ++i) { unsigned t0_ = 0u, t1_ = 0u;
        t0_ = __builtin_amdgcn_cvt_pk_fp8_f32(qf[j][i][0], qf[j][i][1], t0_, false); t0_ = __builtin_amdgcn_cvt_pk_fp8_f32(qf[j][i][2], qf[j][i][3], t0_, true);
        t1_ = __builtin_amdgcn_cvt_pk_fp8_f32(qf[j][i][4], qf[j][i][5], t1_, false); t1_ = __builtin_amdgcn_cvt_pk_fp8_f32(qf[j][i][6], qf[j][i][7], t1_, true);
        w[2 * i] = (int)t0_; w[2 * i + 1] = (int)t1_; }
      q8[j] = (v8i){w[0], w[1], w[2], w[3], w[4], w[5], w[6], w[7]}; }
  }
  const int sr = tid >> 4, sc = (tid & 15) * 8, vst0 = v_st(sr, sc), vst1 = v_st(32 + sr, sc);
  const int krow = tid >> 3, kch = tid & 7, kst = krow * 128 + 16 * (kch ^ ((krow >> 1) & 7));
  const int vb0 = (int)(uintptr_t)V_lds + v_rd_base(lane);
  struct { bf16x8 vs0, vs1; v4i ks; } sr_[2];
#define VROWP(k0) (((k0) < nkc) ? (Vc + (long)(k0) * NIN) : (Vl + (long)((k0) - nkc) * NIN))
#define SLOAD(i, k0) do { const bf16_t* vb_ = VROWP(k0) + (long)sr * NIN + sc; \
    sr_[i].vs0 = *reinterpret_cast<const bf16x8*>(vb_); sr_[i].vs1 = *reinterpret_cast<const bf16x8*>(vb_ + 32L * NIN); \
    sr_[i].ks = *reinterpret_cast<const v4i*>(K8b + (long)((k0) + krow) * 128 + 16 * kch); } while (0)
#define SWRITE(b, i) do { *(bf16x8*)(V_lds + (b) * SHM_V + vst0) = sr_[i].vs0; *(bf16x8*)(V_lds + (b) * SHM_V + vst1) = sr_[i].vs1; \
    *(v4i*)(K_lds + (b) * SHM_K8 + kst) = sr_[i].ks; } while (0)
#define SWAIT() asm volatile("s_waitcnt vmcnt(3)" ::: "memory")
#define RESC(a) do { if (__any((a) < 1.f)) { if (hi == 0) al_l[r32] = (a); asm volatile("s_waitcnt lgkmcnt(0)" ::: "memory"); \
    _Pragma("unroll") for (int d = 0; d < 4; ++d) _Pragma("unroll") for (int r = 0; r < 16; ++r) o[d][r] *= al_l[crow(r, hi)]; } } while (0)
  f32x16 pA0, pA1, pB0, pB1; float mnA, mnB, alA, alB; bf16x8 pa0, pa1, pa2, pa3; const int NT = seq / KVBLK;
  constexpr int SE = 0, SO = 1;
  SLOAD(SE, 0); asm volatile("s_waitcnt vmcnt(0)" ::: "memory"); SWRITE(0, SE); __syncthreads();
  qkt8(pA0, pA1, K_lds, q8, r32, hi); partialSM(pA0, pA1, m_reg, mnA, alA);
  SLOAD(SO, KVBLK); if (2 < NT) SLOAD(SE, 2 * KVBLK);
  SWAIT(); SWRITE(1, SO); __syncthreads();
  for (int j = 1; j + 1 < NT; j += 2) {
    SBAR(); qkt8(pB0, pB1, K_lds + SHM_K8, q8, r32, hi);
    finishSM(pA0, pA1, alA, l_reg, pa0, pa1, pa2, pa3); SBAR();
    SLOAD(SO, (j + 2) * KVBLK); SBAR();
    pv_d0(o, vb0, pa0, pa1, pa2, pa3); partialSM(pB0, pB1, m_reg, mnB, alB);
    __syncthreads(); SWAIT(); SWRITE(0, SE);
    RESC(alB); __syncthreads();
    SBAR(); qkt8(pA0, pA1, K_lds, q8, r32, hi);
    finishSM(pB0, pB1, alB, l_reg, pa0, pa1, pa2, pa3); SBAR();
    if (j + 3 < NT) SLOAD(SE, (j + 3) * KVBLK); SBAR();
    pv_d0(o, vb0 + (int)SHM_V, pa0, pa1, pa2, pa3); partialSM(pA0, pA1, m_reg, mnA, alA);
    __syncthreads(); SWAIT(); SWRITE(1, SO);
    RESC(alA); __syncthreads();
  }
  SBAR(); qkt8(pB0, pB1, K_lds + SHM_K8, q8, r32, hi);
  finishSM(pA0, pA1, alA, l_reg, pa0, pa1, pa2, pa3); SBAR();
  pv_d0(o, vb0, pa0, pa1, pa2, pa3); partialSM(pB0, pB1, m_reg, mnB, alB);
  __syncthreads(); RESC(alB);
  finishSM(pB0, pB1, alB, l_reg, pa0, pa1, pa2, pa3); SBAR();
  pv_d0(o, vb0 + (int)SHM_V, pa0, pa1, pa2, pa3);
  if (hi == 0) li_l[r32] = l_reg; asm volatile("s_waitcnt lgkmcnt(0)" ::: "memory");
  float rli[16];
#pragma unroll
  for (int r = 0; r < 16; ++r) rli[r] = __builtin_amdgcn_rcpf(li_l[crow(r, hi)]);
  bf16_t* Ow = Ob + (long)(wid * QBLK) * NIN;
#pragma unroll
  for (int r = 0; r < 16; ++r) { int orow = crow(r, hi);
#pragma unroll
    for (int d0 = 0; d0 < 4; ++d0) Ow[(long)orow * NIN + d0 * 32 + r32] = (bf16_t)(cvt_pk_bf16(o[d0][r] * rli[r], 0.f) & 0xffffu); }
  __syncthreads();
#undef VROWP
#undef SLOAD
#undef SWRITE
#undef SWAIT
#undef RESC
}

constexpr float THR8 = 3.f;
constexpr size_t SHM_V8 = KVBLK * DH;
__host__ __device__ __forceinline__ int v_pos(int kk) { return 32 * ((kk >> 2) & 1) + 16 * (kk >> 5) + (kk & 3) + 4 * ((kk & 31) >> 3); }
__device__ __forceinline__ float fma_s(float a, float b, float c) { float r; asm("v_fma_f32 %0, %1, %2, %3" : "=v"(r) : "v"(a), "v"(b), "v"(c)); return r; }
__device__ __forceinline__ void partialSM8(f32x16& p0, f32x16& p1, float& m_reg, float& mn, float& alpha) {
  constexpr float C = SCALE * 1.4426950408889634f;
  float pmax = p0[0];
#pragma unroll
  for (int r = 1; r < 16; ++r) pmax = fmaxf(pmax, p0[r]);
#pragma unroll
  for (int r = 0; r < 16; ++r) pmax = fmaxf(pmax, p1[r]);
  { auto rr = __builtin_amdgcn_permlane32_swap(__float_as_uint(pmax), __float_as_uint(pmax), false, false);
    pmax = fmaxf(__uint_as_float(rr[0]), __uint_as_float(rr[1])); }
  if (__builtin_expect(__all(pmax - m_reg <= THR8 / SCALE), 1)) { mn = m_reg; alpha = 1.f; }
  else { mn = fmaxf(m_reg, pmax); alpha = __builtin_amdgcn_exp2f((m_reg - mn) * C); m_reg = mn; }
  float mnC = 4.0f - mn * C;
#pragma unroll
  for (int r = 0; r < 16; ++r) p0[r] = fma_s(p0[r], C, mnC);
#pragma unroll
  for (int r = 0; r < 16; ++r) p1[r] = fma_s(p1[r], C, mnC);
#pragma unroll
  for (int r = 0; r < 16; ++r) p0[r] = __builtin_amdgcn_exp2f(p0[r]);
}
__device__ __forceinline__ void finishSM8(f32x16& p0, f32x16& p1, float alpha, float& l_reg, v8i& p8) {
#pragma unroll
  for (int r = 0; r < 16; ++r) p1[r] = __builtin_amdgcn_exp2f(p1[r]);
  float ps = 0;
#pragma unroll
  for (int r = 0; r < 16; ++r) ps += p0[r];
#pragma unroll
  for (int r = 0; r < 16; ++r) ps += p1[r];
  { auto rr = __builtin_amdgcn_permlane32_swap(__float_as_uint(ps), __float_as_uint(ps), false, false);
    ps = __uint_as_float(rr[0]) + __uint_as_float(rr[1]); }
  l_reg = l_reg * alpha + ps;
  int w[8];
#pragma unroll
  for (int i = 0; i < 4; ++i) { unsigned a = 0u, b = 0u;
    a = __builtin_amdgcn_cvt_pk_fp8_f32(p0[4 * i], p0[4 * i + 1], a, false); a = __builtin_amdgcn_cvt_pk_fp8_f32(p0[4 * i + 2], p0[4 * i + 3], a, true);
    b = __builtin_amdgcn_cvt_pk_fp8_f32(p1[4 * i], p1[4 * i + 1], b, false); b = __builtin_amdgcn_cvt_pk_fp8_f32(p1[4 * i + 2], p1[4 * i + 3], b, true);
    w[i] = (int)a; w[4 + i] = (int)b; }
  p8 = (v8i){w[0], w[1], w[2], w[3], w[4], w[5], w[6], w[7]};
}
__device__ __forceinline__ void pv8(f32x16* o, const char* Vs, v8i p8, int r32, int hi) {
  const int sw = (r32 >> 2) & 3, c0 = (2 * hi) ^ sw, c1 = (2 * hi + 1) ^ sw;
#pragma unroll
  for (int d0 = 0; d0 < 4; ++d0) { const char* rp = Vs + (32 * d0 + r32) * 64;
    const v4i v0 = *reinterpret_cast<const v4i*>(rp + 16 * c0), v1 = *reinterpret_cast<const v4i*>(rp + 16 * c1);
    const v8i vf = __builtin_shufflevector(v0, v1, 0, 1, 2, 3, 4, 5, 6, 7);
    o[d0] = __builtin_amdgcn_mfma_scale_f32_32x32x64_f8f6f4(p8, vf, o[d0], 0, 0, 0, 0x7b7b7b7b, 0, 0x7f7f7f7f); }
}
__device__ __forceinline__ void attn_unit9(const bf16_t* __restrict__ Qb, const unsigned char* __restrict__ K8b, const unsigned char* __restrict__ VT8b, bf16_t* __restrict__ Ob,
                                           int seq, char* lds, const float* __restrict__ qg, const float* __restrict__ rope, int t0) {
  int tid_ = threadIdx.x; asm volatile("" : "+v"(tid_));
  const int tid = tid_, wid = tid >> 6, lane = tid & 63, r32 = lane & 31, hi = lane >> 5;
  char* V_lds = lds; char* K_lds = lds + 2 * SHM_V8;
  float* ws = (float*)(lds + 2 * SHM_V8 + 2 * SHM_K8) + wid * 64; float* li_l = ws; float* al_l = ws + 32;
  float m_reg = -1e30f, l_reg = 0; f32x16 o[4] = {}; v8i q8[2];
  {
    const bf16_t* Qw = Qb + (long)(wid * QBLK + r32) * NIN + hi * 32;
    float qf[2][4][8]; float ss = 0.f;
#pragma unroll
    for (int j = 0; j < 2; ++j)
#pragma unroll
      for (int i = 0; i < 4; ++i) { const u32x4 w = *reinterpret_cast<const u32x4*>(Qw + 64 * j + 8 * i);
        qf[j][i][0] = bf_lo(w.x); qf[j][i][1] = bf_hi(w.x); qf[j][i][2] = bf_lo(w.y); qf[j][i][3] = bf_hi(w.y); qf[j][i][4] = bf_lo(w.z); qf[j][i][5] = bf_hi(w.z); qf[j][i][6] = bf_lo(w.w); qf[j][i][7] = bf_hi(w.w);
#pragma unroll
        for (int e = 0; e < 8; ++e) ss += qf[j][i][e] * qf[j][i][e]; }
    ss += __shfl_xor(ss, 32);
    const float rstd = rsqrtf(ss * (1.f / 128.f) + NORM_EPS);
#pragma unroll
    for (int j = 0; j < 2; ++j)
#pragma unroll
      for (int i = 0; i < 4; ++i) { const float* gp = qg + 64 * j + 32 * hi + 8 * i; const f32x4 g0 = *reinterpret_cast<const f32x4*>(gp), g1 = *reinterpret_cast<const f32x4*>(gp + 4);
#pragma unroll
        for (int e = 0; e < 4; ++e) { qf[j][i][e] *= rstd * g0[e]; qf[j][i][4 + e] *= rstd * g1[e]; } }
    if (t0 >= 0) {
      const int t = t0 + wid * QBLK + r32;
#pragma unroll
      for (int j = 0; j < 2; ++j) { const int pos = j == 0 ? (t >> 6) : (t & 63);
#pragma unroll
        for (int i = 0; i < 4; ++i) { const float* rp = rope + pos * 32 + 8 * i;
          const f32x4 c0 = *reinterpret_cast<const f32x4*>(rp), c1 = *reinterpret_cast<const f32x4*>(rp + 4), s0 = *reinterpret_cast<const f32x4*>(rp + 4096), s1 = *reinterpret_cast<const f32x4*>(rp + 4100);
#pragma unroll
          for (int e = 0; e < 8; ++e) { const float cs = e < 4 ? c0[e] : c1[e - 4], sn = e < 4 ? s0[e] : s1[e - 4]; const float x = qf[j][i][e], pr = __shfl_xor(x, 32);
            qf[j][i][e] = x * cs + (hi ? pr : -pr) * sn; } } }
    }
#pragma unroll
    for (int j = 0; j < 2; ++j) { int w[8];
#pragma unroll
      for (int i = 0; i < 4; ++i) { unsigned t0_ = 0u, t1_ = 0u;
        t0_ = __builtin_amdgcn_cvt_pk_fp8_f32(qf[j][i][0], qf[j][i][1], t0_, false); t0_ = __builtin_amdgcn_cvt_pk_fp8_f32(qf[j][i][2], qf[j][i][3], t0_, true);
        t1_ = __builtin_amdgcn_cvt_pk_fp8_f32(qf[j][i][4], qf[j][i][5], t1_, false); t1_ = __builtin_amdgcn_cvt_pk_fp8_f32(qf[j][i][6], qf[j][i][7], t1_, true);
        w[2 * i] = (int)t0_; w[2 * i + 1] = (int)t1_; }
      q8[j] = (v8i){w[0], w[1], w[2], w[3], w[4], w[5], w[6], w[7]}; }
  }
  const int krow = tid >> 3, kch = tid & 7, kst = krow * 128 + 16 * (kch ^ ((krow >> 1) & 7));
  const int vrow = tid >> 2, vch = tid & 3, vst = vrow * 64 + 16 * (vch ^ ((vrow >> 2) & 3));
  struct { v4i vs, ks; } sr_[2];
#define SLOAD(i, k0) do { sr_[i].vs = *reinterpret_cast<const v4i*>(VT8b + (long)(k0) * 128 + 16 * tid); \
    sr_[i].ks = *reinterpret_cast<const v4i*>(K8b + (long)((k0) + krow) * 128 + 16 * kch); } while (0)
#define SWRITE(b, i) do { *(v4i*)(V_lds + (b) * SHM_V8 + vst) = sr_[i].vs; *(v4i*)(K_lds + (b) * SHM_K8 + kst) = sr_[i].ks; } while (0)
#define SWAIT() asm volatile("s_waitcnt vmcnt(2)" ::: "memory")
#define RESC(a) do { if (__any((a) < 1.f)) { if (hi == 0) al_l[r32] = (a); asm volatile("s_waitcnt lgkmcnt(0)" ::: "memory"); \
    _Pragma("unroll") for (int d = 0; d < 4; ++d) _Pragma("unroll") for (int r = 0; r < 16; ++r) o[d][r] *= al_l[crow(r, hi)]; } } while (0)
  f32x16 pA0, pA1, pB0, pB1; float mnA, mnB, alA, alB; v8i p8; const int NT = seq / KVBLK;
  constexpr int SE = 0, SO = 1;
  SLOAD(SE, 0); asm volatile("s_waitcnt vmcnt(0)" ::: "memory"); SWRITE(0, SE); __syncthreads();
  qkt8(pA0, pA1, K_lds, q8, r32, hi); partialSM8(pA0, pA1, m_reg, mnA, alA);
  SLOAD(SO, KVBLK); if (2 < NT) SLOAD(SE, 2 * KVBLK);
  SWAIT(); SWRITE(1, SO); __syncthreads();
  for (int j = 1; j + 1 < NT; j += 2) {
    SBAR(); qkt8(pB0, pB1, K_lds + SHM_K8, q8, r32, hi);
    finishSM8(pA0, pA1, alA, l_reg, p8); SBAR();
    SLOAD(SO, (j + 2) * KVBLK); SBAR();
    pv8(o, V_lds, p8, r32, hi); partialSM8(pB0, pB1, m_reg, mnB, alB);
    __syncthreads(); SWAIT(); SWRITE(0, SE);
    RESC(alB); __syncthreads();
    SBAR(); qkt8(pA0, pA1, K_lds, q8, r32, hi);
    finishSM8(pB0, pB1, alB, l_reg, p8); SBAR();
    if (j + 3 < NT) SLOAD(SE, (j + 3) * KVBLK); SBAR();
    pv8(o, V_lds + SHM_V8, p8, r32, hi); partialSM8(pA0, pA1, m_reg, mnA, alA);
    __syncthreads(); SWAIT(); SWRITE(1, SO);
    RESC(alA); __syncthreads();
  }
  SBAR(); qkt8(pB0, pB1, K_lds + SHM_K8, q8, r32, hi);
  finishSM8(pA0, pA1, alA, l_reg, p8); SBAR();
  pv8(o, V_lds, p8, r32, hi); partialSM8(pB0, pB1, m_reg, mnB, alB);
  __syncthreads(); RESC(alB);
  finishSM8(pB0, pB1, alB, l_reg, p8); SBAR();
  pv8(o, V_lds + SHM_V8, p8, r32, hi);
  if (hi == 0) li_l[r32] = l_reg; asm volatile("s_waitcnt lgkmcnt(0)" ::: "memory");
  float rli[16];
#pragma unroll
  for (int r = 0; r < 16; ++r) rli[r] = 16.0f * __builtin_amdgcn_rcpf(li_l[crow(r, hi)]);
  bf16_t* Ow = Ob + (long)(wid * QBLK) * NIN;
#pragma unroll
  for (int r = 0; r < 16; ++r) { int orow = crow(r, hi);
#pragma unroll
    for (int d0 = 0; d0 < 4; ++d0) Ow[(long)orow * NIN + d0 * 32 + r32] = (bf16_t)(cvt_pk_bf16(o[d0][r] * rli[r], 0.f) & 0xffffu); }
  __syncthreads();
#undef SLOAD
#undef SWRITE
#undef SWAIT
#undef RESC
}

__device__ __forceinline__ void qkt9(f32x16& p0, f32x16& p1, const char* Ks, const v8i* q8, const f32x16& negm, int r32, int hi) {
  const int sw = (r32 >> 1) & 7;
  { const int c0 = (2 * hi) ^ sw, c1 = (2 * hi + 1) ^ sw;
    const v4i a0 = *reinterpret_cast<const v4i*>(Ks + r32 * 128 + 16 * c0), a1 = *reinterpret_cast<const v4i*>(Ks + r32 * 128 + 16 * c1);
    const v4i b0 = *reinterpret_cast<const v4i*>(Ks + (32 + r32) * 128 + 16 * c0), b1 = *reinterpret_cast<const v4i*>(Ks + (32 + r32) * 128 + 16 * c1);
    const v8i ka = __builtin_shufflevector(a0, a1, 0, 1, 2, 3, 4, 5, 6, 7), kb = __builtin_shufflevector(b0, b1, 0, 1, 2, 3, 4, 5, 6, 7);
    p0 = __builtin_amdgcn_mfma_scale_f32_32x32x64_f8f6f4(ka, q8[0], negm, 0, 0, 0, 0x7f7f7f7f, 0, 0x7f7f7f7f);
    p1 = __builtin_amdgcn_mfma_scale_f32_32x32x64_f8f6f4(kb, q8[0], negm, 0, 0, 0, 0x7f7f7f7f, 0, 0x7f7f7f7f); }
  { const int c0 = (4 + 2 * hi) ^ sw, c1 = (4 + 2 * hi + 1) ^ sw;
    const v4i a0 = *reinterpret_cast<const v4i*>(Ks + r32 * 128 + 16 * c0), a1 = *reinterpret_cast<const v4i*>(Ks + r32 * 128 + 16 * c1);
    const v4i b0 = *reinterpret_cast<const v4i*>(Ks + (32 + r32) * 128 + 16 * c0), b1 = *reinterpret_cast<const v4i*>(Ks + (32 + r32) * 128 + 16 * c1);
    const v8i ka = __builtin_shufflevector(a0, a1, 0, 1, 2, 3, 4, 5, 6, 7), kb = __builtin_shufflevector(b0, b1, 0, 1, 2, 3, 4, 5, 6, 7);
    p0 = __builtin_amdgcn_mfma_scale_f32_32x32x64_f8f6f4(ka, q8[1], p0, 0, 0, 0, 0x7f7f7f7f, 0, 0x7f7f7f7f);
    p1 = __builtin_amdgcn_mfma_scale_f32_32x32x64_f8f6f4(kb, q8[1], p1, 0, 0, 0, 0x7f7f7f7f, 0, 0x7f7f7f7f); }
}
template <bool FIRST>
__device__ __forceinline__ void partialSM9(f32x16& p0, f32x16& p1, float& m_reg, f32x16& negm, float& alpha) {
  constexpr float THRL = THR8 * 1.4426950408889634f;
  float pmax = p0[0];
#pragma unroll
  for (int r = 1; r < 16; ++r) pmax = fmaxf(pmax, p0[r]);
#pragma unroll
  for (int r = 0; r < 16; ++r) pmax = fmaxf(pmax, p1[r]);
  { auto rr = __builtin_amdgcn_permlane32_swap(__float_as_uint(pmax), __float_as_uint(pmax), false, false);
    pmax = fmaxf(__uint_as_float(rr[0]), __uint_as_float(rr[1])); }
  if (!FIRST && __builtin_expect(__all(pmax - 4.0f <= THRL), 1)) { alpha = 1.f; }
  else {
    const float d = FIRST ? (pmax - 4.0f) : fmaxf(pmax - 4.0f, 0.f);
    alpha = FIRST ? 1.f : __builtin_amdgcn_exp2f(-d); m_reg += d;
#pragma unroll
    for (int r = 0; r < 16; ++r) { p0[r] -= d; p1[r] -= d; negm[r] -= d; }
    if (FIRST) {
#pragma unroll
      for (int r = 0; r < 16; ++r) negm[r] = 4.0f - m_reg; }
  }
#pragma unroll
  for (int r = 0; r < 16; ++r) p0[r] = __builtin_amdgcn_exp2f(p0[r]);
}
__device__ __forceinline__ void attn_unit11(const bf16_t* __restrict__ Qb, const unsigned char* __restrict__ K8b, const unsigned char* __restrict__ VT8b, bf16_t* __restrict__ Ob,
                                           int seq, char* lds, const float* __restrict__ qg, const float* __restrict__ rope, int t0) {
  int tid_ = threadIdx.x; asm volatile("" : "+v"(tid_));
  const int tid = tid_, wid = tid >> 6, lane = tid & 63, r32 = lane & 31, hi = lane >> 5;
  char* V_lds = lds; char* K_lds = lds + 2 * SHM_V8;
  float* ws = (float*)(lds + 2 * SHM_V8 + 2 * SHM_K8) + wid * 64; float* li_l = ws; float* al_l = ws + 32;
  float m_reg = 4.0f, l_reg = 0; f32x16 o[4] = {}; v8i q8[2]; f32x16 negm = {};
  {
    const bf16_t* Qw = Qb + (long)(wid * QBLK + r32) * NIN + hi * 32;
    float qf[2][4][8]; float ss = 0.f;
#pragma unroll
    for (int j = 0; j < 2; ++j)
#pragma unroll
      for (int i = 0; i < 4; ++i) { const u32x4 w = *reinterpret_cast<const u32x4*>(Qw + 64 * j + 8 * i);
        qf[j][i][0] = bf_lo(w.x); qf[j][i][1] = bf_hi(w.x); qf[j][i][2] = bf_lo(w.y); qf[j][i][3] = bf_hi(w.y); qf[j][i][4] = bf_lo(w.z); qf[j][i][5] = bf_hi(w.z); qf[j][i][6] = bf_lo(w.w); qf[j][i][7] = bf_hi(w.w);
#pragma unroll
        for (int e = 0; e < 8; ++e) ss += qf[j][i][e] * qf[j][i][e]; }
    ss += __shfl_xor(ss, 32);
    const float rstd = rsqrtf(ss * (1.f / 128.f) + NORM_EPS);
#pragma unroll
    for (int j = 0; j < 2; ++j)
#pragma unroll
      for (int i = 0; i < 4; ++i) { const float* gp = qg + 64 * j + 32 * hi + 8 * i; const f32x4 g0 = *reinterpret_cast<const f32x4*>(gp), g1 = *reinterpret_cast<const f32x4*>(gp + 4);
#pragma unroll
        for (int e = 0; e < 4; ++e) { qf[j][i][e] *= (rstd * (SCALE * 1.4426950408889634f)) * g0[e]; qf[j][i][4 + e] *= (rstd * (SCALE * 1.4426950408889634f)) * g1[e]; } }
    if (t0 >= 0) {
      const int t = t0 + wid * QBLK + r32;
#pragma unroll
      for (int j = 0; j < 2; ++j) { const int pos = j == 0 ? (t >> 6) : (t & 63);
#pragma unroll
        for (int i = 0; i < 4; ++i) { const float* rp = rope + pos * 32 + 8 * i;
          const f32x4 c0 = *reinterpret_cast<const f32x4*>(rp), c1 = *reinterpret_cast<const f32x4*>(rp + 4), s0 = *reinterpret_cast<const f32x4*>(rp + 4096), s1 = *reinterpret_cast<const f32x4*>(rp + 4100);
#pragma unroll
          for (int e = 0; e < 8; ++e) { const float cs = e < 4 ? c0[e] : c1[e - 4], sn = e < 4 ? s0[e] : s1[e - 4]; const float x = qf[j][i][e], pr = __shfl_xor(x, 32);
            qf[j][i][e] = x * cs + (hi ? pr : -pr) * sn; } } }
    }
#pragma unroll
    for (int j = 0; j < 2; ++j) { int w[8];
#pragma unroll
      for (int i = 0; i < 4; ++i) { unsigned t0_ = 0u, t1_ = 0u;
        t0_ = __builtin_amdgcn_cvt_pk_fp8_f32(qf[j][i][0], qf[j][i][1], t0_, false); t0_ = __builtin_amdgcn_cvt_pk_fp8_f32(qf[j][i][2], qf[j][i][3], t0_, true);
        t1_ = __builtin_amdgcn_cvt_pk_fp8_f32(qf[j][i][4], qf[j][i][5], t1_, false); t1_ = __builtin_amdgcn_cvt_pk_fp8_f32(qf[j][i][6], qf[j][i][7], t1_, true);
        w[2 * i] = (int)t0_; w[2 * i + 1] = (int)t1_; }
      q8[j] = (v8i){w[0], w[1], w[2], w[3], w[4], w[5], w[6], w[7]}; }
  }
  const int krow = tid >> 3, kch = tid & 7, kst = krow * 128 + 16 * (kch ^ ((krow >> 1) & 7));
  const int vrow = tid >> 2, vch = tid & 3, vst = vrow * 64 + 16 * (vch ^ ((vrow >> 2) & 3));
  struct { v4i vs, ks; } sr_[2];
#define SLOAD(i, k0) do { sr_[i].vs = *reinterpret_cast<const v4i*>(VT8b + (long)(k0) * 128 + 16 * tid); \
    sr_[i].ks = *reinterpret_cast<const v4i*>(K8b + (long)((k0) + krow) * 128 + 16 * kch); } while (0)
#define SWRITE(b, i) do { *(v4i*)(V_lds + (b) * SHM_V8 + vst) = sr_[i].vs; *(v4i*)(K_lds + (b) * SHM_K8 + kst) = sr_[i].ks; } while (0)
#define SWAIT() asm volatile("s_waitcnt vmcnt(2)" ::: "memory")
#define RESC(a) do { if (__any((a) < 1.f)) { if (hi == 0) al_l[r32] = (a); asm volatile("s_waitcnt lgkmcnt(0)" ::: "memory"); \
    _Pragma("unroll") for (int d = 0; d < 4; ++d) _Pragma("unroll") for (int r = 0; r < 16; ++r) o[d][r] *= al_l[crow(r, hi)]; } } while (0)
  f32x16 pA0, pA1, pB0, pB1; float mnA, mnB, alA, alB; v8i p8; const int NT = seq / KVBLK;
  constexpr int SE = 0, SO = 1;
  SLOAD(SE, 0); asm volatile("s_waitcnt vmcnt(0)" ::: "memory"); SWRITE(0, SE); __syncthreads();
  qkt9(pA0, pA1, K_lds, q8, negm, r32, hi); partialSM9<true>(pA0, pA1, m_reg, negm, alA);
  SLOAD(SO, KVBLK); if (2 < NT) SLOAD(SE, 2 * KVBLK);
  SWAIT(); SWRITE(1, SO); __syncthreads();
  for (int j = 1; j + 1 < NT; j += 2) {
    SBAR(); qkt9(pB0, pB1, K_lds + SHM_K8, q8, negm, r32, hi);
    finishSM8(pA0, pA1, alA, l_reg, p8); SBAR();
    SLOAD(SO, (j + 2) * KVBLK); SBAR();
    pv8(o, V_lds, p8, r32, hi); partialSM9<false>(pB0, pB1, m_reg, negm, alB);
    __syncthreads(); SWAIT(); SWRITE(0, SE);
    RESC(alB); __syncthreads();
    SBAR(); qkt9(pA0, pA1, K_lds, q8, negm, r32, hi);
    finishSM8(pB0, pB1, alB, l_reg, p8); SBAR();
    if (j + 3 < NT) SLOAD(SE, (j + 3) * KVBLK); SBAR();
    pv8(o, V_lds + SHM_V8, p8, r32, hi); partialSM9<false>(pA0, pA1, m_reg, negm, alA);
    __syncthreads(); SWAIT(); SWRITE(1, SO);
    RESC(alA); __syncthreads();
  }
  SBAR(); qkt9(pB0, pB1, K_lds + SHM_K8, q8, negm, r32, hi);
  finishSM8(pA0, pA1, alA, l_reg, p8); SBAR();
  pv8(o, V_lds, p8, r32, hi); partialSM9<false>(pB0, pB1, m_reg, negm, alB);
  __syncthreads(); RESC(alB);
  finishSM8(pB0, pB1, alB, l_reg, p8); SBAR();
  pv8(o, V_lds + SHM_V8, p8, r32, hi);
  if (hi == 0) li_l[r32] = l_reg; asm volatile("s_waitcnt lgkmcnt(0)" ::: "memory");
  float rli[16];
#pragma unroll
  for (int r = 0; r < 16; ++r) rli[r] = 16.0f * __builtin_amdgcn_rcpf(li_l[crow(r, hi)]);
  bf16_t* Ow = Ob + (long)(wid * QBLK) * NIN;
#pragma unroll
  for (int r = 0; r < 16; ++r) { int orow = crow(r, hi);
#pragma unroll
    for (int d0 = 0; d0 < 4; ++d0) Ow[(long)orow * NIN + d0 * 32 + r32] = (bf16_t)(cvt_pk_bf16(o[d0][r] * rli[r], 0.f) & 0xffffu); }
  __syncthreads();
#undef SLOAD
#undef SWRITE
#undef SWAIT
#undef RESC
}
template <bool FIRST, bool NOSUM = false>
__device__ __forceinline__ void softmax14(f32x16& p0, f32x16& p1, float& m_reg, f32x16& negm, float& l_reg, v8i& p8, float& alpha) {
  constexpr float THRL = THR8 * 1.4426950408889634f;
  float ma = fmaxf(fmaxf(p0[0], p0[1]), p0[2]), mb = fmaxf(fmaxf(p0[3], p0[4]), p0[5]), mc = fmaxf(fmaxf(p0[6], p0[7]), p0[8]), md = fmaxf(fmaxf(p0[9], p0[10]), p0[11]);
  ma = fmaxf(fmaxf(ma, p0[12]), p0[13]); mb = fmaxf(fmaxf(mb, p0[14]), p0[15]); mc = fmaxf(fmaxf(mc, p1[0]), p1[1]); md = fmaxf(fmaxf(md, p1[2]), p1[3]);
  ma = fmaxf(fmaxf(ma, p1[4]), p1[5]); mb = fmaxf(fmaxf(mb, p1[6]), p1[7]); mc = fmaxf(fmaxf(mc, p1[8]), p1[9]); md = fmaxf(fmaxf(md, p1[10]), p1[11]);
  ma = fmaxf(fmaxf(ma, p1[12]), p1[13]); mb = fmaxf(fmaxf(mb, p1[14]), p1[15]);
  float pmax = fmaxf(fmaxf(fmaxf(ma, mb), mc), md);
  { auto rr = __builtin_amdgcn_permlane32_swap(__float_as_uint(pmax), __float_as_uint(pmax), false, false);
    pmax = fmaxf(__uint_as_float(rr[0]), __uint_as_float(rr[1])); }
  if (!FIRST && __builtin_expect(__all(pmax - 4.0f <= THRL), 1)) { alpha = 1.f; }
  else {
    const float d = FIRST ? (pmax - 4.0f) : fmaxf(pmax - 4.0f, 0.f);
    alpha = FIRST ? 1.f : __builtin_amdgcn_exp2f(-d); m_reg += d;
#pragma unroll
    for (int r = 0; r < 16; ++r) { p0[r] -= d; p1[r] -= d; negm[r] -= d; }
    if (FIRST) {
#pragma unroll
      for (int r = 0; r < 16; ++r) negm[r] = 4.0f - m_reg; }
  }
#pragma unroll
  for (int r = 0; r < 16; ++r) p0[r] = __builtin_amdgcn_exp2f(p0[r]);
#pragma unroll
  for (int r = 0; r < 16; ++r) p1[r] = __builtin_amdgcn_exp2f(p1[r]);
  if (!NOSUM) {
  float sa = p0[0] + p0[4], sb = p0[1] + p0[5], sc = p0[2] + p0[6], sd = p0[3] + p0[7];
  sa += p0[8]; sb += p0[9]; sc += p0[10]; sd += p0[11]; sa += p0[12]; sb += p0[13]; sc += p0[14]; sd += p0[15];
#pragma unroll
  for (int r = 0; r < 16; r += 4) { sa += p1[r]; sb += p1[r + 1]; sc += p1[r + 2]; sd += p1[r + 3]; }
  float ps = (sa + sb) + (sc + sd);
  { auto rr = __builtin_amdgcn_permlane32_swap(__float_as_uint(ps), __float_as_uint(ps), false, false);
    ps = __uint_as_float(rr[0]) + __uint_as_float(rr[1]); }
  l_reg = l_reg * alpha + ps;
  }
  int w[8];
#pragma unroll
  for (int i = 0; i < 4; ++i) { unsigned a = __float_as_uint(p0[4 * i]), b = __float_as_uint(p1[4 * i]);
    a = __builtin_amdgcn_cvt_pk_fp8_f32(p0[4 * i], p0[4 * i + 1], a, false); a = __builtin_amdgcn_cvt_pk_fp8_f32(p0[4 * i + 2], p0[4 * i + 3], a, true);
    b = __builtin_amdgcn_cvt_pk_fp8_f32(p1[4 * i], p1[4 * i + 1], b, false); b = __builtin_amdgcn_cvt_pk_fp8_f32(p1[4 * i + 2], p1[4 * i + 3], b, true);
    w[i] = (int)a; w[4 + i] = (int)b; }
  p8 = (v8i){w[0], w[1], w[2], w[3], w[4], w[5], w[6], w[7]};
}
constexpr int RING = 6;
template <int MODE = 0>
__device__ __forceinline__ void attn_unit14(const bf16_t* __restrict__ Qb, const unsigned char* __restrict__ K8b, const unsigned char* __restrict__ VT8b, bf16_t* __restrict__ Ob,
                                           int seq, char* lds, LAS unsigned char* ldsl, const float* __restrict__ qg, const float* __restrict__ rope, int t0, int ostr = NIN) {
  int tid_ = threadIdx.x; asm volatile("" : "+v"(tid_));
  const int tid = tid_, wid = tid >> 6, lane = tid & 63, r32 = lane & 31, hi = lane >> 5;
  char* K_lds = lds; char* V_lds = lds + RING * SHM_K8;
  float* ws = (float*)(lds + RING * SHM_K8 + RING * SHM_V8) + wid * 64; float* li_l = ws; float* al_l = ws + 32;
  float m_reg = 4.0f, l_reg = 0; f32x16 o[5] = {}; v8i q8[2]; f32x16 negm = {};
  const int one8 = r32 == 0 ? 0x38383838 : 0; const v8i vones = (v8i){one8, one8, one8, one8, one8, one8, one8, one8};
  {
    const bf16_t* Qw = Qb + (long)(wid * QBLK + r32) * NIN + hi * 32;
    float qf[2][4][8]; float ss = 0.f;
#pragma unroll
    for (int j = 0; j < 2; ++j)
#pragma unroll
      for (int i = 0; i < 4; ++i) { const u32x4 w = *reinterpret_cast<const u32x4*>(Qw + 64 * j + 8 * i);
        qf[j][i][0] = bf_lo(w.x); qf[j][i][1] = bf_hi(w.x); qf[j][i][2] = bf_lo(w.y); qf[j][i][3] = bf_hi(w.y); qf[j][i][4] = bf_lo(w.z); qf[j][i][5] = bf_hi(w.z); qf[j][i][6] = bf_lo(w.w); qf[j][i][7] = bf_hi(w.w);
#pragma unroll
        for (int e = 0; e < 8; ++e) ss += qf[j][i][e] * qf[j][i][e]; }
    ss += __shfl_xor(ss, 32);
    const float rstd = rsqrtf(ss * (1.f / 128.f) + NORM_EPS);
#pragma unroll
    for (int j = 0; j < 2; ++j)
#pragma unroll
      for (int i = 0; i < 4; ++i) { const float* gp = qg + 64 * j + 32 * hi + 8 * i; const f32x4 g0 = *reinterpret_cast<const f32x4*>(gp), g1 = *reinterpret_cast<const f32x4*>(gp + 4);
#pragma unroll
        for (int e = 0; e < 4; ++e) { qf[j][i][e] *= (rstd * (SCALE * 1.4426950408889634f)) * g0[e]; qf[j][i][4 + e] *= (rstd * (SCALE * 1.4426950408889634f)) * g1[e]; } }
    if (t0 >= 0) {
      const int t = t0 + wid * QBLK + r32;
#pragma unroll
      for (int j = 0; j < 2; ++j) { const int pos = j == 0 ? (t >> 6) : (t & 63);
#pragma unroll
        for (int i = 0; i < 4; ++i) { const float* rp = rope + pos * 32 + 8 * i;
          const f32x4 c0 = *reinterpret_cast<const f32x4*>(rp), c1 = *reinterpret_cast<const f32x4*>(rp + 4), s0 = *reinterpret_cast<const f32x4*>(rp + 4096), s1 = *reinterpret_cast<const f32x4*>(rp + 4100);
#pragma unroll
          for (int e = 0; e < 8; ++e) { const float cs = e < 4 ? c0[e] : c1[e - 4], sn = e < 4 ? s0[e] : s1[e - 4]; const float x = qf[j][i][e], pr = __shfl_xor(x, 32);
            qf[j][i][e] = x * cs + (hi ? pr : -pr) * sn; } } }
    }
#pragma unroll
    for (int j = 0; j < 2; ++j) { int w[8];
#pragma unroll
      for (int i = 0; i < 4; ++i) { unsigned t0_ = 0u, t1_ = 0u;
        t0_ = __builtin_amdgcn_cvt_pk_fp8_f32(qf[j][i][0], qf[j][i][1], t0_, false); t0_ = __builtin_amdgcn_cvt_pk_fp8_f32(qf[j][i][2], qf[j][i][3], t0_, true);
        t1_ = __builtin_amdgcn_cvt_pk_fp8_f32(qf[j][i][4], qf[j][i][5], t1_, false); t1_ = __builtin_amdgcn_cvt_pk_fp8_f32(qf[j][i][6], qf[j][i][7], t1_, true);
        w[2 * i] = (int)t0_; w[2 * i + 1] = (int)t1_; }
      q8[j] = (v8i){w[0], w[1], w[2], w[3], w[4], w[5], w[6], w[7]}; }
  }
  const int widu = __builtin_amdgcn_readfirstlane(wid);
  const bool grpB = widu >= 4;
  const int krow = 8 * wid + (lane >> 3), koff = krow * 128 + 16 * ((lane & 7) ^ ((krow >> 1) & 7));
  const int vrow = 16 * wid + (lane >> 2), voff = vrow * 64 + 16 * ((lane & 3) ^ ((vrow >> 2) & 3));
  const int NT = seq / KVBLK;
#define DMA(t, s) do { const long to_ = (long)((t) < NT ? (t) : NT - 1) * 8192; \
    __builtin_amdgcn_global_load_lds((const unsigned*)(K8b + to_ + koff), (LAS unsigned*)(ldsl + (s) * SHM_K8 + 1024 * widu), 16, 0, 0); \
    __builtin_amdgcn_global_load_lds((const unsigned*)(VT8b + to_ + voff), (LAS unsigned*)(ldsl + RING * SHM_K8 + (s) * SHM_V8 + 1024 * widu), 16, 0, 0); } while (0)
#define BAR() do { SBAR(); __builtin_amdgcn_s_barrier(); asm volatile("" ::: "memory"); SBAR(); } while (0)
#define BAR_V() do { SBAR(); asm volatile("s_barrier" : "+v"(p8) :: "memory"); SBAR(); } while (0)
#define WAIT_BAR() do { SBAR(); asm volatile("s_waitcnt vmcnt(4)\n\ts_barrier" : "+v"(o[0]), "+v"(o[1]), "+v"(o[2]), "+v"(o[3]), "+v"(o[4]), "+v"(s0), "+v"(s1) :: "memory"); SBAR(); } while (0)
#define RESC(a) do { if (__any((a) < 1.f)) { if (hi == 0) al_l[r32] = (a); asm volatile("s_waitcnt lgkmcnt(0)" ::: "memory"); \
    _Pragma("unroll") for (int d = 0; d < 5; ++d) _Pragma("unroll") for (int r = 0; r < 16; ++r) o[d][r] *= al_l[crow(r, hi)]; } } while (0)
#define PVS() (o[4] = __builtin_amdgcn_mfma_scale_f32_32x32x64_f8f6f4(p8, vones, o[4], 0, 0, 0, 0x7b7b7b7b, 0, 0x7f7f7f7f))
#define LDK(Ks) do { const char* ks_ = (Ks); const int sw_ = (r32 >> 1) & 7; \
    { const int c0 = (2 * hi) ^ sw_, c1 = (2 * hi + 1) ^ sw_; \
      const v4i a0 = *reinterpret_cast<const v4i*>(ks_ + r32 * 128 + 16 * c0), a1 = *reinterpret_cast<const v4i*>(ks_ + r32 * 128 + 16 * c1); \
      const v4i b0 = *reinterpret_cast<const v4i*>(ks_ + (32 + r32) * 128 + 16 * c0), b1 = *reinterpret_cast<const v4i*>(ks_ + (32 + r32) * 128 + 16 * c1); \
      kf0 = __builtin_shufflevector(a0, a1, 0, 1, 2, 3, 4, 5, 6, 7); kf1 = __builtin_shufflevector(b0, b1, 0, 1, 2, 3, 4, 5, 6, 7); } \
    { const int c0 = (4 + 2 * hi) ^ sw_, c1 = (4 + 2 * hi + 1) ^ sw_; \
      const v4i a0 = *reinterpret_cast<const v4i*>(ks_ + r32 * 128 + 16 * c0), a1 = *reinterpret_cast<const v4i*>(ks_ + r32 * 128 + 16 * c1); \
      const v4i b0 = *reinterpret_cast<const v4i*>(ks_ + (32 + r32) * 128 + 16 * c0), b1 = *reinterpret_cast<const v4i*>(ks_ + (32 + r32) * 128 + 16 * c1); \
      kf2 = __builtin_shufflevector(a0, a1, 0, 1, 2, 3, 4, 5, 6, 7); kf3 = __builtin_shufflevector(b0, b1, 0, 1, 2, 3, 4, 5, 6, 7); } } while (0)
#define QK() do { \
    s0 = __builtin_amdgcn_mfma_scale_f32_32x32x64_f8f6f4(kf0, q8[0], negm, 0, 0, 0, 0x7f7f7f7f, 0, 0x7f7f7f7f); \
    s1 = __builtin_amdgcn_mfma_scale_f32_32x32x64_f8f6f4(kf1, q8[0], negm, 0, 0, 0, 0x7f7f7f7f, 0, 0x7f7f7f7f); \
    s0 = __builtin_amdgcn_mfma_scale_f32_32x32x64_f8f6f4(kf2, q8[1], s0, 0, 0, 0, 0x7f7f7f7f, 0, 0x7f7f7f7f); \
    s1 = __builtin_amdgcn_mfma_scale_f32_32x32x64_f8f6f4(kf3, q8[1], s1, 0, 0, 0, 0x7f7f7f7f, 0, 0x7f7f7f7f); } while (0)
  f32x16 s0, s1; float al; v8i p8, kf0, kf1, kf2, kf3;
#pragma unroll
  for (int t = 0; t < RING - 1; ++t) DMA(t, t);
  asm volatile("s_waitcnt vmcnt(4)" ::: "memory"); BAR();
  if (grpB) BAR();
  LDK(K_lds); QK();
  WAIT_BAR();
  softmax14<true, true>(s0, s1, m_reg, negm, l_reg, p8, al);
  LDK(K_lds + SHM_K8);
  BAR_V();
  int sv = 0;
  for (int j = 0; j + 1 < NT; ++j) {
    const int sd = sv == 0 ? RING - 1 : sv - 1, sk2 = sv + 2 >= RING ? sv + 2 - RING : sv + 2;
    if (MODE != 2) DMA(j + RING - 1, sd);
    SBAR(); if (MODE != 3) { QK();
    pv8(o, V_lds + sv * SHM_V8, p8, r32, hi); PVS(); }
    WAIT_BAR();
    if (MODE != 1) { softmax14<false, true>(s0, s1, m_reg, negm, l_reg, p8, al);
    RESC(al); } else { p8 = (v8i){(int)__float_as_uint(s0[0]), (int)__float_as_uint(s0[1]), (int)__float_as_uint(s0[2]), (int)__float_as_uint(s0[3]), (int)__float_as_uint(s1[0]), (int)__float_as_uint(s1[1]), (int)__float_as_uint(s1[2]), (int)__float_as_uint(s1[3])}; l_reg += s0[5]; }
    LDK(K_lds + sk2 * SHM_K8);
    BAR_V();
    sv = sv + 1 == RING ? 0 : sv + 1;
  }
  pv8(o, V_lds + sv * SHM_V8, p8, r32, hi); PVS();
  if (!grpB) BAR();
  asm volatile("s_waitcnt vmcnt(0)" ::: "memory");
  if (r32 == 0) {
#pragma unroll
    for (int r = 0; r < 16; ++r) li_l[crow(r, hi)] = o[4][r]; }
  asm volatile("s_waitcnt lgkmcnt(0)" ::: "memory");
  float rli[16];
#pragma unroll
  for (int r = 0; r < 16; ++r) rli[r] = __builtin_amdgcn_rcpf(li_l[crow(r, hi)]);
  bf16_t* Ow = Ob + (long)(wid * QBLK) * ostr;
#pragma unroll
  for (int r = 0; r < 16; ++r) { int orow = crow(r, hi);
#pragma unroll
    for (int d0 = 0; d0 < 4; ++d0) Ow[(long)orow * ostr + d0 * 32 + r32] = (bf16_t)(cvt_pk_bf16(o[d0][r] * rli[r], 0.f) & 0xffffu); }
  __syncthreads();
#undef DMA
#undef BAR
#undef BAR_V
#undef WAIT_BAR
#undef RESC
#undef LDK
#undef PVS
#undef QK
}
}

struct Args { const float* in[28]; float* out; unsigned char* ws; int lo, hi; };
enum { I_X = 0, I_C, I_CTX, I_CCTX, I_WMOD, I_BMOD, I_GPREMIX, I_GPOSTMIX, I_GPREMLP, I_GPOSTMLP, I_WIN, I_CONVW, I_WCO, I_LRE, I_LIM, I_LDT, I_BRE, I_BIM, I_CRE, I_CIM, I_SD, I_WGLU, I_QG, I_KG, I_WAO, I_WOUT, I_WUP, I_WDN };

__device__ __forceinline__ void transpose_block(const float* W, int K, int N, int k0, int n0, bf16_t* dst, LAS float* scr, int lane) {
    f32x4 v[8];
    const int lr = lane >> 3, lc = (lane & 7) * 4;
#pragma unroll
    for (int i = 0; i < 8; ++i) v[i] = *(const f32x4*)(W + (size_t)(k0 + 8 * i + lr) * N + n0 + lc);
#pragma unroll
    for (int i = 0; i < 8; ++i) { LAS float* s = scr + (8 * i + lr) * 33 + lc; s[0] = v[i].x; s[1] = v[i].y; s[2] = v[i].z; s[3] = v[i].w; }
    LDS_WAIT(); asm volatile("" ::: "memory");
    const int c = lane & 7;
#pragma unroll
    for (int j = 0; j < 4; ++j) { const int n = (lane >> 3) + 8 * j; const LAS float* s = scr + (8 * c) * 33 + n;
        u32x4 o; o.x = cvt_pk_bf16(s[0 * 33], s[1 * 33]); o.y = cvt_pk_bf16(s[2 * 33], s[3 * 33]); o.z = cvt_pk_bf16(s[4 * 33], s[5 * 33]); o.w = cvt_pk_bf16(s[6 * 33], s[7 * 33]);
        *(u32x4*)(dst + (size_t)n * K + k0 + 8 * c) = o; }
    LDS_WAIT(); asm volatile("" ::: "memory");
}
__device__ __forceinline__ void transpose_block_f8(const float* W, int K, int N, int k0, int n0, unsigned char* dst, float sc, LAS float* scr, int lane) {
    f32x4 v[8];
    const int lr = lane >> 3, lc = (lane & 7) * 4;
#pragma unroll
    for (int i = 0; i < 8; ++i) v[i] = *(const f32x4*)(W + (size_t)(k0 + 8 * i + lr) * N + n0 + lc);
#pragma unroll
    for (int i = 0; i < 8; ++i) { LAS float* s = scr + (8 * i + lr) * 33 + lc; s[0] = v[i].x * sc; s[1] = v[i].y * sc; s[2] = v[i].z * sc; s[3] = v[i].w * sc; }
    LDS_WAIT(); asm volatile("" ::: "memory");
    const int c = lane & 3;
#pragma unroll
    for (int j = 0; j < 2; ++j) { const int n = (lane >> 2) + 16 * j; const LAS float* s = scr + (16 * c) * 33 + n;
        unsigned w[4];
#pragma unroll
        for (int q = 0; q < 4; ++q) { unsigned t = 0u; t = __builtin_amdgcn_cvt_pk_fp8_f32(s[(4 * q) * 33], s[(4 * q + 1) * 33], t, false); t = __builtin_amdgcn_cvt_pk_fp8_f32(s[(4 * q + 2) * 33], s[(4 * q + 3) * 33], t, true); w[q] = t; }
        *(u32x4*)(dst + (size_t)n * K + k0 + 16 * c) = (u32x4){w[0], w[1], w[2], w[3]}; }
    LDS_WAIT(); asm volatile("" ::: "memory");
}
__device__ __forceinline__ void convert_weights(const Args& a, int l, LAS unsigned char* lds, int gw, int NGW, int wave, int lane) {
    LAS float* scr = (LAS float*)(lds + wave * 16384);
    unsigned char* ws = a.ws;
    constexpr int I_IN = (D / 64) * (NIN / 32), I_CO = (1024 / 64) * (D / 32), I_GLU = (768 / 64) * (4096 / 32), I_AO = I_CO, I_OUT = (D / 64) * (D / 32), I_UP = (D / 64) * (FF / 32), I_DN = (FF / 64) * (D / 32);
    constexpr int NITEMS = I_IN + I_CO + I_GLU + I_AO + I_OUT + I_UP + I_DN;
    for (int it = gw; it < NITEMS; it += NGW) {
        int r = it;
        if (r < I_IN) { const int nb = r % (NIN / 32), kb = r / (NIN / 32);
            if (32 * nb < C_F8) { int dcol = 32 * nb;
                if (dcol >= C_AC && dcol < C_SU) { const bool isv = dcol >= C_AV; const int jn = dcol - (isv ? C_AV : C_AC); dcol = C_AC + 256 * (jn >> 7) + (isv ? 128 : 0) + (jn & 127); }
                transpose_block(a.in[I_WIN] + (size_t)l * D * NIN, D, NIN, 64 * kb, 32 * nb, (bf16_t*)(ws + WS_WIN) + (size_t)dcol * D, scr, lane); }
            else transpose_block_f8(a.in[I_WIN] + (size_t)l * D * NIN, D, NIN, 64 * kb, 32 * nb, (unsigned char*)(ws + WS_WG8) + (size_t)(32 * nb - C_F8) * D, WG8_SCALE, scr, lane);
            continue; } r -= I_IN;
        if (r < I_CO) { const int nb = r % (D / 32), kb = r / (D / 32); transpose_block(a.in[I_WCO] + (size_t)l * 1024 * D, 1024, D, 64 * kb, 32 * nb, (bf16_t*)(ws + WS_WCO) + (size_t)(32 * nb) * 1024, scr, lane); continue; } r -= I_CO;
        if (r < I_GLU) { const int nb = r % 128, kb = r / 128; const int nq = nb & 63, drow = 256 * (nq >> 2) + 32 * (nq & 3) + (nb >= 64 ? 128 : 0);
            transpose_block(a.in[I_WGLU] + (size_t)l * 768 * 4096, 768, 4096, 64 * kb, 32 * nb, (bf16_t*)(ws + WS_WGLU) + (size_t)drow * 768, scr, lane); continue; } r -= I_GLU;
        if (r < I_AO) { const int nb = r % (D / 32), kb = r / (D / 32); transpose_block(a.in[I_WAO] + (size_t)l * 1024 * D, 1024, D, 64 * kb, 32 * nb, (bf16_t*)(ws + WS_WAO) + (size_t)(32 * nb) * 1024, scr, lane); continue; } r -= I_AO;
        if (r < I_OUT) { const int nb = r % (D / 32), kb = r / (D / 32); transpose_block(a.in[I_WOUT] + (size_t)l * D * D, D, D, 64 * kb, 32 * nb, (bf16_t*)(ws + WS_WOUT) + (size_t)(32 * nb) * D, scr, lane); continue; } r -= I_OUT;
        if (r < I_UP) { const int nb = r % (FF / 32), kb = r / (FF / 32); transpose_block(a.in[I_WUP] + (size_t)l * D * FF, D, FF, 64 * kb, 32 * nb, (bf16_t*)(ws + WS_WUP) + (size_t)(32 * nb) * D, scr, lane); continue; } r -= I_UP;
        { const int nb = r % (D / 32), kb = r / (D / 32); transpose_block(a.in[I_WDN] + (size_t)l * FF * D, FF, D, 64 * kb, 32 * nb, (bf16_t*)(ws + WS_WDN) + (size_t)(32 * nb) * FF, scr, lane); }
    }
}

__device__ __forceinline__ void mod_gemv(const Args& a, LAS unsigned char* lds, int bid, int G, int tid, int wave, int lane) {
    LAS float* SV = (LAS float*)lds;
    LAS float* RED = (LAS float*)(lds + 40960);
    float* MOD = (float*)(a.ws + WS_MOD);
    if (bid >= 384) return;
    for (int i = tid; i < 5 * D; i += 512) { const int j = i / D, k = i % D; const float v = j < 4 ? a.in[I_C][j * D + k] : a.in[I_CCTX][k]; SV[i] = v * sigmoidf_(v); }
    __syncthreads();
    for (int it = bid; it < 384; it += G) {
        const int l = it / 96, n0 = (it % 96) * 128;
        const float* W = a.in[I_WMOD] + (size_t)l * D * NMOD + n0 + 2 * lane;
        float acc[5][2];
#pragma unroll
        for (int j = 0; j < 5; ++j) { acc[j][0] = 0.f; acc[j][1] = 0.f; }
        const int kb = wave * 256;
#pragma unroll 16
        for (int k = 0; k < 256; ++k) { const f32x2 w = *(const f32x2*)(W + (size_t)(kb + k) * NMOD);
#pragma unroll
            for (int j = 0; j < 5; ++j) { const float s = SV[j * D + kb + k]; acc[j][0] += s * w.x; acc[j][1] += s * w.y; } }
#pragma unroll
        for (int j = 0; j < 5; ++j) { RED[(wave * 5 + j) * 128 + 2 * lane] = acc[j][0]; RED[(wave * 5 + j) * 128 + 2 * lane + 1] = acc[j][1]; }
        __syncthreads();
        for (int i = tid; i < 640; i += 512) { const int j = i >> 7, cn = i & 127; float s = 0.f;
#pragma unroll
            for (int w = 0; w < 8; ++w) s += RED[(w * 5 + j) * 128 + cn];
            MOD[((size_t)l * 5 + j) * NMOD + n0 + cn] = s + a.in[I_BMOD][l * NMOD + n0 + cn]; }
        __syncthreads();
    }
}

__device__ __forceinline__ void ssm_tables_t1(const Args& a, int gtid, int NT) {
    float* ETAB = (float*)(a.ws + WS_ETAB); float* BBT = (float*)(a.ws + WS_BB);
    for (int idx = gtid; idx < DEPTH * 2 * SG * 64; idx += NT) {
        const int n = idx & 63, gq = (idx >> 6) % SG, dir = (idx / (64 * SG)) & 1, l = idx / (64 * SG * 2);
        const double lr = fmin((double)a.in[I_LRE][idx], -1e-4), li = (double)a.in[I_LIM][idx], dt = exp((double)a.in[I_LDT][(l * 2 + dir) * SG + gq]);
        const double mag = exp(lr * dt), th = li * dt; double sn, cs; sincos(th, &sn, &cs);
        const double ab_re = mag * cs, ab_im = mag * sn, nr = ab_re - 1.0, den = lr * lr + li * li;
        const double f_re = (nr * lr + ab_im * li) / den, f_im = (ab_im * lr - nr * li) / den;
        const size_t o = (((size_t)(l * SG + gq) * 2 + dir) * 64 + n);
        float* e = ETAB + o * 66;
        double pr = 1.0, pi = 0.0;
        for (int k = 0; k <= 32; ++k) { e[2 * k] = (float)pr; e[2 * k + 1] = (float)pi; const double nr2 = pr * ab_re - pi * ab_im, ni2 = pr * ab_im + pi * ab_re; pr = nr2; pi = ni2; }
        float* bb = BBT + o * 32;
        for (int q = 0; q < 16; ++q) { const double br = (double)a.in[I_BRE][(size_t)idx * 16 + q], bi = (double)a.in[I_BIM][(size_t)idx * 16 + q];
            bb[2 * q] = (float)(f_re * br - f_im * bi); bb[2 * q + 1] = (float)(f_re * bi + f_im * br); }
    }
}
__device__ __forceinline__ void ssm_tables_t2(const Args& a, LAS unsigned char* lds, int bid, int G, int tid) {
    LAS float* Cs = (LAS float*)lds;
    LAS float* Es = (LAS float*)(lds + 16 * 65 * 8);
    LAS float* Bs = Es + 64 * 32 * 2;
    const float* ETAB = (const float*)(a.ws + WS_ETAB); const float* BBT = (const float*)(a.ws + WS_BB); float* MT = (float*)(a.ws + WS_MT);
    for (int it = bid; it < DEPTH * SG * 2; it += G) {
        const int dir = it & 1, gq = (it >> 1) % SG, l = it / (2 * SG);
        const size_t o = ((size_t)(l * SG + gq) * 2 + dir);
        const size_t ci = ((size_t)(l * 2 + dir) * SG + gq) * 1024;
        for (int i = tid; i < 1024; i += 512) { const int p = i >> 6, n = i & 63; Cs[(p * 65 + n) * 2] = a.in[I_CRE][ci + i]; Cs[(p * 65 + n) * 2 + 1] = a.in[I_CIM][ci + i]; }
        for (int i = tid; i < 64 * 32; i += 512) { const int n = i >> 5, lag = i & 31; Es[i * 2] = ETAB[(o * 64 + n) * 66 + 2 * lag]; Es[i * 2 + 1] = ETAB[(o * 64 + n) * 66 + 2 * lag + 1]; }
        for (int i = tid; i < 64 * 32; i += 512) Bs[i] = BBT[o * 64 * 32 + i];
        __syncthreads();
        const int lag = tid >> 4, p = tid & 15;
        float acc[16];
#pragma unroll
        for (int q = 0; q < 16; ++q) acc[q] = 0.f;
        for (int n = 0; n < 64; ++n) {
            const float cr = Cs[(p * 65 + n) * 2], cim = Cs[(p * 65 + n) * 2 + 1], er = Es[(n * 32 + lag) * 2], ei = Es[(n * 32 + lag) * 2 + 1];
            const float gr = cr * er - cim * ei, gi = cr * ei + cim * er;
#pragma unroll
            for (int q = 0; q < 16; ++q) acc[q] += gr * Bs[(n * 16 + q) * 2] - gi * Bs[(n * 16 + q) * 2 + 1];
        }
        float* dst = MT + (o * 32 + lag) * 256 + p * 16;
#pragma unroll
        for (int q = 0; q < 16; q += 4) *(f32x4*)(dst + q) = (f32x4){acc[q], acc[q + 1], acc[q + 2], acc[q + 3]};
        __syncthreads();
    }
}
__device__ __forceinline__ void ssm_fill(const Args& a, int l, LAS unsigned char* lds, int bid, int G, int tid) {
    LAS float* MTs = (LAS float*)lds;
    LAS float* Es = (LAS float*)(lds + 65536);
    LAS float* Cs = (LAS float*)(lds + 65536 + 33792);
    LAS float* Bs = (LAS float*)(lds + 65536 + 33792 + 16384);
    LAS float* Ds = (LAS float*)(lds + 65536 + 33792 + 32768);
    const float* ETAB = (const float*)(a.ws + WS_ETAB); const float* BBT = (const float*)(a.ws + WS_BB); const float* MT = (const float*)(a.ws + WS_MT);
    bf16_t* W1 = (bf16_t*)(a.ws + WS_W1); bf16_t* W3 = (bf16_t*)(a.ws + WS_W3);
    for (int it = bid; it < SG * 4; it += G) {
        const int gq = it >> 2, part = it & 3;
        const size_t o = (size_t)(l * SG + gq) * 2;
        for (int i = tid; i < 2 * 32 * 256; i += 512) MTs[i] = MT[o * 32 * 256 + i];
        for (int i = tid; i < 2 * 64 * 66; i += 512) Es[i] = ETAB[o * 64 * 66 + i];
        for (int i = tid; i < 2 * 64 * 32; i += 512) Bs[i] = BBT[o * 64 * 32 + i];
        for (int i = tid; i < 2 * 1024; i += 512) { const int dir = i >> 10, pn = i & 1023; const size_t ci = ((size_t)(l * 2 + dir) * SG + gq) * 1024 + pn;
            Cs[i * 2] = a.in[I_CRE][ci]; Cs[i * 2 + 1] = a.in[I_CIM][ci]; }
        if (tid < 16) Ds[tid] = a.in[I_SD][l * 768 + gq * 16 + tid];
        __syncthreads();
        for (int ch = tid; ch < 128 * 96; ch += 512) {
            const int ncol = part * 128 + ch / 96, kc = ch % 96, t = ncol >> 4, p = ncol & 15;
            float v[8];
            if (kc < 64) { const int s = kc >> 1, q0 = (kc & 1) * 8;
#pragma unroll
                for (int i = 0; i < 8; ++i) { const int q = q0 + i; float x = 0.f;
                    if (s <= t) x += MTs[((t - s) * 16 + p) * 16 + q];
                    if (s >= t) x += MTs[8192 + ((s - t) * 16 + p) * 16 + q];
                    if (s == t && p == q) x += Ds[p];
                    v[i] = x; }
            } else { const int dir = (kc - 64) >> 4, kk0 = ((kc - 64) & 15) * 8, e = dir == 0 ? t + 1 : 32 - t;
#pragma unroll
                for (int i = 0; i < 8; ++i) { const int kk = kk0 + i, prt = kk >> 6, n = kk & 63;
                    const float cr = Cs[((dir * 16 + p) * 64 + n) * 2], cim = Cs[((dir * 16 + p) * 64 + n) * 2 + 1], er = Es[((dir * 64 + n) * 33 + e) * 2], ei = Es[((dir * 64 + n) * 33 + e) * 2 + 1];
                    v[i] = prt == 0 ? (cr * er - cim * ei) : -(cr * ei + cim * er); }
            }
            u32x4 w; w.x = cvt_pk_bf16(v[0], v[1]); w.y = cvt_pk_bf16(v[2], v[3]); w.z = cvt_pk_bf16(v[4], v[5]); w.w = cvt_pk_bf16(v[6], v[7]);
            *(u32x4*)(W3 + ((size_t)(gq * 512 + ncol) * 768 + kc * 8)) = w;
        }
        for (int ch = tid; ch < 64 * 64; ch += 512) {
            const int ncol = part * 64 + (ch >> 6), kc = ch & 63, dir = ncol >> 7, prt = (ncol >> 6) & 1, n = ncol & 63, s = kc >> 1, q0 = (kc & 1) * 8, e = dir == 0 ? 31 - s : s;
            const float er = Es[((dir * 64 + n) * 33 + e) * 2], ei = Es[((dir * 64 + n) * 33 + e) * 2 + 1];
            float v[8];
#pragma unroll
            for (int i = 0; i < 8; ++i) { const float br = Bs[((dir * 64 + n) * 16 + q0 + i) * 2], bi = Bs[((dir * 64 + n) * 16 + q0 + i) * 2 + 1];
                v[i] = prt == 0 ? (er * br - ei * bi) : (er * bi + ei * br); }
            u32x4 w; w.x = cvt_pk_bf16(v[0], v[1]); w.y = cvt_pk_bf16(v[2], v[3]); w.z = cvt_pk_bf16(v[4], v[5]); w.w = cvt_pk_bf16(v[6], v[7]);
            *(u32x4*)(W1 + ((size_t)(gq * 256 + ncol) * 512 + kc * 8)) = w;
        }
        __syncthreads();
    }
}

template <int MODE>
__device__ __forceinline__ void row_pass(LAS unsigned char* lds, int bid, int G, int tid, int wave, int lane,
                                         const float* xin, float* xout, const float* cin, float* cout, const bf16_t* Y, const float* YP  , int nrows, bf16_t* XN, unsigned char* XN8, bool w8,
                                         const float* gpost, const float* gpre, const float* modg  , int gate_off,
                                         const float* modn  , int shift_off, int scale_off) {
    LAS float* V = (LAS float*)lds;
    int cur = -1;
    const int nblk = nrows / 16;
    for (int blk = bid; blk < nblk; blk += G) {
        const int row0 = blk * 16, jb = row0 < ML ? row0 / SEQ : 4;
        if (jb != cur) {
            __syncthreads();
            for (int i = tid; i < D; i += 512) {
                if (cur < 0) { if (MODE != 0) V[i] = gpost[i]; if (MODE != 2) V[D + i] = gpre[i]; }
                if (MODE != 0) V[2 * D + i] = modg[(size_t)jb * NMOD + gate_off + i];
                if (MODE != 2) { V[3 * D + i] = modn[(size_t)jb * NMOD + shift_off + i]; V[4 * D + i] = 1.0f + modn[(size_t)jb * NMOD + scale_off + i]; }
            }
            cur = jb;
            __syncthreads();
        }
        f32x4 x2[2][8]; u32x2 yw[2][8];
#pragma unroll
        for (int rr = 0; rr < 2; ++rr) {
            const int row = row0 + wave * 2 + rr;
            const float* xs = row < ML ? xin + (size_t)row * D : cin + (size_t)(row - ML) * D;
#pragma unroll
            for (int j = 0; j < 8; ++j) x2[rr][j] = __builtin_nontemporal_load((const f32x4*)(xs + 4 * lane + 256 * j));
            if (MODE != 0 && row < ML) {
#pragma unroll
                for (int j = 0; j < 8; ++j) yw[rr][j] = __builtin_nontemporal_load((const u32x2*)(Y + (size_t)row * D + 4 * lane + 256 * j)); }
        }
#pragma unroll
        for (int rr = 0; rr < 2; ++rr) {
            const int row = row0 + wave * 2 + rr;
            float* xd = row < ML ? xout + (size_t)row * D : cout + (size_t)(row - ML) * D;
            f32x4 x[8];
#pragma unroll
            for (int j = 0; j < 8; ++j) x[j] = x2[rr][j];
            if (MODE != 0) {
                f32x4 y[8]; float ss = 0.f;
#pragma unroll
                for (int j = 0; j < 8; ++j) {
                    if (row < ML) { const u32x2 w = yw[rr][j]; y[j] = (f32x4){bf_lo(w.x), bf_hi(w.x), bf_lo(w.y), bf_hi(w.y)}; }
                    else { const float* yp = YP + (size_t)(row - ML) * D + 4 * lane + 256 * j; f32x4 s = *(const f32x4*)yp;
#pragma unroll
                        for (int ks = 1; ks < 8; ++ks) s += *(const f32x4*)(yp + (size_t)ks * MC * D);
                        y[j] = s; }
                    ss += (y[j].x * y[j].x + y[j].y * y[j].y) + (y[j].z * y[j].z + y[j].w * y[j].w); }
                const float rstd = rsqrtf(wave_sum(ss) * (1.f / D) + NORM_EPS);
#pragma unroll
                for (int j = 0; j < 8; ++j) { const f32x4 gp = *(const LAS f32x4*)(V + 4 * lane + 256 * j), gt = *(const LAS f32x4*)(V + 2 * D + 4 * lane + 256 * j);
                    x[j] = x[j] + gt * (y[j] * rstd * gp);
                    if (MODE != 3) __builtin_nontemporal_store(x[j], (f32x4*)(xd + 4 * lane + 256 * j)); }
            }
            if (MODE != 2) {
                float ss = 0.f;
#pragma unroll
                for (int j = 0; j < 8; ++j) ss += (x[j].x * x[j].x + x[j].y * x[j].y) + (x[j].z * x[j].z + x[j].w * x[j].w);
                const float rstd = rsqrtf(wave_sum(ss) * (1.f / D) + NORM_EPS);
#pragma unroll
                for (int j = 0; j < 8; ++j) { const f32x4 gp = *(const LAS f32x4*)(V + D + 4 * lane + 256 * j), sh = *(const LAS f32x4*)(V + 3 * D + 4 * lane + 256 * j), sc = *(const LAS f32x4*)(V + 4 * D + 4 * lane + 256 * j);
                    const f32x4 h = sh + sc * (x[j] * rstd * gp);
                    u32x2 w; w.x = cvt_pk_bf16(h.x, h.y); w.y = cvt_pk_bf16(h.z, h.w);
                    *(u32x2*)(XN + (size_t)row * D + 4 * lane + 256 * j) = w;
                    if (w8) { unsigned t = 0u; t = __builtin_amdgcn_cvt_pk_fp8_f32(h.x, h.y, t, false); t = __builtin_amdgcn_cvt_pk_fp8_f32(h.z, h.w, t, true); *(unsigned*)(XN8 + (size_t)row * D + 4 * lane + 256 * j) = t; } }
            }
        }
    }
    __syncthreads();
}

__device__ __forceinline__ void conv_pass(const Args& a, int l, int wk, int nwk, int lane) {
    bf16_t* P = (bf16_t*)(a.ws + WS_P);
    const int c = (wk & 1) * 512 + 8 * lane;
    const float* cw = a.in[I_CONVW] + (size_t)l * 3 * 1024 + c;
    float w0[8], w1[8], w2[8];
#pragma unroll
    for (int i = 0; i < 8; ++i) { w0[i] = cw[i]; w1[i] = cw[1024 + i]; w2[i] = cw[2048 + i]; }
    for (int it = wk; it < (M / 16) * 8; it += nwk) {
        const int r0 = (it >> 3) * 16 + ((it >> 1) & 3) * 4;
        const int s0 = r0 < ML ? (r0 / SEQ) * SEQ : ML + ((r0 - ML) / CTXL) * CTXL, s1 = s0 + (r0 < ML ? SEQ : CTXL);
        float u[6][8];
#pragma unroll
        for (int k = 0; k < 6; ++k) { const int r = r0 - 1 + k;
            if (r >= s0 && r < s1) { f32x4 c0, c1; pg8::unpack8(*(const u32x4*)(P + (size_t)r * NIN + C_AC + c), c0, c1);
#pragma unroll
                for (int i = 0; i < 4; ++i) { u[k][i] = c0[i]; u[k][4 + i] = c1[i]; } }
            else {
#pragma unroll
                for (int i = 0; i < 8; ++i) u[k][i] = 0.f; } }
#pragma unroll
        for (int k = 0; k < 4; ++k) { bf16_t* pb = P + (size_t)(r0 + k) * NIN + C_AB + c; f32x4 b0, b1; pg8::unpack8(*(const u32x4*)pb, b0, b1);
#pragma unroll
            for (int i = 0; i < 4; ++i) { b0[i] *= w0[i] * u[k][i] + w1[i] * u[k + 1][i] + w2[i] * u[k + 2][i]; b1[i] *= w0[4 + i] * u[k][4 + i] + w1[4 + i] * u[k + 1][4 + i] + w2[4 + i] * u[k + 2][4 + i]; }
            *(u32x4*)pb = pg8::pack8(b0, b1); }
    }
}
__device__ __forceinline__ void qk_pass(const Args& a, int l, int gw, int NGW, int lane) {
    bf16_t* P = (bf16_t*)(a.ws + WS_P); unsigned char* K8 = (unsigned char*)(a.ws + WS_K8);
    const float* ROPE = (const float*)(a.ws + WS_ROPE);
    const int j = lane & 15, hd = (lane >> 4) & 1, rp2 = lane >> 5;
    float gk_[8];
#pragma unroll
    for (int i = 0; i < 8; ++i) gk_[i] = a.in[I_KG][l * 128 + 8 * j + i];
    for (int r0 = 8 * gw; r0 < M; r0 += 8 * NGW) {
        const bool lat = r0 < ML;
        u32x4 raw[4]; f32x4 cs[4][2], sn[4][2];
#pragma unroll
        for (int rr = 0; rr < 4; ++rr) { const int row = r0 + 2 * rr + rp2;
            raw[rr] = *(const u32x4*)(P + (size_t)row * NIN + C_K + hd * 128 + 8 * j);
            if (lat) { const int t = row % SEQ, pos = (j < 8) ? (t >> 6) : (t & 63); const float* rp = ROPE + pos * 32 + 8 * (j & 3);
                cs[rr][0] = *(const f32x4*)rp; cs[rr][1] = *(const f32x4*)(rp + 4); sn[rr][0] = *(const f32x4*)(rp + 4096); sn[rr][1] = *(const f32x4*)(rp + 4100); } }
#pragma unroll
        for (int rr = 0; rr < 4; ++rr) { const int row = r0 + 2 * rr + rp2;
            f32x4 v0, v1; pg8::unpack8(raw[rr], v0, v1);
            float x[8] = {v0[0], v0[1], v0[2], v0[3], v1[0], v1[1], v1[2], v1[3]};
            float ss = 0.f;
#pragma unroll
            for (int i = 0; i < 8; ++i) ss += x[i] * x[i];
            ss += __shfl_xor(ss, 1); ss += __shfl_xor(ss, 2); ss += __shfl_xor(ss, 4); ss += __shfl_xor(ss, 8);
            const float rstd = rsqrtf(ss * (1.f / 128.f) + NORM_EPS);
#pragma unroll
            for (int i = 0; i < 8; ++i) x[i] = x[i] * rstd * gk_[i];
            if (lat) {
#pragma unroll
                for (int i = 0; i < 8; ++i) { const float pr = __shfl_xor(x[i], 4); x[i] = x[i] * cs[rr][i >> 2][i & 3] + ((j & 4) ? pr : -pr) * sn[rr][i >> 2][i & 3]; } }
            {
                const int bq = lat ? row / SEQ : (row - ML) / CTXL, key = lat ? CTXL + row % SEQ : (row - ML) % CTXL;
                unsigned t0_ = 0u, t1_ = 0u;
                t0_ = __builtin_amdgcn_cvt_pk_fp8_f32(x[0], x[1], t0_, false); t0_ = __builtin_amdgcn_cvt_pk_fp8_f32(x[2], x[3], t0_, true);
                t1_ = __builtin_amdgcn_cvt_pk_fp8_f32(x[4], x[5], t1_, false); t1_ = __builtin_amdgcn_cvt_pk_fp8_f32(x[6], x[7], t1_, true);
                *(u32x2*)(K8 + ((size_t)(bq * 2 + hd) * (CTXL + SEQ) + key) * 128 + 8 * j) = (u32x2){t0_, t1_}; }
        }
    }
}
__device__ __forceinline__ void vt_pass(const Args& a, LAS unsigned char* scr, int wk, int nwk, int lane) {
    const bf16_t* P = (const bf16_t*)(a.ws + WS_P); unsigned char* VT8 = (unsigned char*)(a.ws + WS_VT8);
    const int j = lane & 15, kq = lane >> 4;
    for (int it = wk; it < NBATCH * 2 * 132; it += nwk) {
        const int b = it / 264, kvh = (it / 132) & 1, tau = it % 132;
        const size_t row0 = tau < 4 ? (size_t)(ML + b * CTXL + tau * 64) : (size_t)b * SEQ + (size_t)(tau - 4) * 64;
        u32x4 raw[16];
#pragma unroll
        for (int i = 0; i < 16; ++i) raw[i] = *(const u32x4*)(P + (row0 + 4 * i + kq) * NIN + C_V + kvh * 128 + 8 * j);
#pragma unroll
        for (int i = 0; i < 16; ++i) { const int pos = attn::v_pos(4 * i + kq); f32x4 v0, v1; pg8::unpack8(raw[i], v0, v1);
            unsigned w0 = 0u, w1 = 0u;
            w0 = __builtin_amdgcn_cvt_pk_fp8_f32(v0[0], v0[1], w0, false); w0 = __builtin_amdgcn_cvt_pk_fp8_f32(v0[2], v0[3], w0, true);
            w1 = __builtin_amdgcn_cvt_pk_fp8_f32(v1[0], v1[1], w1, false); w1 = __builtin_amdgcn_cvt_pk_fp8_f32(v1[2], v1[3], w1, true);
#pragma unroll
            for (int e = 0; e < 4; ++e) { scr[(8 * j + e) * 64 + pos] = (unsigned char)(w0 >> (8 * e)); scr[(8 * j + 4 + e) * 64 + pos] = (unsigned char)(w1 >> (8 * e)); } }
        LDS_WAIT(); asm volatile("" ::: "memory");
        unsigned char* dst = VT8 + ((size_t)(b * 2 + kvh) * 132 + tau) * 8192;
#pragma unroll
        for (int i = 0; i < 8; ++i) *(u32x4*)(dst + 16 * (lane + 64 * i)) = *(const LAS u32x4*)(scr + 16 * (lane + 64 * i));
        LDS_WAIT(); asm volatile("" ::: "memory");
    }
}
__device__ __forceinline__ void ssm_scan(const Args& a, int l, int bid, int G, int wave, int lane) {
    const float* S = (const float*)(a.ws + WS_S); bf16_t* As = (bf16_t*)(a.ws + WS_ASSM); const float* ETAB = (const float*)(a.ws + WS_ETAB);
    for (int ch = bid + G * wave; ch < NBATCH * SG * 2; ch += G * 8) {
        const int dir = ch & 1, gq = (ch >> 1) % SG, b = ch / (2 * SG);
        const float* e = ETAB + ((((size_t)(l * SG + gq) * 2 + dir) * 64 + lane) * 66 + 64);
        const float ar = e[0], ai = e[1];
        float hr = 0.f, hi = 0.f;
        for (int s0 = 0; s0 < 264; s0 += 12) {
            float sr[12], si[12]; int rows[12];
#pragma unroll
            for (int k = 0; k < 12; ++k) { const int s = s0 + k; int row;
                if (s < 8) row = 1024 + 8 * b + (dir == 0 ? s : 7 - s); else row = 256 * b + (dir == 0 ? s - 8 : 263 - s);
                rows[k] = row; const float* sp = S + ((size_t)(gq * SGR + row) * 256 + dir * 128 + lane); sr[k] = sp[0]; si[k] = sp[64]; }
#pragma unroll
            for (int k = 0; k < 12; ++k) { bf16_t* hp = As + ((size_t)(gq * SGR + rows[k]) * 768 + 512 + dir * 128 + lane);
                hp[0] = (bf16_t)(cvt_pk_bf16(hr, 0.f) & 0xffffu); hp[64] = (bf16_t)(cvt_pk_bf16(hi, 0.f) & 0xffffu);
                const float nr = ar * hr - ai * hi + sr[k], ni = ar * hi + ai * hr + si[k]; hr = nr; hi = ni; }
        }
    }
}

typedef const __attribute__((address_space(4))) unsigned long long* KArgP;
__device__ __forceinline__ Args load_args() {
    KArgP p = (KArgP)__builtin_amdgcn_kernarg_segment_ptr(); asm volatile("" : "+s"(p));
    Args r;
#pragma unroll
    for (int i = 0; i < 28; ++i) r.in[i] = (const float*)(const GAS float*)p[i];
    r.out = (float*)(GAS float*)p[28]; r.ws = (unsigned char*)(GAS unsigned char*)p[29]; const unsigned long long lh = p[30]; r.lo = (int)(unsigned)lh; r.hi = (int)(unsigned)(lh >> 32);
    return r;
}
__global__ void __launch_bounds__(512, 2) hybrid_fwd(Args ka) {
    extern __shared__ __attribute__((aligned(16))) unsigned char lds_raw[];
    LAS unsigned char* lds = (LAS unsigned char*)lds_raw;
    volatile LAS unsigned* MISC = (volatile LAS unsigned*)(lds + MISC_OFF);
    const int G = gridDim.x, bid = blockIdx.x;
    if (threadIdx.x < 64) MISC[threadIdx.x] = 0u;
    __syncthreads();
    XcdBarrier bar; bar.bar = (unsigned*)(ka.ws + WS_CTL) + CW_BAR; bar.x = 0; bar.st = nullptr;
    if (ka.hi - ka.lo > 1) bar = xcd_barrier_post((unsigned*)(ka.ws + WS_CTL) + CW_BAR, MISC + 8);
#define PH(k) (ka.lo <= (k) && (k) < ka.hi)
#define SEAM(k) do { if ((k) + 1 < ka.hi) xcd_barrier(bar); } while (0)
#define PHASE_ARGS const Args a = load_args(); unsigned char* const ws = a.ws; (void)ws; \
    int tid_ = threadIdx.x; asm volatile("" : "+v"(tid_)); const int tid = tid_, lane = tid & 63, wave = __builtin_amdgcn_readfirstlane(tid >> 6); \
    const int gw = bid * 8 + wave, NGW = G * 8, gtid = bid * 512 + tid, NTHR = G * 512; (void)lane; (void)gw; (void)NGW; (void)gtid; (void)NTHR; \
    bf16_t* const P = (bf16_t*)(ws + WS_P); bf16_t* const XN = (bf16_t*)(ws + WS_XN); bf16_t* const MX = (bf16_t*)(ws + WS_MX); bf16_t* const UP = (bf16_t*)(ws + WS_UP); \
    bf16_t* const ASSM = (bf16_t*)(ws + WS_ASSM); float* const SST = (float*)(ws + WS_S); float* const CTXR = (float*)(ws + WS_CTXR); float* const MOD = (float*)(ws + WS_MOD); \
    (void)P; (void)XN; (void)MX; (void)UP; (void)ASSM; (void)SST; (void)CTXR; (void)MOD;

    if (PH(0)) { PHASE_ARGS
        float* ROPE = (float*)(ws + WS_ROPE);
        for (int idx = gtid; idx < 4096; idx += NTHR) { const int pos = idx >> 5, i = idx & 31; const double inv = exp(-(double)i * (9.210340371976184 / 32.0)); double s, c; sincos((double)pos * inv, &s, &c); ROPE[idx] = (float)c; ROPE[4096 + idx] = (float)s; }
        for (int rep = 0; rep < REP_CV; ++rep) { ssm_tables_t1(a, gtid, NTHR);
        mod_gemv(a, lds, bid, G, tid, wave, lane); __syncthreads(); }
        __syncthreads();
        for (int rep = 0; rep < REP_CV; ++rep) convert_weights(a, 0, lds, gw, NGW, wave, lane);
        SEAM(0);
    }
    if (PH(1)) { PHASE_ARGS
        for (int rep = 0; rep < REP_CV; ++rep) ssm_tables_t2(a, lds, bid, G, tid);
        if (REP_RP > 1) row_pass<0>(lds, bid, G, tid, wave, lane, a.in[I_X], (float*)P, a.in[I_CTX], (float*)(ws + WS_P + 500 * MiB), MX, (const float*)(ws + WS_PART), M, (bf16_t*)(ws + WS_P + 300 * MiB), (unsigned char*)(ws + WS_XN8), false, a.in[I_GPREMIX], a.in[I_GPREMIX], MOD, 0, MOD, 0, D);
        row_pass<0>(lds, bid, G, tid, wave, lane, a.in[I_X], a.out, a.in[I_CTX], CTXR, MX, (const float*)(ws + WS_PART), M, XN, (unsigned char*)(ws + WS_XN8), true, a.in[I_GPREMIX], a.in[I_GPREMIX], MOD, 0, MOD, 0, D);
        SEAM(1);
    }
    for (int l = 0; l < DEPTH; ++l) {
        const int pb = 2 + 12 * l;
        const int Meff = l + 1 < DEPTH ? M : ML;
        if (PH(pb + 0)) { PHASE_ARGS
            if (l == 0) for (int rep = 0; rep < REP_CV; ++rep) ssm_fill(a, l, lds, bid, G, tid);
            { pg8::Gemm g{XN, (const bf16_t*)(ws + WS_WIN), D, D, D}; pg8::StaticOrder S; S.init(M, C_F8, D, G, bid);
              pg8::EpiProj E{P, ASSM};
              for (int rep = 0; rep < REP_BIG * REP_PROJ; ++rep) pg8::gemm_phase(lds, g, S, E); }
            SEAM(pb + 0);
        }
        if (PH(pb + 1)) { PHASE_ARGS
            if (bid & 1) conv_pass(a, l, gw, NGW, lane);
            {
              pg8::Gemm g{(const bf16_t*)(ws + WS_XN8), (const bf16_t*)(ws + WS_WG8), D / 2, D / 2, D / 2}; pg8::StaticOrder S; S.init(M, NIN - C_F8, D / 2, G, bid);
              pg8::EpiGate E{P};
              for (int rep = 0; rep < REP_BIG * REP_PROJ; ++rep) pg8::gemm_phase<pg8::EpiGate, pg8::StaticOrder, true>(lds, g, S, E); }
            { pg8::Gemm g{ASSM, (const bf16_t*)(ws + WS_W1), 768, 512, 512}; pg8::GroupOrder S;
              {
                const int rem_ = ((M / 256) * ((NIN - C_F8) / 256)) % G;
                if (rem_ != 0 && 2 * (G - rem_) >= SG * 5) S.init(1, 512, G - rem_, bid >= rem_ ? bid - rem_ : (1 << 20)); else S.init(1, 512, G, bid); }
              pg8::EpiState E{SST}; for (int rep = 0; rep < REP_RG; ++rep) pg8::gemm_phase(lds, g, S, E); }
            if (!(bid & 1)) conv_pass(a, l, gw, NGW, lane);
            SEAM(pb + 1);
        }
        if (PH(pb + 2)) { PHASE_ARGS
            if (wave < 2) { for (int rep = 0; rep < REP_SCAN; ++rep) ssm_scan(a, l, bid, G, wave, lane); }
            else { const int wk = bid * 6 + (wave - 2), nwk = G * 6; qk_pass(a, l, wk, nwk, lane); vt_pass(a, lds + wave * 8192, wk, nwk, lane); }
            SEAM(pb + 2);
        }
        if (PH(pb + 3)) { PHASE_ARGS
            { pg8::Gemm g{ASSM, (const bf16_t*)(ws + WS_W3), 768, 768, 768}; pg8::GroupOrder S; S.init(2, 768, G, bid); pg8::EpiSsmY E{P}; for (int rep = 0; rep < REP_RG; ++rep) pg8::gemm_phase(lds, g, S, E); }
            for (int rep = 0; rep < REP_ATT; ++rep)
            for (int u = bid; u < (l + 1 < DEPTH ? 1056 : 1024); u += G) {
                const bool lat = u < 1024; int b, hq, qb;
                if (lat) { const int xcd = u & 7, idx = (u >> 3) & 31, rnd = u >> 8; b = xcd >> 1; hq = (xcd & 1) * 4 + (idx >> 3); qb = (idx & 7) + 8 * rnd; }
                else { const int c = u - 1024; b = c >> 3; hq = c & 7; qb = 0; }
                const int kvh = hq >> 2;
                const size_t r0 = lat ? (size_t)b * SEQ + (size_t)qb * 256 : (size_t)(ML + b * CTXL);
                const size_t kvo = (size_t)(b * 2 + kvh) * (CTXL + SEQ) * 128;
#ifdef ATT_PROBE
                attn::attn_unit14<ATT_PROBE - 1>(P + r0 * NIN + C_Q + hq * 128, (const unsigned char*)(ws + WS_K8) + kvo, (const unsigned char*)(ws + WS_VT8) + kvo, XN + (size_t)bid * 256 * 128, lat ? CTXL + SEQ : CTXL,
                                  (char*)lds_raw, lds, a.in[I_QG] + l * 128, (const float*)(ws + WS_ROPE), lat ? qb * 256 : -1, 128);
#endif
                attn::attn_unit14(P + r0 * NIN + C_Q + hq * 128, (const unsigned char*)(ws + WS_K8) + kvo, (const unsigned char*)(ws + WS_VT8) + kvo, P + r0 * NIN + C_O + hq * 128, lat ? CTXL + SEQ : CTXL,
                                  (char*)lds_raw, lds, a.in[I_QG] + l * 128, (const float*)(ws + WS_ROPE), lat ? qb * 256 : -1);
            }
            SEAM(pb + 3);
        }
        if (PH(pb + 4)) { PHASE_ARGS pg8::Gemm g{P + C_AB, (const bf16_t*)(ws + WS_WCO), NIN, 1024, 1024}; pg8::StaticOrder S; S.init(Meff, D, 1024, G, bid); pg8::EpiMerge<false> E{XN, P, C_GC}; for (int rep = 0; rep < REP_RG; ++rep) pg8::gemm_phase(lds, g, S, E, S.stagger()); SEAM(pb + 4); }
        if (PH(pb + 5)) { PHASE_ARGS pg8::Gemm g{P + C_Y, (const bf16_t*)(ws + WS_WGLU), NIN, 768, 768}; pg8::StaticOrder S; S.init(Meff, 4096, 768, G, bid); pg8::EpiGlu E{XN, P}; if (REP_RG > 1) { pg8::EpiGlu Ed{MX, P}; pg8::gemm_phase(lds, g, S, Ed); } pg8::gemm_phase(lds, g, S, E, S.stagger()); SEAM(pb + 5); }
        if (PH(pb + 6)) { PHASE_ARGS pg8::Gemm g{P + C_O, (const bf16_t*)(ws + WS_WAO), NIN, 1024, 1024}; pg8::StaticOrder S; S.init(Meff, D, 1024, G, bid); pg8::EpiMerge<true> E{XN, P, C_GA}; if (REP_RG > 1) { pg8::EpiMerge<true> Ed{MX, P, C_GA}; pg8::gemm_phase(lds, g, S, Ed); } pg8::gemm_phase(lds, g, S, E, S.stagger()); SEAM(pb + 6); }
        if (PH(pb + 7)) { PHASE_ARGS pg8::Gemm g{XN, (const bf16_t*)(ws + WS_WOUT), D, D, D}; pg8::SplitCtxOrder S; S.init(D, D, G, bid, l + 1 < DEPTH); pg8::EpiBf16Part E{MX, (float*)(ws + WS_PART)}; for (int rep = 0; rep < REP_RG; ++rep) pg8::gemm_phase(lds, g, S, E); SEAM(pb + 7); }
        if (PH(pb + 8)) { PHASE_ARGS
            const float* modl = MOD + (size_t)l * 5 * NMOD;
            if (REP_RP > 1) row_pass<1>(lds, bid, G, tid, wave, lane, l == 0 ? a.in[I_X] : a.out, (float*)P, l == 0 ? a.in[I_CTX] : CTXR, (float*)(ws + WS_P + 500 * MiB), MX, (const float*)(ws + WS_PART), Meff, (bf16_t*)(ws + WS_P + 300 * MiB), (unsigned char*)(ws + WS_XN8), false, a.in[I_GPOSTMIX] + l * D, a.in[I_GPREMLP] + l * D, modl, 2 * D, modl, 3 * D, 4 * D);
            row_pass<1>(lds, bid, G, tid, wave, lane, l == 0 ? a.in[I_X] : a.out, a.out, l == 0 ? a.in[I_CTX] : CTXR, CTXR, MX, (const float*)(ws + WS_PART), Meff, XN, (unsigned char*)(ws + WS_XN8), false, a.in[I_GPOSTMIX] + l * D, a.in[I_GPREMLP] + l * D, modl, 2 * D, modl, 3 * D, 4 * D);
            SEAM(pb + 8);
        }
        if (PH(pb + 9)) { PHASE_ARGS pg8::Gemm g{XN, (const bf16_t*)(ws + WS_WUP), D, D, D}; pg8::StaticOrder S; S.init(Meff, FF, D, G, bid); pg8::EpiBf16<1> E{UP, FF, 0};
#if OVL_EXP
            { const float* modl = MOD + (size_t)l * 5 * NMOD; const int kq = OVL_EXP == 2 ? (bid & 15) : 0;
              if (kq > 0) { pg8::StaticOrder S1 = S; S1.iend = kq; pg8::gemm_phase(lds, g, S1, E); }
              row_pass<3>(lds, bid, G, tid, wave, lane, a.out, a.out, CTXR, CTXR, MX, (const float*)(ws + WS_PART), ML, ASSM, (unsigned char*)(ws + WS_XN8), false, a.in[I_GPOSTMIX] + l * D, a.in[I_GPREMLP] + l * D, modl, 2 * D, modl, 3 * D, 4 * D);
              S.ibeg = kq; }
#endif
            if (REP_UP) { pg8::EpiBf16<1> Ed{UP, FF, REP_UP == 2 ? (G + 1000) : 0}; pg8::gemm_phase(lds, g, S, Ed); } for (int rep = 0; rep < REP_BIG; ++rep) pg8::gemm_phase(lds, g, S, E, S.stagger()); SEAM(pb + 9); }
        if (PH(pb + 10)) { PHASE_ARGS pg8::Gemm g{UP, (const bf16_t*)(ws + WS_WDN), FF, FF, FF}; pg8::SplitCtxOrder S; S.init(D, FF, G, bid, l + 1 < DEPTH); S.so.wgm = 4; pg8::EpiBf16Part E{MX, (float*)(ws + WS_PART)}; for (int rep = 0; rep < REP_BIG * REP_DOWN; ++rep) pg8::gemm_phase(lds, g, S, E); SEAM(pb + 10); }
        if (PH(pb + 11)) { PHASE_ARGS
            const float* modl = MOD + (size_t)l * 5 * NMOD;
            if (l + 1 < DEPTH) {
                if (REP_RP > 1) row_pass<1>(lds, bid, G, tid, wave, lane, a.out, (float*)P, CTXR, (float*)(ws + WS_P + 500 * MiB), MX, (const float*)(ws + WS_PART), M, (bf16_t*)(ws + WS_P + 300 * MiB), (unsigned char*)(ws + WS_XN8), false, a.in[I_GPOSTMLP] + l * D, a.in[I_GPREMIX] + (l + 1) * D, modl, 5 * D, modl + 5 * NMOD, 0, D);
                row_pass<1>(lds, bid, G, tid, wave, lane, a.out, a.out, CTXR, CTXR, MX, (const float*)(ws + WS_PART), M, XN, (unsigned char*)(ws + WS_XN8), true, a.in[I_GPOSTMLP] + l * D, a.in[I_GPREMIX] + (l + 1) * D, modl, 5 * D, modl + 5 * NMOD, 0, D);
                for (int rep = 0; rep < REP_CV; ++rep) convert_weights(a, l + 1, lds, gw, NGW, wave, lane);
                __syncthreads();
                ssm_fill(a, l + 1, lds, (bid + 64) % G, G, tid);
                SEAM(pb + 11);
            } else {
                if (REP_RP > 1) row_pass<2>(lds, bid, G, tid, wave, lane, a.out, (float*)P, CTXR, CTXR, MX, (const float*)(ws + WS_PART), ML, XN, (unsigned char*)(ws + WS_XN8), false, a.in[I_GPOSTMLP] + l * D, a.in[I_GPOSTMLP] + l * D, modl, 5 * D, modl, 0, 0);
                row_pass<2>(lds, bid, G, tid, wave, lane, a.out, a.out, CTXR, CTXR, MX, (const float*)(ws + WS_PART), ML, XN, (unsigned char*)(ws + WS_XN8), false, a.in[I_GPOSTMLP] + l * D, a.in[I_GPOSTMLP] + l * D, modl, 5 * D, modl, 0, 0);
            }
        }
    }
#undef PH
#undef PHASE_ARGS
#undef SEAM
}

constexpr int N_PHASES = 2 + 12 * DEPTH;
extern "C" void kernel_launch(void* const* d_in, const int* in_sizes, int n_in, void* d_out, int out_size, void* d_ws, size_t ws_size, hipStream_t stream) {
    static int grid = 0;
    if (grid == 0) {
        if (n_in != 28 || in_sizes[0] != ML * D || out_size != ML * D || ws_size < WS_END) { fprintf(stderr, "kernel_launch: shape/workspace mismatch (n_in %d, ws %zu < %zu?)\n", n_in, ws_size, (size_t)WS_END); grid = -1; return; }
        int dev = 0, cus = 0, per_cu = 0;
        if (hipGetDevice(&dev) != hipSuccess || hipDeviceGetAttribute(&cus, hipDeviceAttributeMultiprocessorCount, dev) != hipSuccess) { grid = -1; return; }
        if (hipFuncSetAttribute((const void*)hybrid_fwd, hipFuncAttributeMaxDynamicSharedMemorySize, LDS_BYTES) != hipSuccess) { fprintf(stderr, "kernel_launch: hipFuncSetAttribute failed\n"); grid = -1; return; }
        if (hipOccupancyMaxActiveBlocksPerMultiprocessor(&per_cu, (const void*)hybrid_fwd, 512, LDS_BYTES) != hipSuccess || per_cu < 1) { fprintf(stderr, "kernel_launch: occupancy query says %d blocks per CU\n", per_cu); (void)hipGetLastError(); if (per_cu < 1) { grid = -1; return; } }
        grid = cus;
    }
    if (grid < 0) return;
    if (hipMemsetAsync((char*)d_ws + WS_CTL, 0, CTL_ZERO_BYTES, stream) != hipSuccess) return;
    Args a{};
    for (int i = 0; i < 28; ++i) a.in[i] = (const float*)d_in[i];
    a.out = (float*)d_out; a.ws = (unsigned char*)d_ws;
#if MK_PER_PHASE
    for (int p = 0; p < N_PHASES; ++p) { a.lo = p; a.hi = p + 1; hipLaunchKernelGGL(hybrid_fwd, dim3(grid), dim3(512), LDS_BYTES, stream, a); }
#else
    a.lo = 0; a.hi = N_PHASES;
    hipLaunchKernelGGL(hybrid_fwd, dim3(grid), dim3(512), LDS_BYTES, stream, a);
#endif
    const hipError_t le = hipPeekAtLastError();
    if (le != hipSuccess) fprintf(stderr, "kernel_launch: launch failed: %s\n", hipGetErrorName(le));
}
```
